# Optimizing an MI355X kernel written in HIP

```python
import math
import jax, jax.numpy as jnp
from jax import lax
import numpy as np

D_MODEL = 1024
BATCH = 4
SEQ = 4096
DEPTH = 2

MIX_WIDTH = D_MODEL
DN_WIDTH = MIX_WIDTH // 2
DN_HEAD_DIM = 128
DN_HEADS = DN_WIDTH // DN_HEAD_DIM
DN_CONV = 5
DN_CHUNK = 64
DN_IN = 4 * DN_WIDTH + 4 * DN_HEADS
S5_WIDTH = MIX_WIDTH - DN_WIDTH
S5_GROUP = 16
S5_GROUPS = S5_WIDTH // S5_GROUP
S5_STATE = 64
AB_IN = DN_IN + S5_WIDTH
RW_WIDTH = MIX_WIDTH // 2
RW_HEAD_DIM = 64
RW_HEADS = RW_WIDTH // RW_HEAD_DIM
RW_DECAY_LORA = 64
RW_AAA_LORA = 64
RW_GATE_LORA = 128
RW_GN_EPS = 64e-5
RW_IN = 3 * RW_WIDTH + 2 * RW_DECAY_LORA + 2 * RW_AAA_LORA + RW_GATE_LORA
DF_WIDTH = MIX_WIDTH - RW_WIDTH
DF_HEAD_DIM = 64
DF_HEADS = DF_WIDTH // (2 * DF_HEAD_DIM)
DF_Q_BLOCK = 128
CD_IN = RW_IN + 3 * DF_WIDTH
N_EXPERTS = 16
EC_CAPACITY_FACTOR = 2
D_EXPERT = 2816
NORM_EPS = 1e-6

kernel_name = 'hybrid_deltanet_s5_rwkv7_diffattn_ec_moe'

F32 = jnp.float32


def rms_norm(x, gain, eps=NORM_EPS):
    xf = x.astype(F32)
    y = xf * lax.rsqrt(jnp.mean(xf * xf, axis=-1, keepdims=True) + eps)
    return (y * gain.astype(F32)).astype(x.dtype)


def l2_normalize(x, eps=1e-6):
    xf = x.astype(F32)
    return xf * lax.rsqrt(jnp.sum(xf * xf, axis=-1, keepdims=True) + eps)


def centred_depthwise_conv(x, w):
    pad = w.shape[0] // 2
    return lax.conv_general_dilated(x, w[:, None, :], window_strides=(1,), padding=[(pad, pad)],
                                    dimension_numbers=('NWC', 'WIO', 'NWC'),
                                    feature_group_count=x.shape[-1])


def chunk_gated_delta_rule(q, k, v, g, beta):
    b, h, s, dk = q.shape
    dv = v.shape[-1]
    cs = DN_CHUNK
    n = s // cs
    q = q * dk ** -0.5
    rs = lambda t: t.reshape(b, h, n, cs, *t.shape[3:])
    q, k, v, g, beta = rs(q), rs(k), rs(v), rs(g), rs(beta)
    gc = jnp.cumsum(g, axis=-1)
    tri_incl = jnp.tril(jnp.ones((cs, cs), bool))
    tri_strict = jnp.tril(jnp.ones((cs, cs), bool), -1)
    decay = jnp.exp(jnp.where(tri_incl, gc[..., :, None] - gc[..., None, :], -jnp.inf))
    k_beta = k * beta[..., None]
    v_beta = v * beta[..., None]
    lower = jnp.where(tri_strict, jnp.einsum('bhncd,bhnsd->bhncs', k_beta, k) * decay, 0.0)
    eye = jnp.eye(cs, dtype=F32)
    t_mat = lax.linalg.triangular_solve(eye + lower, jnp.broadcast_to(eye, lower.shape),
                                        left_side=True, lower=True)
    u = t_mat @ v_beta
    w = t_mat @ (k_beta * jnp.exp(gc)[..., None])
    attn_intra = jnp.einsum('bhncd,bhnsd->bhncs', q, k) * decay
    q_dec = q * jnp.exp(gc)[..., None]
    k_dec = k * jnp.exp(gc[..., -1:] - gc)[..., None]
    g_last = jnp.exp(gc[..., -1])

    def step(state, xs):
        u_c, w_c, qd_c, kd_c, a_c, gl_c = xs
        v_new = u_c - w_c @ state
        o = qd_c @ state + a_c @ v_new
        state = state * gl_c[..., None, None] + jnp.swapaxes(kd_c, -1, -2) @ v_new
        return state, o

    xs = tuple(jnp.moveaxis(t, 2, 0) for t in (u, w, q_dec, k_dec, attn_intra, g_last))
    _, o = lax.scan(step, jnp.zeros((b, h, dk, dv), F32), xs)
    return jnp.moveaxis(o, 0, 2).reshape(b, h, s, dv)


def gated_deltanet(p, conv_w, a_log, dt_bias, norm_w):
    b, s, _ = p.shape
    p = p.astype(F32)
    wd = DN_WIDTH
    qkv = jax.nn.silu(centred_depthwise_conv(p[..., :3 * wd], conv_w.astype(F32)))
    z = p[..., 3 * wd:4 * wd].reshape(b, s, DN_HEADS, DN_HEAD_DIM)
    a_in = p[..., 4 * wd:4 * wd + 2 * DN_HEADS].reshape(b, s, 2, DN_HEADS)
    b_in = p[..., 4 * wd + 2 * DN_HEADS:].reshape(b, s, 2, DN_HEADS)
    hd = lambda t: t.reshape(b, s, DN_HEADS, DN_HEAD_DIM)
    q = jnp.moveaxis(l2_normalize(hd(qkv[..., :wd])), 2, 1)
    k = jnp.moveaxis(l2_normalize(hd(qkv[..., wd:2 * wd])), 2, 1)
    v = jnp.moveaxis(hd(qkv[..., 2 * wd:]), 2, 1)
    g = -jnp.exp(a_log.astype(F32)) * jax.nn.softplus(a_in + dt_bias.astype(F32))
    g = jnp.moveaxis(g, 1, -1)
    beta = jnp.moveaxis(jax.nn.sigmoid(b_in), 1, -1)
    flip = lambda t: jnp.flip(t, axis=2)
    o_f = chunk_gated_delta_rule(q, k, v, g[:, 0], beta[:, 0])
    o_b = flip(chunk_gated_delta_rule(flip(q), flip(k), flip(v), flip(g[:, 1]), flip(beta[:, 1])))
    o = jnp.moveaxis(o_f + o_b, 1, 2)
    o = rms_norm(o, norm_w) * jax.nn.silu(z)
    return o.reshape(b, s, wd)


def s5_scan(u, a_re, a_im, log_dt, b_re, b_im, c_re, c_im, reverse):
    a_re, a_im, b_re, b_im, c_re, c_im = (t.astype(F32) for t in (a_re, a_im, b_re, b_im, c_re, c_im))
    dt = jnp.exp(log_dt.astype(F32))[:, None]
    mag = jnp.exp(a_re * dt)
    lb_re, lb_im = mag * jnp.cos(a_im * dt), mag * jnp.sin(a_im * dt)
    den = a_re * a_re + a_im * a_im
    nr, ni = lb_re - 1.0, lb_im
    f_re = (nr * a_re + ni * a_im) / den
    f_im = (ni * a_re - nr * a_im) / den
    bb_re = f_re[..., None] * b_re - f_im[..., None] * b_im
    bb_im = f_re[..., None] * b_im + f_im[..., None] * b_re
    bu_re = jnp.einsum('gph,bsgh->bsgp', bb_re, u)
    bu_im = jnp.einsum('gph,bsgh->bsgp', bb_im, u)
    shape = bu_re.shape
    elems = (jnp.broadcast_to(lb_re, shape), jnp.broadcast_to(lb_im, shape), bu_re, bu_im)

    def combine(e1, e2):
        a1r, a1i, b1r, b1i = e1
        a2r, a2i, b2r, b2i = e2
        return (a2r * a1r - a2i * a1i, a2r * a1i + a2i * a1r,
                a2r * b1r - a2i * b1i + b2r, a2r * b1i + a2i * b1r + b2i)

    _, _, x_re, x_im = lax.associative_scan(combine, elems, axis=1, reverse=reverse)
    return jnp.einsum('ghp,bsgp->bsgh', c_re, x_re) - jnp.einsum('ghp,bsgp->bsgh', c_im, x_im)


def s5_mixer(p, a_re, a_im, log_dt, b_re, b_im, c_re, c_im, d_skip, glu_w, glu_b):
    bsz, s, _ = p.shape
    u = p.astype(F32)
    ug = u.reshape(bsz, s, S5_GROUPS, S5_GROUP)
    y = d_skip.astype(F32) * u
    for direction in range(2):
        y = y + s5_scan(ug, a_re[direction], a_im[direction], log_dt[direction], b_re[direction],
                        b_im[direction], c_re[direction], c_im[direction],
                        reverse=(direction == 1)).reshape(bsz, s, S5_WIDTH)
    y = jax.nn.gelu(y)
    return y * jax.nn.sigmoid(y @ glu_w.astype(F32) + glu_b.astype(F32))


def rwkv7_scan(r, w, k, v, kk, a, reverse):
    b, s, h, n = r.shape
    xs = tuple(jnp.moveaxis(t, 1, 0) for t in (r, w, k, v, -kk, kk * a))

    def step(state, xt):
        r_t, w_t, k_t, v_t, ka_t, kb_t = xt
        sa = jnp.einsum('bhvk,bhk->bhv', state, ka_t)
        state = (state * w_t[:, :, None, :] + sa[..., None] * kb_t[:, :, None, :]
                 + v_t[..., None] * k_t[:, :, None, :])
        return state, jnp.einsum('bhvk,bhk->bhv', state, r_t)

    _, y = lax.scan(step, jnp.zeros((b, h, n, n), F32), xs, reverse=reverse)
    return jnp.moveaxis(y, 0, 1)


def rwkv7_mixer(p, mu, w0, w2, a0, a2, g2, k_k, k_a, r_k, ln_w, ln_b):
    b, s, _ = p.shape
    pf = p.astype(F32)
    zero = jnp.zeros_like(pf[:, :1])
    neigh = 0.5 * (jnp.concatenate([zero, pf[:, :-1]], 1) + jnp.concatenate([pf[:, 1:], zero], 1))
    pf = pf + mu.astype(F32) * (neigh - pf)
    n = RW_WIDTH
    r, k, v = pf[..., :n], pf[..., n:2 * n], pf[..., 2 * n:3 * n]
    o = 3 * n
    w_lo = pf[..., o:o + 2 * RW_DECAY_LORA].reshape(b, s, 2, RW_DECAY_LORA)
    o += 2 * RW_DECAY_LORA
    a_lo = pf[..., o:o + 2 * RW_AAA_LORA].reshape(b, s, 2, RW_AAA_LORA)
    o += 2 * RW_AAA_LORA
    g_lo = pf[..., o:]
    w = -jax.nn.softplus(-(w0.astype(F32) + jnp.einsum('bsdr,drc->bsdc', jnp.tanh(w_lo), w2.astype(F32)))) - 0.5
    decay = jnp.exp(-jnp.exp(w))
    a = jax.nn.sigmoid(a0.astype(F32) + jnp.einsum('bsdr,drc->bsdc', a_lo, a2.astype(F32)))
    g = jax.nn.sigmoid(g_lo) @ g2.astype(F32)
    hd = lambda t: t.reshape(*t.shape[:-1], RW_HEADS, RW_HEAD_DIM)
    kk = l2_normalize(hd(k * k_k.astype(F32)))
    k_dir = k[:, :, None, :] * (1.0 + (a - 1.0) * k_a.astype(F32))
    rh, vh = hd(r), hd(v)
    y = (rwkv7_scan(rh, hd(decay[:, :, 0]), hd(k_dir[:, :, 0]), vh, kk, hd(a[:, :, 0]), False)
         + rwkv7_scan(rh, hd(decay[:, :, 1]), hd(k_dir[:, :, 1]), vh, kk, hd(a[:, :, 1]), True))
    mean = jnp.mean(y, axis=-1, keepdims=True)
    var = jnp.mean(jnp.square(y - mean), axis=-1, keepdims=True)
    y = (y - mean) * lax.rsqrt(var + RW_GN_EPS) * hd(ln_w.astype(F32)) + hd(ln_b.astype(F32))
    k_bonus = hd(jnp.mean(k_dir, axis=2))
    y = y + jnp.sum(rh * k_bonus * r_k.astype(F32), axis=-1, keepdims=True) * vh
    return y.reshape(b, s, n) * g


def alibi_slopes(n_heads):
    return jnp.asarray(2.0 ** (-8.0 * np.arange(1, n_heads + 1) / n_heads), dtype=F32)


def diff_attention(p, lam_params, subln_w, lambda_init):
    b, s, _ = p.shape
    pf = p.astype(F32)
    q = pf[..., :DF_WIDTH].reshape(b, s, DF_HEADS, 2, DF_HEAD_DIM) * DF_HEAD_DIM ** -0.5
    k = pf[..., DF_WIDTH:2 * DF_WIDTH].reshape(b, s, DF_HEADS, 2, DF_HEAD_DIM)
    v = pf[..., 2 * DF_WIDTH:].reshape(b, s, DF_HEADS, 2 * DF_HEAD_DIM)
    lp = lam_params.astype(F32)
    lam = jnp.exp(jnp.sum(lp[0] * lp[1])) - jnp.exp(jnp.sum(lp[2] * lp[3])) + lambda_init
    slopes = alibi_slopes(DF_HEADS)
    pos = jnp.arange(s)
    nb = s // DF_Q_BLOCK
    q_blocks = jnp.moveaxis(q.reshape(b, nb, DF_Q_BLOCK, DF_HEADS, 2, DF_HEAD_DIM), 1, 0)
    starts = jnp.arange(nb) * DF_Q_BLOCK

    def block(args):
        qb, q0 = args
        scores = jnp.einsum('bqhmd,bkhmd->bhmqk', qb, k)
        dist = jnp.abs((q0 + jnp.arange(DF_Q_BLOCK))[:, None] - pos[None, :]).astype(F32)
        scores = scores - slopes[:, None, None, None] * dist
        probs = jax.nn.softmax(scores, axis=-1)
        attn = probs[:, :, 0] - lam * probs[:, :, 1]
        return jnp.einsum('bhqk,bkhd->bqhd', attn, v)

    o = lax.map(block, (q_blocks, starts))
    o = jnp.moveaxis(o, 0, 1).reshape(b, s, DF_HEADS, 2 * DF_HEAD_DIM)
    o = rms_norm(o, subln_w, eps=1e-5) * (1.0 - lambda_init)
    return o.reshape(b, s, DF_WIDTH)


def expert_choice_ffn(h, router_w, w_gate, w_up, w_down):
    b, s, d = h.shape
    cap = EC_CAPACITY_FACTOR * s // N_EXPERTS
    probs = jax.nn.softmax((h @ router_w).astype(F32), axis=-1)
    gate, idx = lax.top_k(jnp.swapaxes(probs, 1, 2), cap)
    xin = jax.vmap(lambda hb, ib: hb[ib])(h, idx)
    hid = jax.nn.silu(jnp.einsum('becd,edf->becf', xin, w_gate)) * jnp.einsum('becd,edf->becf', xin, w_up)
    out = jnp.einsum('becf,efd->becd', hid, w_down) * gate[..., None].astype(h.dtype)
    bidx = jnp.arange(b)[:, None, None]
    return jnp.zeros_like(h).at[bidx, idx].add(out)


def setup_inputs(seed: int = 0) -> dict:
    key = jax.random.key(seed)
    ks = iter(jax.random.split(key, 48))
    nl, ne, no = DEPTH, (DEPTH + 1) // 2, DEPTH // 2
    d = D_MODEL

    def nrm(shape, scale=1.0):
        return jax.random.normal(next(ks), shape, F32) * scale

    def unif(shape, lo, hi):
        return jax.random.uniform(next(ks), shape, F32, lo, hi)

    dn_dt = jnp.exp(unif((ne, 2, DN_HEADS), math.log(1e-3), math.log(1e-1)))
    s5_n = jnp.arange(S5_STATE, dtype=F32)
    return {
        'x': nrm((BATCH, SEQ, d)),
        'c': nrm((BATCH, d)),
        'ada_w': nrm((nl, d, 6 * d), 0.5 * d ** -0.5),
        'ada_b': nrm((nl, 6 * d), 0.02),
        'norm_mix_pre': 1.0 + nrm((nl, d), 0.05),
        'norm_mix_post': 1.0 + nrm((nl, d), 0.05),
        'norm_ffn_pre': 1.0 + nrm((nl, d), 0.05),
        'norm_ffn_post': 1.0 + nrm((nl, d), 0.05),
        'router_w': nrm((nl, d, N_EXPERTS), d ** -0.5),
        'exp_w_gate': nrm((nl, N_EXPERTS, d, D_EXPERT), d ** -0.5),
        'exp_w_up': nrm((nl, N_EXPERTS, d, D_EXPERT), d ** -0.5),
        'exp_w_down': nrm((nl, N_EXPERTS, D_EXPERT, d), D_EXPERT ** -0.5),
        'ab_w_in': nrm((ne, d, AB_IN), d ** -0.5),
        'ab_w_out': nrm((ne, MIX_WIDTH, d), MIX_WIDTH ** -0.5),
        'dn_conv': nrm((ne, DN_CONV, 3 * DN_WIDTH), DN_CONV ** -0.5),
        'dn_a_log': jnp.log(unif((ne, 2, DN_HEADS), 1.0, 16.0)),
        'dn_dt_bias': dn_dt + jnp.log(-jnp.expm1(-dn_dt)),
        'dn_norm': 1.0 + nrm((ne, DN_HEAD_DIM), 0.05),
        's5_a_re': -0.5 + nrm((ne, 2, S5_GROUPS, S5_STATE), 0.01),
        's5_a_im': jnp.pi * s5_n + nrm((ne, 2, S5_GROUPS, S5_STATE), 0.01),
        's5_log_dt': unif((ne, 2, S5_GROUPS), math.log(1e-3), math.log(1e-1)),
        's5_b_re': nrm((ne, 2, S5_GROUPS, S5_STATE, S5_GROUP), (2 * S5_GROUP) ** -0.5),
        's5_b_im': nrm((ne, 2, S5_GROUPS, S5_STATE, S5_GROUP), (2 * S5_GROUP) ** -0.5),
        's5_c_re': nrm((ne, 2, S5_GROUPS, S5_GROUP, S5_STATE), S5_STATE ** -0.5),
        's5_c_im': nrm((ne, 2, S5_GROUPS, S5_GROUP, S5_STATE), S5_STATE ** -0.5),
        's5_d': nrm((ne, S5_WIDTH)),
        's5_glu_w': nrm((ne, S5_WIDTH, S5_WIDTH), S5_WIDTH ** -0.5),
        's5_glu_b': nrm((ne, S5_WIDTH), 0.02),
        'cd_w_in': nrm((no, d, CD_IN), d ** -0.5),
        'cd_w_out': nrm((no, MIX_WIDTH, d), MIX_WIDTH ** -0.5),
        'rw_mu': unif((no, RW_IN), 0.0, 1.0),
        'rw_w0': unif((no, 2, RW_WIDTH), -6.5, -1.5),
        'rw_w2': nrm((no, 2, RW_DECAY_LORA, RW_WIDTH), 0.5 * RW_DECAY_LORA ** -0.5),
        'rw_a0': nrm((no, 2, RW_WIDTH), 0.1),
        'rw_a2': nrm((no, 2, RW_AAA_LORA, RW_WIDTH), 0.5 * RW_AAA_LORA ** -0.5),
        'rw_g2': nrm((no, RW_GATE_LORA, RW_WIDTH), RW_GATE_LORA ** -0.5),
        'rw_k_k': 0.85 + nrm((no, RW_WIDTH), 0.05),
        'rw_k_a': 1.0 + nrm((no, RW_WIDTH), 0.05),
        'rw_r_k': nrm((no, RW_HEADS, RW_HEAD_DIM), 0.1),
        'rw_ln_w': 1.0 + nrm((no, RW_WIDTH), 0.05),
        'rw_ln_b': nrm((no, RW_WIDTH), 0.02),
        'df_lambda': nrm((no, 4, DF_HEAD_DIM), 0.1),
        'df_subln': 1.0 + nrm((no, 2 * DF_HEAD_DIM), 0.05),
    }


def reference(x, c, ada_w, ada_b, norm_mix_pre, norm_mix_post, norm_ffn_pre, norm_ffn_post,
              router_w, exp_w_gate, exp_w_up, exp_w_down,
              ab_w_in, ab_w_out, dn_conv, dn_a_log, dn_dt_bias, dn_norm,
              s5_a_re, s5_a_im, s5_log_dt, s5_b_re, s5_b_im, s5_c_re, s5_c_im, s5_d, s5_glu_w, s5_glu_b,
              cd_w_in, cd_w_out, rw_mu, rw_w0, rw_w2, rw_a0, rw_a2, rw_g2, rw_k_k, rw_k_a, rw_r_k,
              rw_ln_w, rw_ln_b, df_lambda, df_subln):
    for layer in range(DEPTH):
        mod = jax.nn.silu(c) @ ada_w[layer] + ada_b[layer]
        sh1, sc1, g1, sh2, sc2, g2 = jnp.split(mod[:, None, :], 6, axis=-1)
        h = rms_norm(x, norm_mix_pre[layer]) * (1.0 + sc1) + sh1
        if layer % 2 == 0:
            i = layer // 2
            p = h @ ab_w_in[i]
            ya = gated_deltanet(p[..., :DN_IN], dn_conv[i], dn_a_log[i], dn_dt_bias[i], dn_norm[i])
            yb = s5_mixer(p[..., DN_IN:], s5_a_re[i], s5_a_im[i], s5_log_dt[i], s5_b_re[i], s5_b_im[i],
                          s5_c_re[i], s5_c_im[i], s5_d[i], s5_glu_w[i], s5_glu_b[i])
            y = jnp.concatenate([ya, yb], axis=-1).astype(h.dtype) @ ab_w_out[i]
        else:
            i = layer // 2
            lambda_init = 0.8 - 0.6 * math.exp(-0.3 * layer)
            p = h @ cd_w_in[i]
            yc = rwkv7_mixer(p[..., :RW_IN], rw_mu[i], rw_w0[i], rw_w2[i], rw_a0[i], rw_a2[i], rw_g2[i],
                             rw_k_k[i], rw_k_a[i], rw_r_k[i], rw_ln_w[i], rw_ln_b[i])
            yd = diff_attention(p[..., RW_IN:], df_lambda[i], df_subln[i], lambda_init)
            y = jnp.concatenate([yc, yd], axis=-1).astype(h.dtype) @ cd_w_out[i]
        x = x + g1 * rms_norm(y, norm_mix_post[layer])
        h = rms_norm(x, norm_ffn_pre[layer]) * (1.0 + sc2) + sh2
        y = expert_choice_ffn(h, router_w[layer], exp_w_gate[layer], exp_w_up[layer], exp_w_down[layer])
        x = x + g2 * rms_norm(y, norm_ffn_post[layer])
    return x
```

```cpp
#include <hip/hip_runtime.h>
#include <stdint.h>
#include <stdio.h>

#define LAS __attribute__((address_space(3)))
typedef unsigned short bf16_t;
typedef short bf16x8 __attribute__((ext_vector_type(8)));
typedef short bf16x4 __attribute__((ext_vector_type(4)));
typedef float f32x4 __attribute__((ext_vector_type(4)));
typedef float f32x16 __attribute__((ext_vector_type(16)));
typedef unsigned u32x4 __attribute__((ext_vector_type(4)));
typedef unsigned u32x2 __attribute__((ext_vector_type(2)));

constexpr int T_ = 16384, D_ = 1024, B_ = 4, S_ = 4096, E_ = 16, CAP_ = 512, F_ = 2816;
constexpr int NTHR = 512;
constexpr int LDS_MAIN = 131072;
constexpr int LDS_BYTES = LDS_MAIN + 64;

constexpr size_t al256(size_t x) { return (x + 255) & ~(size_t)255; }
constexpr size_t OFF_BAR    = 0;
constexpr size_t OFF_MOD    = 16384;
constexpr size_t OFF_WIN0T  = OFF_MOD    + al256((size_t)2 * 4 * 6144 * 4);
constexpr size_t OFF_WGLUT  = OFF_WIN0T  + (size_t)2560 * 1024 * 2;
constexpr size_t OFF_WOUT0T = OFF_WGLUT  + (size_t)512 * 512 * 2;
constexpr size_t OFF_WIN1T  = OFF_WOUT0T + (size_t)1024 * 1024 * 2;
constexpr size_t OFF_WVT    = OFF_WIN1T  + (size_t)3072 * 1024 * 2;
constexpr size_t OFF_WOUT1T = OFF_WVT    + (size_t)512 * 1024 * 2;
constexpr size_t OFF_WLORAT = OFF_WOUT1T + (size_t)1024 * 1024 * 2;
constexpr size_t OFF_W1T    = OFF_WLORAT + (size_t)2560 * 384 * 2;
constexpr size_t W1T_LAYER  = (size_t)16 * 5632 * 1024 * 2;
constexpr size_t OFF_W2T    = OFF_W1T    + 2 * W1T_LAYER;
constexpr size_t W2T_LAYER  = (size_t)16 * 1024 * 2816 * 2;
constexpr size_t OFF_HB     = OFF_W2T    + 2 * W2T_LAYER;
constexpr size_t OFF_XA     = OFF_HB     + (size_t)T_ * 1024 * 2;
constexpr size_t OFF_XB     = OFF_XA     + (size_t)T_ * 1024 * 4;
constexpr size_t OFF_YMIX   = OFF_XB     + (size_t)T_ * 1024 * 4;
constexpr size_t OFF_YCAT   = OFF_YMIX   + (size_t)T_ * 1024 * 4;
constexpr size_t OFF_PROBS  = OFF_YCAT   + (size_t)T_ * 1024 * 2;
constexpr size_t OFF_ROWTOK = OFF_PROBS  + (size_t)4 * 16 * 4096 * 4;
constexpr size_t OFF_GATEV  = OFF_ROWTOK + (size_t)32768 * 4;
constexpr size_t OFF_SLOT   = OFF_GATEV  + (size_t)32768 * 4;
constexpr size_t OFF_SCR    = OFF_SLOT   + (size_t)T_ * 16 * 4;
constexpr size_t OFF_P0     = OFF_SCR;
constexpr size_t OFF_GB0    = OFF_P0     + (size_t)T_ * 2560 * 2;
constexpr size_t OFF_QKVN   = OFF_GB0    + (size_t)T_ * 16 * 4;
constexpr size_t OFF_DNO    = OFF_QKVN   + (size_t)T_ * 1536 * 4;
constexpr size_t OFF_S5Y    = OFF_DNO    + (size_t)2 * T_ * 512 * 4;
constexpr size_t OFF_YS5    = OFF_S5Y    + (size_t)2 * T_ * 512 * 4;
constexpr size_t END_L0     = OFF_YS5    + (size_t)T_ * 512 * 2;
constexpr size_t OFF_HBUF   = OFF_SCR;
constexpr size_t OFF_YBUF   = OFF_HBUF   + (size_t)32768 * 2816 * 2;
constexpr size_t END_MOE    = OFF_YBUF   + (size_t)32768 * 1024 * 2;
constexpr size_t OFF_P1     = OFF_SCR;
constexpr size_t OFF_VIMG   = OFF_P1     + (size_t)T_ * 3072 * 2;
constexpr size_t OFF_RWR    = OFF_VIMG   + (size_t)512 * T_ * 2;
constexpr size_t OFF_RWK    = OFF_RWR    + (size_t)T_ * 512 * 4;
constexpr size_t OFF_RWV    = OFF_RWK    + (size_t)T_ * 512 * 4;
constexpr size_t OFF_RWKK   = OFF_RWV    + (size_t)T_ * 512 * 4;
constexpr size_t OFF_LORAIN = OFF_RWKK   + (size_t)T_ * 512 * 4;
constexpr size_t OFF_RWDEC  = OFF_LORAIN + (size_t)T_ * 384 * 2;
constexpr size_t OFF_RWA    = OFF_RWDEC  + (size_t)2 * T_ * 512 * 4;
constexpr size_t OFF_RWG    = OFF_RWA    + (size_t)2 * T_ * 512 * 4;
constexpr size_t OFF_RWY    = OFF_RWG    + (size_t)T_ * 512 * 4;
constexpr size_t END_L1     = OFF_RWY    + (size_t)2 * T_ * 512 * 4;
constexpr size_t WS_NEED    = END_L1 > END_L0 ? (END_L1 > END_MOE ? END_L1 : END_MOE) : (END_L0 > END_MOE ? END_L0 : END_MOE);
static_assert(WS_NEED < (size_t)1470000000, "workspace budget");

struct Args { const float* in[43]; float* out; unsigned char* ws; int ph_lo, ph_hi; };

enum { I_X = 0, I_C, I_ADA_W, I_ADA_B, I_NMIX_PRE, I_NMIX_POST, I_NFFN_PRE, I_NFFN_POST, I_ROUTER, I_WGATE, I_WUP, I_WDOWN,
       I_AB_IN, I_AB_OUT, I_DN_CONV, I_DN_ALOG, I_DN_DTB, I_DN_NORM, I_S5_ARE, I_S5_AIM, I_S5_LDT, I_S5_BRE, I_S5_BIM, I_S5_CRE, I_S5_CIM,
       I_S5_D, I_S5_GLUW, I_S5_GLUB, I_CD_IN, I_CD_OUT, I_RW_MU, I_RW_W0, I_RW_W2, I_RW_A0, I_RW_A2, I_RW_G2, I_RW_KK, I_RW_KA, I_RW_RK,
       I_RW_LNW, I_RW_LNB, I_DF_LAM, I_DF_SUBLN };

__device__ __forceinline__ bf16_t f2bf(float f) { unsigned u = __float_as_uint(f); u += 0x7FFFu + ((u >> 16) & 1u); return (bf16_t)(u >> 16); }
__device__ __forceinline__ float bf2f(bf16_t b) { return __uint_as_float(((unsigned)b) << 16); }
__device__ __forceinline__ unsigned pk2(float lo, float hi) { return (unsigned)f2bf(lo) | ((unsigned)f2bf(hi) << 16); }
__device__ __forceinline__ float bflo(unsigned u) { return __uint_as_float(u << 16); }
__device__ __forceinline__ float bfhi(unsigned u) { return __uint_as_float(u & 0xFFFF0000u); }
__device__ __forceinline__ float wave_sum(float v) {
#pragma unroll
    for (int o = 32; o; o >>= 1) v += __shfl_xor(v, o);
    return v;
}
__device__ __forceinline__ float sigmoidf_(float x) { return 1.f / (1.f + __expf(-x)); }
__device__ __forceinline__ float siluf_(float x) { return x / (1.f + __expf(-x)); }
__device__ __forceinline__ float softplusf_(float x) { return fmaxf(x, 0.f) + __logf(1.f + __expf(-fabsf(x))); }
__device__ __forceinline__ float gelu_tanhf_(float x) { const float u = 0.7978845608028654f * (x + 0.044715f * x * x * x); const float t = 2.f / (1.f + __expf(-2.f * u)) - 1.f; return 0.5f * x * (1.f + t); }
template <int CTRL> __device__ __forceinline__ float dppf(float x) { return __int_as_float(__builtin_amdgcn_update_dpp(0, __float_as_int(x), CTRL, 0xF, 0xF, true)); }
__device__ __forceinline__ float row16_sum(float x) { x += dppf<0x128>(x); x += dppf<0x124>(x); x += dppf<0x122>(x); x += dppf<0x121>(x); return x; }

#define XB_TMO      128
#define XB_XCNT(j)  (256  + 64 * (j))
#define XB_XSUB(j)  (1280 + 64 * (j))
#define XB_XGEN(j)  (2304 + 64 * (j))
#define XB_TOP      3328
#define XB_TOPGEN   3392
#define XCD_BAR_WORDS 3456
#define XB_SPIN_CAP (1u << 27)
__device__ __forceinline__ unsigned xb_ld(unsigned* p)              { return __hip_atomic_load(p, __ATOMIC_RELAXED, __HIP_MEMORY_SCOPE_AGENT); }
__device__ __forceinline__ unsigned xb_add(unsigned* p, unsigned v) { return __hip_atomic_fetch_add(p, v, __ATOMIC_RELAXED, __HIP_MEMORY_SCOPE_AGENT); }
__device__ __forceinline__ unsigned xb_xcc_id() { return (unsigned)__builtin_amdgcn_s_getreg((3 << 11) | 20) & 0xFu; }
#define XB_SPIN(cond, bar) do { unsigned _sp = 0; while (cond) { __builtin_amdgcn_s_sleep(1); \
    if ((++_sp & 255u) == 0u) { if (xb_ld(&(bar)[XB_TMO])) break; if (_sp > XB_SPIN_CAP) { atomicAdd(&(bar)[XB_TMO], 1u); break; } } } } while (0)
struct XcdBarrier { unsigned* bar; unsigned x; volatile LAS unsigned* st; };
__device__ __forceinline__ int my_lane() { return (int)__builtin_amdgcn_mbcnt_hi(~0u, __builtin_amdgcn_mbcnt_lo(~0u, 0u)); }
__device__ __forceinline__ XcdBarrier xcd_barrier_post(unsigned* bar, volatile LAS unsigned* st, int tid) {
    XcdBarrier b; b.bar = bar; b.x = xb_xcc_id(); b.st = st;
    if (tid == 0) (void)xb_add(&bar[XB_XCNT(b.x)], 1u);
    return b;
}
__device__ __forceinline__ void xcd_barrier_complete(unsigned* bar, unsigned x, unsigned& nloc, unsigned& nx) {
    const unsigned G = gridDim.x * gridDim.y * gridDim.z;
    unsigned sum, cnt, mine, sp = 0u;
    for (;;) {
        sum = 0u; cnt = 0u; mine = 0u;
#pragma unroll
        for (unsigned j = 0; j < 16; ++j) { const unsigned c = xb_ld(&bar[XB_XCNT(j)]); sum += c; cnt += (c > 0u) ? 1u : 0u; mine = (j == x) ? c : mine; }
        if (sum == G) break;
        __builtin_amdgcn_s_sleep(1);
        if ((++sp & 255u) == 0u) { if (xb_ld(&bar[XB_TMO])) break; if (sp > XB_SPIN_CAP) { atomicAdd(&bar[XB_TMO], 1u); break; } }
    }
    nloc = mine > 0u ? mine : 1u; nx = cnt > 0u ? cnt : 1u;
}
__device__ __forceinline__ void xcd_barrier(const XcdBarrier& b, int tid) {
    asm volatile("s_waitcnt vmcnt(0)" ::: "memory");
    __syncthreads();
    if (tid == 0) {
        unsigned* bar = b.bar;
        __builtin_amdgcn_s_waitcnt(0);
        unsigned nloc = b.st[0], nx = b.st[1];
        if (nloc == 0u) { xcd_barrier_complete(bar, b.x, nloc, nx); b.st[0] = nloc; b.st[1] = nx; }
        const unsigned old = xb_add(&bar[XB_XSUB(b.x)], 1u);
        const unsigned gen = old / nloc;
        if (old + 1u == (gen + 1u) * nloc) {
            __builtin_amdgcn_fence(__ATOMIC_RELEASE, "agent");
            asm volatile("s_waitcnt vmcnt(0)" ::: "memory");
            const unsigned og = xb_add(&bar[XB_TOP], 1u);
            const unsigned tg = og / nx;
            if (og + 1u == (tg + 1u) * nx) xb_add(&bar[XB_TOPGEN], 1u);
            else XB_SPIN(xb_ld(&bar[XB_TOPGEN]) == tg, bar);
            __builtin_amdgcn_fence(__ATOMIC_ACQUIRE, "agent");
            xb_add(&bar[XB_XGEN(b.x)], 1u);
            asm volatile("s_waitcnt vmcnt(0)" ::: "memory");
        } else {
            XB_SPIN(xb_ld(&bar[XB_XGEN(b.x)]) == gen, bar);
            __builtin_amdgcn_fence(__ATOMIC_ACQUIRE, "agent");
            asm volatile("s_waitcnt vmcnt(0)" ::: "memory");
        }
    }
    __syncthreads();
}

namespace pg8 {
constexpr int BM = 256, BK = 64, HALF = 128, HTB = HALF * BK * 2, STAGE_BYTES = 8 * HTB, NXCD = 8, WGM = 8;
__host__ __device__ __forceinline__ int lds_byte(int r, int c) { const int st = (r >> 4) * 2 + (c >> 5), rr = r & 15, cc = c & 31, ob = rr * 64 + cc * 2; return st * 1024 + (ob ^ (((ob >> 9) & 1) << 5)); }
__host__ __device__ __forceinline__ void stage_rc(int b, int& R, int& C) { const int st = b / 1024, sb = b % 1024, swz = sb ^ (((sb >> 9) & 1) << 5); R = (st >> 1) * 16 + swz / 64; C = (st & 1) * 32 + (swz % 64) / 2; }
__host__ __device__ __forceinline__ int perm32(int rho) { const int n = rho >> 4, i = rho & 15; return 8 * (i >> 2) + 4 * n + (i & 3); }
struct Unit { int pm, pn; };
struct Gemm { const bf16_t* A; const bf16_t* Bt; int lda, ldb, K; const int* rowidx; };

struct StaticOrder {
    int nM, nN, nwg, G, c;
    __device__ void init(int M, int N, int G_, int c_) { nM = M / BM; nN = N / BM; nwg = nM * nN; G = G_; c = c_; }
    __device__ bool next(int i, Unit& u) const {
        const long L = (long)i * G + c; if (L >= nwg) return false;
        int wgid = (int)L; { const int q = nwg / NXCD, r = nwg % NXCD, xcd = wgid % NXCD, off = wgid / NXCD; wgid = (xcd < r ? xcd * (q + 1) : r * (q + 1) + (xcd - r) * q) + off; }
        const int nig = WGM * nN, gid = wgid / nig, fm = gid * WGM, gsz = (nM - fm) < WGM ? (nM - fm) : WGM;
        u.pm = fm + ((wgid % nig) % gsz); u.pn = (wgid % nig) / gsz; return true;
    }
};
struct MoeOrder {
    int per_e, npn, G, c;
    __device__ bool next(int i, Unit& u) const {
        const int nwg = 16 * per_e; const long L = (long)i * G + c; if (L >= nwg) return false;
        int wgid = (int)L; { const int q = nwg / NXCD, xcd = wgid % NXCD, off = wgid / NXCD; wgid = xcd * q + off; }
        const int e = wgid / per_e, r = wgid % per_e; u.pm = e * 8 + (r & 7); u.pn = e * npn + (r >> 3); return true;
    }
};

__device__ __forceinline__ unsigned cvt_pk_bf16(float lo, float hi) { unsigned r; asm volatile("v_cvt_pk_bf16_f32 %0, %1, %2" : "=v"(r) : "v"(lo), "v"(hi)); return r; }

template <class Epi, class Sched, bool GATHER>
__device__ __forceinline__ void gemm_phase(LAS unsigned char* lds, const Gemm g, const Sched& S, const Epi& E, int tid_) {
    const int tid = tid_, wid = __builtin_amdgcn_readfirstlane(tid >> 6), lane = tid & 63, wr = wid >> 2, wc = wid & 3, fr = lane & 15, fq = lane >> 4;
    const int K = g.K, nt = K / BK;
    int Rr[2], Cc[2]; unsigned voffA[2], voffB[2];
#pragma unroll
    for (int i = 0; i < 2; ++i) { int R, C; stage_rc(tid * 16 + i * 8192, R, C); const int Rb = Epi::PERM ? ((R & ~31) + perm32(R & 31)) : R;
        Rr[i] = R; Cc[i] = C; voffA[i] = (unsigned)(R * g.lda + C) * 2u; voffB[i] = (unsigned)(Rb * g.ldb + C) * 2u; }
    const size_t kstep = (size_t)(BK * 2);
    const size_t hstepA = (size_t)HALF * g.lda * 2, tstepA = 2 * hstepA;
    const size_t hstepB = (size_t)HALF * g.ldb * 2, tstepB = 2 * hstepB;
    const unsigned ldsw = (unsigned)wid * 1024u;
    const int aoff = lds_byte(wr * 64 + fr, fq * 8), boff = lds_byte(wc * 32 + fr, fq * 8);
    const unsigned lda2 = (unsigned)g.lda * 2u;
#define PG8_AOFF(vo, pm_) do { _Pragma("unroll") for (int _h = 0; _h < 2; ++_h) _Pragma("unroll") for (int _i = 0; _i < 2; ++_i) { const int _row = (pm_) * 256 + _h * 128 + Rr[_i]; \
        (vo)[_h][_i] = (unsigned)g.rowidx[_row] * lda2 + (unsigned)Cc[_i] * 2u; } } while (0)
#define PG8_SA(b, h) (((b) * 2 + (h)) * HTB)
#define PG8_SB(b, h) ((4 + (b) * 2 + (h)) * HTB)
#define PG8_STAGE_B(bufoff, gbase) do { _Pragma("unroll") for (int _i = 0; _i < 2; ++_i) \
        __builtin_amdgcn_global_load_lds((const unsigned*)((const char*)(gbase) + voffB[_i]), (LAS unsigned*)(lds + (bufoff) + ldsw + _i * 8192), 16, 0, 0); } while (0)
#define PG8_STAGE_A(bufoff, uptr, voh, kb) do { _Pragma("unroll") for (int _i = 0; _i < 2; ++_i) { \
        const char* _p = GATHER ? ((const char*)g.A + (size_t)(voh)[_i] + (kb)) : ((const char*)(uptr) + voffA[_i]); \
        __builtin_amdgcn_global_load_lds((const unsigned*)_p, (LAS unsigned*)(lds + (bufoff) + ldsw + _i * 8192), 16, 0, 0); } } while (0)
#define PG8_LDA(dst, b, h) do { _Pragma("unroll") for (int m = 0; m < 4; ++m) _Pragma("unroll") for (int k = 0; k < 2; ++k) dst[m][k] = *(const LAS bf16x8*)(lds + PG8_SA(b, h) + aoff + m * 2048 + k * 1024); } while (0)
#define PG8_LDB(dst, b, h) do { _Pragma("unroll") for (int n = 0; n < 2; ++n) _Pragma("unroll") for (int k = 0; k < 2; ++k) dst[n][k] = *(const LAS bf16x8*)(lds + PG8_SB(b, h) + boff + n * 2048 + k * 1024); } while (0)
#define PG8_MMA(ai, bj, At, Bt) do { __builtin_amdgcn_s_setprio(1); _Pragma("unroll") for (int m = 0; m < 4; ++m) _Pragma("unroll") for (int n = 0; n < 2; ++n) _Pragma("unroll") for (int k = 0; k < 2; ++k) \
        acc[ai][bj][m][n] = __builtin_amdgcn_mfma_f32_16x16x32_bf16(Bt[n][k], At[m][k], acc[ai][bj][m][n], 0, 0, 0); __builtin_amdgcn_s_setprio(0); } while (0)
#define PG8_WAIT_V(n) asm volatile("s_waitcnt vmcnt(" #n ")" ::: "memory")
#define PG8_WAIT_L(n) asm volatile("s_waitcnt lgkmcnt(" #n ")" ::: "memory")
#define PG8_BAR __builtin_amdgcn_s_barrier()
#define PG8_SCHED __builtin_amdgcn_sched_barrier(0)
    Unit cur, nxt; int ui = 0;
    if (!S.next(0, cur)) return;
    f32x4 acc[2][2][4][2];
#pragma unroll
    for (int a = 0; a < 2; ++a)
#pragma unroll
        for (int b = 0; b < 2; ++b)
#pragma unroll
            for (int m = 0; m < 4; ++m)
#pragma unroll
                for (int n = 0; n < 2; ++n) acc[a][b][m][n] = (f32x4){0.f, 0.f, 0.f, 0.f};
    bf16x8 At[4][2], B0[2][2], B1[2][2];
    unsigned vcur[2][2], vnxt[2][2];
    if (GATHER) { PG8_AOFF(vcur, cur.pm); }
    else {
#pragma unroll
        for (int h = 0; h < 2; ++h)
#pragma unroll
            for (int i = 0; i < 2; ++i) vcur[h][i] = 0u; }
    const char* cA = (const char*)g.A + (GATHER ? (size_t)0 : (size_t)cur.pm * tstepA);
    const char* cB = (const char*)g.Bt + (size_t)cur.pn * tstepB;
    PG8_STAGE_B(PG8_SB(0, 0), cB); PG8_STAGE_A(PG8_SA(0, 0), cA, vcur[0], 0); PG8_STAGE_B(PG8_SB(0, 1), cB + hstepB); PG8_STAGE_A(PG8_SA(0, 1), cA + hstepA, vcur[1], 0);
    if (wr == 1) PG8_BAR;
    PG8_WAIT_V(4); PG8_BAR;
    PG8_STAGE_B(PG8_SB(1, 0), cB + kstep); PG8_STAGE_A(PG8_SA(1, 0), cA + kstep, vcur[0], kstep); PG8_STAGE_B(PG8_SB(1, 1), cB + hstepB + kstep);
    PG8_WAIT_V(6); PG8_BAR;
    for (;;) {
        const bool has_next = S.next(ui + 1, nxt);
        if (GATHER) {
            if (has_next) { PG8_AOFF(vnxt, nxt.pm); }
            else {
#pragma unroll
                for (int h = 0; h < 2; ++h)
#pragma unroll
                    for (int i = 0; i < 2; ++i) vnxt[h][i] = vcur[h][i]; } }
        const char* nA = (has_next && !GATHER) ? (const char*)g.A + (size_t)nxt.pm * tstepA : cA;
        const char* nB = has_next ? (const char*)g.Bt + (size_t)nxt.pn * tstepB : cB;
        for (int t = 0; t < nt; t += 2) {
            const bool last = (t == nt - 2);
            const size_t kb1 = (size_t)(t + 1) * kstep;
            const size_t kb2 = last ? (size_t)0 : (size_t)(t + 2) * kstep, kb3 = kb2 + kstep;
            unsigned va2[2][2];
#pragma unroll
            for (int h = 0; h < 2; ++h)
#pragma unroll
                for (int i = 0; i < 2; ++i) va2[h][i] = (GATHER && last) ? vnxt[h][i] : vcur[h][i];
            const char* a1 = cA + kb1;
            const char* a2 = last ? nA : cA + kb2; const char* a3 = a2 + kstep;
            const char* b2 = last ? nB : cB + (size_t)(t + 2) * kstep; const char* b3 = b2 + kstep;
            PG8_LDB(B0, 0, 0); PG8_SCHED; PG8_LDA(At, 0, 0); PG8_STAGE_A(PG8_SA(1, 1), a1 + hstepA, vcur[1], kb1);
            PG8_WAIT_L(8); PG8_BAR; PG8_WAIT_L(0); PG8_MMA(0, 0, At, B0); PG8_BAR; PG8_SCHED;
            PG8_LDB(B1, 0, 1); PG8_STAGE_B(PG8_SB(0, 0), b2);
            PG8_BAR; PG8_WAIT_L(0); PG8_MMA(0, 1, At, B1); PG8_BAR;
            PG8_LDA(At, 0, 1); PG8_STAGE_A(PG8_SA(0, 0), a2, va2[0], kb2);
            PG8_BAR; PG8_WAIT_L(0); PG8_MMA(1, 0, At, B0); PG8_BAR; PG8_SCHED;
            PG8_STAGE_B(PG8_SB(0, 1), b2 + hstepB);
            PG8_WAIT_V(6); PG8_BAR; PG8_MMA(1, 1, At, B1); PG8_BAR;
            PG8_LDB(B0, 1, 0); PG8_SCHED; PG8_LDA(At, 1, 0); PG8_STAGE_A(PG8_SA(0, 1), a2 + hstepA, va2[1], kb2);
            PG8_WAIT_L(8); PG8_BAR; PG8_WAIT_L(0); PG8_MMA(0, 0, At, B0); PG8_BAR; PG8_SCHED;
            PG8_LDB(B1, 1, 1); PG8_STAGE_B(PG8_SB(1, 0), b3);
            PG8_BAR; PG8_WAIT_L(0); PG8_MMA(0, 1, At, B1); PG8_BAR;
            PG8_LDA(At, 1, 1); PG8_STAGE_A(PG8_SA(1, 0), a3, va2[0], kb3);
            PG8_BAR; PG8_WAIT_L(0); PG8_MMA(1, 0, At, B0); PG8_BAR; PG8_SCHED;
            PG8_STAGE_B(PG8_SB(1, 1), b3 + hstepB);
            PG8_WAIT_V(6); PG8_BAR; PG8_MMA(1, 1, At, B1); PG8_BAR;
        }
        E(acc, cur, wr, wc, fr, fq);
        if (!has_next) break;
#pragma unroll
        for (int a = 0; a < 2; ++a)
#pragma unroll
            for (int b = 0; b < 2; ++b)
#pragma unroll
                for (int m = 0; m < 4; ++m)
#pragma unroll
                    for (int n = 0; n < 2; ++n) acc[a][b][m][n] = (f32x4){0.f, 0.f, 0.f, 0.f};
        cur = nxt; cA = nA; cB = nB; ++ui;
#pragma unroll
        for (int h = 0; h < 2; ++h)
#pragma unroll
            for (int i = 0; i < 2; ++i) vcur[h][i] = vnxt[h][i];
    }
    PG8_WAIT_V(0);
    if (wr == 0) PG8_BAR;
    PG8_BAR;
#undef PG8_AOFF
#undef PG8_SA
#undef PG8_SB
#undef PG8_STAGE_A
#undef PG8_STAGE_B
#undef PG8_LDA
#undef PG8_LDB
#undef PG8_MMA
#undef PG8_WAIT_V
#undef PG8_WAIT_L
#undef PG8_BAR
#undef PG8_SCHED
}
}
using pg8::Unit;
typedef f32x4 AccT[2][2][4][2];
struct EpiBf16Plain {
    static constexpr bool PERM = true;
    bf16_t* O; int ldc; int ncols;
    __device__ __forceinline__ void operator()(const AccT& acc, const Unit& u, int wr, int wc, int fr, int fq) const {
        const int row0 = u.pm * 256 + wr * 64 + fr, col0 = u.pn * 256 + wc * 32 + 8 * fq;
#pragma unroll
        for (int ai = 0; ai < 2; ++ai)
#pragma unroll
            for (int m = 0; m < 4; ++m) { bf16_t* rowp = O + (size_t)(row0 + ai * 128 + m * 16) * ldc;
#pragma unroll
                for (int bj = 0; bj < 2; ++bj) { const int col = col0 + bj * 128; if (col < ncols) { const f32x4 v0 = acc[ai][bj][m][0], v1 = acc[ai][bj][m][1];
                    u32x4 pk; pk.x = pg8::cvt_pk_bf16(v0[0], v0[1]); pk.y = pg8::cvt_pk_bf16(v0[2], v0[3]); pk.z = pg8::cvt_pk_bf16(v1[0], v1[1]); pk.w = pg8::cvt_pk_bf16(v1[2], v1[3]);
                    *(u32x4*)(rowp + col) = pk; } } }
    }
};
struct EpiF32 {
    static constexpr bool PERM = false;
    float* C; int ldc;
    __device__ __forceinline__ void operator()(const AccT& acc, const Unit& u, int wr, int wc, int fr, int fq) const {
        const int row0 = u.pm * 256 + wr * 64 + fr, col0 = u.pn * 256 + wc * 32 + 4 * fq;
#pragma unroll
        for (int ai = 0; ai < 2; ++ai)
#pragma unroll
            for (int m = 0; m < 4; ++m) { float* rowp = C + (size_t)(row0 + ai * 128 + m * 16) * ldc + col0;
#pragma unroll
                for (int bj = 0; bj < 2; ++bj)
#pragma unroll
                    for (int n = 0; n < 2; ++n) *(f32x4*)(rowp + bj * 128 + n * 16) = acc[ai][bj][m][n]; }
    }
};
struct EpiGlu {
    static constexpr bool PERM = true;
    const bf16_t* ys5; const float* bias; bf16_t* ycat;
    __device__ __forceinline__ void operator()(const AccT& acc, const Unit& u, int wr, int wc, int fr, int fq) const {
        const int row0 = u.pm * 256 + wr * 64 + fr, col0 = u.pn * 256 + wc * 32 + 8 * fq;
#pragma unroll
        for (int bj = 0; bj < 2; ++bj) { const int col = col0 + bj * 128;
            const f32x4 b0 = *(const f32x4*)(bias + col), b1 = *(const f32x4*)(bias + col + 4);
#pragma unroll
            for (int ai = 0; ai < 2; ++ai)
#pragma unroll
                for (int m = 0; m < 4; ++m) { const int row = row0 + ai * 128 + m * 16;
                    const u32x4 yv = *(const u32x4*)(ys5 + (size_t)row * 512 + col);
                    const f32x4 v0 = acc[ai][bj][m][0] + b0, v1 = acc[ai][bj][m][1] + b1;
                    u32x4 pk;
                    pk.x = pg8::cvt_pk_bf16(bflo(yv.x) * sigmoidf_(v0[0]), bfhi(yv.x) * sigmoidf_(v0[1]));
                    pk.y = pg8::cvt_pk_bf16(bflo(yv.y) * sigmoidf_(v0[2]), bfhi(yv.y) * sigmoidf_(v0[3]));
                    pk.z = pg8::cvt_pk_bf16(bflo(yv.z) * sigmoidf_(v1[0]), bfhi(yv.z) * sigmoidf_(v1[1]));
                    pk.w = pg8::cvt_pk_bf16(bflo(yv.w) * sigmoidf_(v1[2]), bfhi(yv.w) * sigmoidf_(v1[3]));
                    *(u32x4*)(ycat + (size_t)row * 1024 + 512 + col) = pk; } }
    }
};
struct EpiSwiglu {
    static constexpr bool PERM = true;
    bf16_t* H;
    __device__ __forceinline__ void operator()(const AccT& acc, const Unit& u, int wr, int wc, int fr, int fq) const {
        const int e = u.pm >> 3; const int row0 = u.pm * 256 + wr * 64 + fr, col0 = (u.pn - e * 22) * 128 + wc * 32 + 8 * fq;
#pragma unroll
        for (int ai = 0; ai < 2; ++ai)
#pragma unroll
            for (int m = 0; m < 4; ++m) { const f32x4 g0 = acc[ai][0][m][0], g1 = acc[ai][0][m][1], u0 = acc[ai][1][m][0], u1 = acc[ai][1][m][1];
                u32x4 pk;
                pk.x = pg8::cvt_pk_bf16(siluf_(g0[0]) * u0[0], siluf_(g0[1]) * u0[1]); pk.y = pg8::cvt_pk_bf16(siluf_(g0[2]) * u0[2], siluf_(g0[3]) * u0[3]);
                pk.z = pg8::cvt_pk_bf16(siluf_(g1[0]) * u1[0], siluf_(g1[1]) * u1[1]); pk.w = pg8::cvt_pk_bf16(siluf_(g1[2]) * u1[2], siluf_(g1[3]) * u1[3]);
                *(u32x4*)(H + (size_t)(row0 + ai * 128 + m * 16) * F_ + col0) = pk; }
    }
};
struct EpiDown {
    static constexpr bool PERM = true;
    bf16_t* Y; const float* gatev;
    __device__ __forceinline__ void operator()(const AccT& acc, const Unit& u, int wr, int wc, int fr, int fq) const {
        const int e = u.pm >> 3; const int row0 = u.pm * 256 + wr * 64 + fr, col0 = (u.pn - e * 4) * 256 + wc * 32 + 8 * fq;
#pragma unroll
        for (int ai = 0; ai < 2; ++ai)
#pragma unroll
            for (int m = 0; m < 4; ++m) { const int row = row0 + ai * 128 + m * 16; const float gt = gatev[row];
#pragma unroll
                for (int bj = 0; bj < 2; ++bj) { const f32x4 v0 = acc[ai][bj][m][0], v1 = acc[ai][bj][m][1];
                    u32x4 pk; pk.x = pg8::cvt_pk_bf16(v0[0] * gt, v0[1] * gt); pk.y = pg8::cvt_pk_bf16(v0[2] * gt, v0[3] * gt); pk.z = pg8::cvt_pk_bf16(v1[0] * gt, v1[1] * gt); pk.w = pg8::cvt_pk_bf16(v1[2] * gt, v1[3] * gt);
                    *(u32x4*)(Y + (size_t)row * 1024 + col0 + bj * 128) = pk; } }
    }
};
struct EpiVimg {
    static constexpr bool PERM = false;
    bf16_t* V;
    __device__ __forceinline__ void operator()(const AccT& acc, const Unit& u, int wr, int wc, int fr, int fq) const {
        const int row0 = u.pm * 256 + wr * 64 + fr, col0 = u.pn * 256 + wc * 32 + 4 * fq;
#pragma unroll
        for (int ai = 0; ai < 2; ++ai)
#pragma unroll
            for (int m = 0; m < 4; ++m) { const int row = row0 + ai * 128 + m * 16, h = row >> 7, dv = row & 127;
#pragma unroll
                for (int bj = 0; bj < 2; ++bj)
#pragma unroll
                    for (int n = 0; n < 2; ++n) { const int tok = col0 + bj * 128 + n * 16, b = tok >> 12, s = tok & 4095, kt = s >> 6, un = (s & 63) >> 2;
                        const f32x4 v = acc[ai][bj][m][n]; u32x2 pk; pk.x = pg8::cvt_pk_bf16(v[0], v[1]); pk.y = pg8::cvt_pk_bf16(v[2], v[3]);
                        *(u32x2*)(V + ((((size_t)(b * 4 + h) * 64 + kt) * 16 + un) * 128 + dv) * 4) = pk; } }
    }
};
struct EpiLora {
    static constexpr bool PERM = false;
    float* dec; float* av; float* gv; const float* w0; const float* a0;
    __device__ __forceinline__ void operator()(const AccT& acc, const Unit& u, int wr, int wc, int fr, int fq) const {
        const int row0 = u.pm * 256 + wr * 64 + fr, colt = u.pn * 256, kind = colt >> 9;
        const int cbase = (colt & 511) + wc * 32 + 4 * fq;
        float* outp = kind < 2 ? dec + (size_t)kind * T_ * 512 : (kind < 4 ? av + (size_t)(kind - 2) * T_ * 512 : gv);
        const float* addp = kind < 2 ? w0 + kind * 512 : a0 + ((kind - 2) & 1) * 512;
#pragma unroll
        for (int bj = 0; bj < 2; ++bj)
#pragma unroll
            for (int n = 0; n < 2; ++n) { const int c = cbase + bj * 128 + n * 16;
                f32x4 ad = (f32x4){0.f, 0.f, 0.f, 0.f}; if (kind < 4) ad = *(const f32x4*)(addp + c);
#pragma unroll
                for (int ai = 0; ai < 2; ++ai)
#pragma unroll
                    for (int m = 0; m < 4; ++m) { const int row = row0 + ai * 128 + m * 16; const f32x4 v = acc[ai][bj][m][n] + ad; f32x4 o;
#pragma unroll
                        for (int q = 0; q < 4; ++q) { float t = sigmoidf_(v[q]); if (kind < 2) t = __expf(-0.6065306597126334f * t); if (kind == 4) t = v[q]; o[q] = t; }
                        *(f32x4*)(outp + (size_t)row * 512 + c) = o;
                        asm volatile("" ::: "memory"); } }
    }
};

struct Frame {
    unsigned char* smem; LAS unsigned char* lds; int tid, lane, wid, bid, nblk;
    const float* const* in; float* out; unsigned char* ws;
};
#define WSP(T, off) ((T*)(F.ws + (off)))

__device__ __forceinline__ void phase_mod(const Frame& F) {
    float* silu_c = (float*)F.smem; float* red = silu_c + 4096;
    const float* c = F.in[I_C];
    for (int i = F.tid; i < 4096; i += NTHR) silu_c[i] = siluf_(c[i]);
    __syncthreads();
    float* mod = WSP(float, OFF_MOD);
    for (int u = F.bid; u < 192; u += F.nblk) {
        const int l = u / 96, cg = u % 96, col = cg * 64 + F.lane;
        const float* W = F.in[I_ADA_W] + (size_t)l * 1024 * 6144 + col;
        float a0 = 0.f, a1 = 0.f, a2 = 0.f, a3 = 0.f;
        const int kb = F.wid * 128;
#pragma unroll 8
        for (int k = 0; k < 128; ++k) { const float w = W[(size_t)(kb + k) * 6144]; a0 += silu_c[kb + k] * w; a1 += silu_c[1024 + kb + k] * w; a2 += silu_c[2048 + kb + k] * w; a3 += silu_c[3072 + kb + k] * w; }
        red[(F.wid * 4 + 0) * 64 + F.lane] = a0; red[(F.wid * 4 + 1) * 64 + F.lane] = a1; red[(F.wid * 4 + 2) * 64 + F.lane] = a2; red[(F.wid * 4 + 3) * 64 + F.lane] = a3;
        __syncthreads();
        if (F.wid < 4) { float s = 0.f;
#pragma unroll
            for (int w = 0; w < 8; ++w) s += red[(w * 4 + F.wid) * 64 + F.lane];
            mod[(size_t)(l * 4 + F.wid) * 6144 + col] = s + F.in[I_ADA_B][l * 6144 + col]; }
        __syncthreads();
    }
}

__device__ __forceinline__ void cvt_tile(const float* src, size_t ld_src, bf16_t* dst, size_t ld_dst, float* tl, int t) {
    const int kr = t >> 4, nc = (t & 15) * 4;
#pragma unroll
    for (int i = 0; i < 4; ++i) { const int k = kr + 32 * i; const float4 v = *(const float4*)(src + (size_t)k * ld_src + nc); *(float4*)(tl + k * 68 + nc) = v; }
    __syncthreads();
    const int n = t & 63, ks = (t >> 6) * 16;
    unsigned pk[8];
#pragma unroll
    for (int j = 0; j < 8; ++j) pk[j] = pk2(tl[(ks + 2 * j) * 68 + n], tl[(ks + 2 * j + 1) * 68 + n]);
    uint4* d = (uint4*)(dst + (size_t)n * ld_dst + ks);
    d[0] = make_uint4(pk[0], pk[1], pk[2], pk[3]); d[1] = make_uint4(pk[4], pk[5], pk[6], pk[7]);
    __syncthreads();
}
__device__ __forceinline__ void phase_convert(const Frame& F) {
    float* tl = (float*)F.smem;
    for (int x = F.bid; x < 1040; x += F.nblk) {
        const float* src; size_t lds_; bf16_t* dst; size_t ldd; int tt = x;
        if (tt < 256)            { const int kt = tt & 7, nt = tt >> 3; src = F.in[I_AB_IN] + (size_t)kt * 128 * 2576 + nt * 64; lds_ = 2576; dst = WSP(bf16_t, OFF_WIN0T) + (size_t)(nt * 64) * 1024 + kt * 128; ldd = 1024; }
        else if ((tt -= 256) < 64)  { const int kt = tt & 7, nt = tt >> 3; src = F.in[I_AB_IN] + (size_t)kt * 128 * 2576 + 2064 + nt * 64; lds_ = 2576; dst = WSP(bf16_t, OFF_WIN0T) + (size_t)(2048 + nt * 64) * 1024 + kt * 128; ldd = 1024; }
        else if ((tt -= 64) < 32)   { const int kt = tt & 3, nt = tt >> 2; src = F.in[I_S5_GLUW] + (size_t)kt * 128 * 512 + nt * 64; lds_ = 512; dst = WSP(bf16_t, OFF_WGLUT) + (size_t)(nt * 64) * 512 + kt * 128; ldd = 512; }
        else if ((tt -= 32) < 128)  { const int kt = tt & 7, nt = tt >> 3; src = F.in[I_AB_OUT] + (size_t)kt * 128 * 1024 + nt * 64; lds_ = 1024; dst = WSP(bf16_t, OFF_WOUT0T) + (size_t)(nt * 64) * 1024 + kt * 128; ldd = 1024; }
        else if ((tt -= 128) < 368) { const int kt = tt & 7, nt = tt >> 3; src = F.in[I_CD_IN] + (size_t)kt * 128 * 3456 + nt * 64; lds_ = 3456; dst = WSP(bf16_t, OFF_WIN1T) + (size_t)(nt * 64) * 1024 + kt * 128; ldd = 1024; }
        else if ((tt -= 368) < 64)  { const int kt = tt & 7, nt = tt >> 3; src = F.in[I_CD_IN] + (size_t)kt * 128 * 3456 + 2944 + nt * 64; lds_ = 3456; dst = WSP(bf16_t, OFF_WVT) + (size_t)(nt * 64) * 1024 + kt * 128; ldd = 1024; }
        else { tt -= 64;              const int kt = tt & 7, nt = tt >> 3; src = F.in[I_CD_OUT] + (size_t)kt * 128 * 1024 + nt * 64; lds_ = 1024; dst = WSP(bf16_t, OFF_WOUT1T) + (size_t)(nt * 64) * 1024 + kt * 128; ldd = 1024; }
        cvt_tile(src, lds_, dst, ldd, tl, F.tid);
    }
    for (int x = F.bid; x < 33792; x += F.nblk) {
        const int region = x / 352, tt = x % 352, l = region / 48, rem = region % 48, e = rem / 3, kind = rem % 3;
        if (kind < 2) {
            const int kt = tt & 7, nt = tt >> 3;
            const float* src = F.in[kind == 0 ? I_WGATE : I_WUP] + ((size_t)(l * 16 + e) * 1024 + kt * 128) * 2816 + nt * 64;
            const int f = nt * 64, tile22 = f >> 7, r = f & 127;
            bf16_t* dst = (bf16_t*)(F.ws + OFF_W1T + (size_t)l * W1T_LAYER) + ((size_t)((e * 22 + tile22) * 256 + kind * 128 + r)) * 1024 + kt * 128;
            cvt_tile(src, 2816, dst, 1024, tl, F.tid);
        } else {
            const int kt = tt % 22, nt = tt / 22;
            const float* src = F.in[I_WDOWN] + ((size_t)(l * 16 + e) * 2816 + kt * 128) * 1024 + nt * 64;
            bf16_t* dst = (bf16_t*)(F.ws + OFF_W2T + (size_t)l * W2T_LAYER) + ((size_t)(e * 1024 + nt * 64)) * 2816 + kt * 128;
            cvt_tile(src, 1024, dst, 2816, tl, F.tid);
        }
    }
    {
        bf16_t* Wl = WSP(bf16_t, OFF_WLORAT);
        const float* w2 = F.in[I_RW_W2]; const float* a2 = F.in[I_RW_A2]; const float* g2 = F.in[I_RW_G2];
        for (int i = F.bid * NTHR + F.tid; i < 2560 * 384; i += F.nblk * NTHR) {
            const int n = i / 384, k = i % 384, kind = n >> 9, c = n & 511; float v = 0.f;
            if (kind == 0) { if (k < 64) v = w2[(size_t)(0 * 64 + k) * 512 + c]; }
            else if (kind == 1) { if (k >= 64 && k < 128) v = w2[(size_t)(1 * 64 + (k - 64)) * 512 + c]; }
            else if (kind == 2) { if (k >= 128 && k < 192) v = a2[(size_t)(0 * 64 + (k - 128)) * 512 + c]; }
            else if (kind == 3) { if (k >= 192 && k < 256) v = a2[(size_t)(1 * 64 + (k - 192)) * 512 + c]; }
            else { if (k >= 256) v = g2[(size_t)(k - 256) * 512 + c]; }
            Wl[i] = f2bf(v);
        }
    }
}

__device__ __forceinline__ void load_row16(const float* p, int lane, float (&v)[16]) {
    const float4* q = (const float4*)(p + lane * 16);
#pragma unroll
    for (int i = 0; i < 4; ++i) { const float4 t = q[i]; v[4 * i] = t.x; v[4 * i + 1] = t.y; v[4 * i + 2] = t.z; v[4 * i + 3] = t.w; }
}
__device__ __forceinline__ void store_row16(float* p, int lane, const float (&v)[16]) {
    float4* q = (float4*)(p + lane * 16);
#pragma unroll
    for (int i = 0; i < 4; ++i) q[i] = make_float4(v[4 * i], v[4 * i + 1], v[4 * i + 2], v[4 * i + 3]);
}
__device__ __forceinline__ void store_row16_bf(bf16_t* p, int lane, const float (&v)[16]) {
    uint4* q = (uint4*)(p + lane * 16);
    q[0] = make_uint4(pk2(v[0], v[1]), pk2(v[2], v[3]), pk2(v[4], v[5]), pk2(v[6], v[7]));
    q[1] = make_uint4(pk2(v[8], v[9]), pk2(v[10], v[11]), pk2(v[12], v[13]), pk2(v[14], v[15]));
}
__device__ __forceinline__ void fill_thin(float* wl, const float* W, int ldw, int tid) {
    for (int i = tid; i < 1024 * 16; i += NTHR) { const int c = i >> 4, j = i & 15; wl[((c & 15) * 64 + (c >> 4)) * 20 + j] = W[(size_t)c * ldw + j]; }
}
__device__ __forceinline__ void thin16(const float* wl, int lane, const float (&h)[16], float (&o)[16]) {
#pragma unroll
    for (int j = 0; j < 16; ++j) o[j] = 0.f;
#pragma unroll
    for (int i = 0; i < 16; ++i) { const float4* w = (const float4*)(wl + (i * 64 + lane) * 20);
        if ((i & 1) == 0) asm volatile("" ::: "memory");
#pragma unroll
        for (int q = 0; q < 4; ++q) { const float4 t = w[q]; o[4 * q] += h[i] * t.x; o[4 * q + 1] += h[i] * t.y; o[4 * q + 2] += h[i] * t.z; o[4 * q + 3] += h[i] * t.w; } }
#pragma unroll
    for (int j = 0; j < 16; ++j) o[j] = wave_sum(o[j]);
}

__device__ __forceinline__ void phase_norm0(const Frame& F) {
    float* wl = (float*)F.smem;
    fill_thin(wl, F.in[I_AB_IN] + 2048, 2576, F.tid);
    __syncthreads();
    const float* x = F.in[I_X]; const float* mod = WSP(float, OFF_MOD); bf16_t* hb = WSP(bf16_t, OFF_HB); float* gb = WSP(float, OFF_GB0);
    for (int tb = F.bid; tb < 256; tb += F.nblk) {
        const int base = tb * 64 + F.wid * 8, b = base >> 12;
        float gain[16], sc[16], sh[16];
        load_row16(F.in[I_NMIX_PRE], F.lane, gain);
        load_row16(mod + (size_t)(0 * 4 + b) * 6144 + 1024, F.lane, sc);
        load_row16(mod + (size_t)(0 * 4 + b) * 6144, F.lane, sh);
        for (int i = 0; i < 8; ++i) {
            const int tok = base + i; float v[16]; load_row16(x + (size_t)tok * 1024, F.lane, v);
            float ss = 0.f;
#pragma unroll
            for (int q = 0; q < 16; ++q) ss += v[q] * v[q];
            ss = wave_sum(ss); const float rstd = rsqrtf(ss * (1.f / 1024.f) + 1e-6f);
#pragma unroll
            for (int q = 0; q < 16; ++q) v[q] = v[q] * rstd * gain[q] * (1.f + sc[q]) + sh[q];
            store_row16_bf(hb + (size_t)tok * 1024, F.lane, v);
            float o[16]; thin16(wl, F.lane, v, o);
            if (F.lane < 16) { const int j = F.lane; float r = 0.f;
#pragma unroll
                for (int q = 0; q < 16; ++q) r = (q == j) ? o[q] : r;
                float outv;
                if (j < 8) outv = -__expf(F.in[I_DN_ALOG][j]) * softplusf_(r + F.in[I_DN_DTB][j]);
                else outv = sigmoidf_(r);
                gb[(size_t)tok * 16 + j] = outv; }
        }
    }
}

__device__ __forceinline__ void phase_dnprep(const Frame& F) {
    const bf16_t* P0 = WSP(bf16_t, OFF_P0); float* qkvn = WSP(float, OFF_QKVN); const float* cw = F.in[I_DN_CONV];
    const int c0 = F.lane * 8;
    for (int tb = F.bid; tb < 256; tb += F.nblk) {
        const int base = tb * 64 + F.wid * 8;
        for (int i = 0; i < 8; ++i) {
            const int tok = base + i, s = tok & 4095;
#pragma unroll
            for (int grp = 0; grp < 3; ++grp) {
                float acc[8];
#pragma unroll
                for (int q = 0; q < 8; ++q) acc[q] = 0.f;
#pragma unroll
                for (int j = 0; j < 5; ++j) { const int sj = s + j - 2;
                    if (sj >= 0 && sj < 4096) {
                        const u32x4 pv = *(const u32x4*)(P0 + (size_t)(tok + j - 2) * 2560 + grp * 512 + c0);
                        const float4 w0 = *(const float4*)(cw + j * 1536 + grp * 512 + c0), w1 = *(const float4*)(cw + j * 1536 + grp * 512 + c0 + 4);
                        acc[0] += w0.x * bflo(pv.x); acc[1] += w0.y * bfhi(pv.x); acc[2] += w0.z * bflo(pv.y); acc[3] += w0.w * bfhi(pv.y);
                        acc[4] += w1.x * bflo(pv.z); acc[5] += w1.y * bfhi(pv.z); acc[6] += w1.z * bflo(pv.w); acc[7] += w1.w * bfhi(pv.w); } }
                float ss = 0.f;
#pragma unroll
                for (int q = 0; q < 8; ++q) { acc[q] = siluf_(acc[q]); ss += acc[q] * acc[q]; }
                if (grp < 2) {
                    ss += __shfl_xor(ss, 1); ss += __shfl_xor(ss, 2); ss += __shfl_xor(ss, 4); ss += __shfl_xor(ss, 8);
                    float sc = rsqrtf(ss + 1e-6f); if (grp == 0) sc *= 0.08838834764831845f;
#pragma unroll
                    for (int q = 0; q < 8; ++q) acc[q] *= sc; }
                float4* o = (float4*)(qkvn + (size_t)tok * 1536 + grp * 512 + c0);
                o[0] = make_float4(acc[0], acc[1], acc[2], acc[3]); o[1] = make_float4(acc[4], acc[5], acc[6], acc[7]);
            }
        }
    }
}

__device__ __forceinline__ void phase_dnscan(const Frame& F) {
    float* bufQK = (float*)F.smem;
    float* bufV = bufQK + 2 * 32 * 256;
    float* bufG = bufV + 2 * 32 * 32;
    const float* qkvn = WSP(float, OFF_QKVN); const float* gb = WSP(float, OFF_GB0); float* dno = WSP(float, OFF_DNO);
    const int col4 = F.lane >> 4, kp = F.lane & 15, jj = F.wid * 4 + col4;
    for (int u = F.bid; u < 128; u += F.nblk) {
        const int cb = u & 3, seq = u >> 2, dir = seq & 1, h = (seq >> 1) & 3, b = seq >> 3;
        float s[8];
#pragma unroll
        for (int q = 0; q < 8; ++q) s[q] = 0.f;
        float4 rq0, rq1, rq2, rq3; float4 rv = make_float4(0.f, 0.f, 0.f, 0.f); float rg = 0.f;
#define DN_LD1(dst, i, c) do { const int idx = F.tid + NTHR * (i), row = idx >> 6, c4 = idx & 63, step = (c) * 32 + row, t = dir ? 4095 - step : step; \
            const size_t tok = (size_t)b * 4096 + t; dst = *(const float4*)(qkvn + tok * 1536 + (c4 < 32 ? h * 128 + c4 * 4 : 512 + h * 128 + (c4 - 32) * 4)); } while (0)
#define DN_GLOAD(c) do { DN_LD1(rq0, 0, c); DN_LD1(rq1, 1, c); DN_LD1(rq2, 2, c); DN_LD1(rq3, 3, c); \
            if (F.tid < 256) { const int row = F.tid >> 3, c4 = F.tid & 7, step = (c) * 32 + row, t = dir ? 4095 - step : step; const size_t tok = (size_t)b * 4096 + t; \
                rv = *(const float4*)(qkvn + tok * 1536 + 1024 + h * 128 + cb * 32 + c4 * 4); } \
            else if (F.tid < 320) { const int row = (F.tid - 256) >> 1, which = F.tid & 1, step = (c) * 32 + row, t = dir ? 4095 - step : step; const size_t tok = (size_t)b * 4096 + t; \
                rg = gb[tok * 16 + which * 8 + dir * 4 + h]; } } while (0)
#define DN_LSTORE(buf) do { *(float4*)(bufQK + (buf) * 8192 + (F.tid) * 4) = rq0; *(float4*)(bufQK + (buf) * 8192 + (F.tid + NTHR) * 4) = rq1; \
            *(float4*)(bufQK + (buf) * 8192 + (F.tid + 2 * NTHR) * 4) = rq2; *(float4*)(bufQK + (buf) * 8192 + (F.tid + 3 * NTHR) * 4) = rq3; \
            if (F.tid < 256) *(float4*)(bufV + (buf) * 1024 + F.tid * 4) = rv; else if (F.tid < 320) bufG[(buf) * 64 + (F.tid - 256)] = rg; } while (0)
        DN_GLOAD(0); DN_LSTORE(0); __syncthreads();
        for (int c = 0; c < 128; ++c) {
            const int buf = c & 1;
            if (c + 1 < 128) DN_GLOAD(c + 1);
            float osel = 0.f;
#pragma unroll 4
            for (int i = 0; i < 32; ++i) {
                const float* row = bufQK + buf * 8192 + i * 256;
                const float4 q0 = *(const float4*)(row + kp * 8), q1 = *(const float4*)(row + kp * 8 + 4);
                const float4 k0 = *(const float4*)(row + 128 + kp * 8), k1 = *(const float4*)(row + 128 + kp * 8 + 4);
                const float v = bufV[buf * 1024 + i * 32 + jj]; const float g = bufG[buf * 64 + i * 2], beta = bufG[buf * 64 + i * 2 + 1];
                const float a = __expf(g);
#pragma unroll
                for (int q = 0; q < 8; ++q) s[q] *= a;
                float d = k0.x * s[0] + k0.y * s[1] + k0.z * s[2] + k0.w * s[3] + k1.x * s[4] + k1.y * s[5] + k1.z * s[6] + k1.w * s[7];
                d = row16_sum(d);
                const float cc = beta * (v - d);
                s[0] += k0.x * cc; s[1] += k0.y * cc; s[2] += k0.z * cc; s[3] += k0.w * cc; s[4] += k1.x * cc; s[5] += k1.y * cc; s[6] += k1.z * cc; s[7] += k1.w * cc;
                float o = q0.x * s[0] + q0.y * s[1] + q0.z * s[2] + q0.w * s[3] + q1.x * s[4] + q1.y * s[5] + q1.z * s[6] + q1.w * s[7];
                o = row16_sum(o);
                osel = (kp == (i & 15)) ? o : osel;
                if ((i & 15) == 15) { const int step = c * 32 + (i & 16) + kp, t = dir ? 4095 - step : step;
                    dno[((size_t)dir * T_ + (size_t)b * 4096 + t) * 512 + h * 128 + cb * 32 + jj] = osel; }
            }
            if (c + 1 < 128) DN_LSTORE(buf ^ 1);
            __syncthreads();
        }
    }
#undef DN_LD1
#undef DN_GLOAD
#undef DN_LSTORE
}

__device__ __forceinline__ void phase_s5scan(const Frame& F) {
    float* Ebuf = (float*)F.smem;
    float* ubuf = Ebuf + 64 * 64 * 2 + F.wid * 64 * 16;
    bf16_t* xs = (bf16_t*)((float*)F.smem + 64 * 64 * 2 + 8 * 64 * 16) + F.wid * 16 * 136;
    const bf16_t* P0 = WSP(bf16_t, OFF_P0); float* s5y = WSP(float, OFF_S5Y);
    const int p = F.lane;
    for (int u = F.bid; u < 256; u += F.nblk) {
        const int d = u & 1, g = (u >> 1) & 31, b = u >> 6;
        const float dt = __expf(F.in[I_S5_LDT][d * 32 + g]);
        const float are = F.in[I_S5_ARE][(d * 32 + g) * 64 + p], aim = F.in[I_S5_AIM][(d * 32 + g) * 64 + p];
        const float mag = __expf(are * dt);
        float rev = aim * dt * 0.15915494309189535f; rev -= floorf(rev);
        const float lr = mag * __builtin_amdgcn_cosf(rev), li = mag * __builtin_amdgcn_sinf(rev);
        const float den = are * are + aim * aim, nr = lr - 1.f, ni = li;
        const float fre = (nr * are + ni * aim) / den, fim = (ni * are - nr * aim) / den;
        float bbr[16], bbi[16];
        { const float* br = F.in[I_S5_BRE] + ((size_t)(d * 32 + g) * 64 + p) * 16; const float* bi = F.in[I_S5_BIM] + ((size_t)(d * 32 + g) * 64 + p) * 16;
#pragma unroll
          for (int hh = 0; hh < 16; ++hh) { const float r_ = br[hh], i_ = bi[hh]; bbr[hh] = fre * r_ - fim * i_; bbi[hh] = fre * i_ + fim * r_; } }
        bf16x8 cfrag[4];
        { const int hcol = F.lane & 15, kq = F.lane >> 4;
#pragma unroll
          for (int s = 0; s < 4; ++s) { const int kk0 = 32 * s + 8 * kq; bf16x8 f;
#pragma unroll
              for (int j = 0; j < 8; ++j) { const int kk = kk0 + j; const float v = kk < 64 ? F.in[I_S5_CRE][((size_t)(d * 32 + g) * 16 + hcol) * 64 + kk] : -F.in[I_S5_CIM][((size_t)(d * 32 + g) * 16 + hcol) * 64 + (kk - 64)]; f[j] = (short)f2bf(v); }
              cfrag[s] = f; } }
        float l64r = lr, l64i = li;
#pragma unroll
        for (int q = 0; q < 6; ++q) { const float r2 = l64r * l64r - l64i * l64i, i2 = 2.f * l64r * l64i; l64r = r2; l64i = i2; }
        auto load_u = [&](int cw) {
            const int n = cw * 64 + F.lane, t = d ? 4095 - n : n; const bf16_t* src = P0 + ((size_t)b * 4096 + t) * 2560 + 2048 + g * 16;
            const u32x4 a = *(const u32x4*)src, c = *(const u32x4*)(src + 8);
            float4* dst = (float4*)(ubuf + F.lane * 16);
            dst[0] = make_float4(bflo(a.x), bfhi(a.x), bflo(a.y), bfhi(a.y)); dst[1] = make_float4(bflo(a.z), bfhi(a.z), bflo(a.w), bfhi(a.w));
            dst[2] = make_float4(bflo(c.x), bfhi(c.x), bflo(c.y), bfhi(c.y)); dst[3] = make_float4(bflo(c.z), bfhi(c.z), bflo(c.w), bfhi(c.w));
            asm volatile("s_waitcnt lgkmcnt(0)" ::: "memory"); __builtin_amdgcn_wave_barrier();
        };
        auto step_x = [&](int j, float& xr, float& xi) {
            const float4* uu = (const float4*)(ubuf + j * 16);
            const float4 u0 = uu[0], u1 = uu[1], u2 = uu[2], u3 = uu[3];
            float br_ = bbr[0] * u0.x + bbr[1] * u0.y + bbr[2] * u0.z + bbr[3] * u0.w + bbr[4] * u1.x + bbr[5] * u1.y + bbr[6] * u1.z + bbr[7] * u1.w
                      + bbr[8] * u2.x + bbr[9] * u2.y + bbr[10] * u2.z + bbr[11] * u2.w + bbr[12] * u3.x + bbr[13] * u3.y + bbr[14] * u3.z + bbr[15] * u3.w;
            float bi_ = bbi[0] * u0.x + bbi[1] * u0.y + bbi[2] * u0.z + bbi[3] * u0.w + bbi[4] * u1.x + bbi[5] * u1.y + bbi[6] * u1.z + bbi[7] * u1.w
                      + bbi[8] * u2.x + bbi[9] * u2.y + bbi[10] * u2.z + bbi[11] * u2.w + bbi[12] * u3.x + bbi[13] * u3.y + bbi[14] * u3.z + bbi[15] * u3.w;
            const float nxr = lr * xr - li * xi + br_, nxi = lr * xi + li * xr + bi_; xr = nxr; xi = nxi;
        };
        for (int i = 0; i < 8; ++i) { const int cw = F.wid * 8 + i; load_u(cw); float xr = 0.f, xi = 0.f;
            for (int j = 0; j < 64; ++j) step_x(j, xr, xi);
            Ebuf[(cw * 64 + p) * 2] = xr; Ebuf[(cw * 64 + p) * 2 + 1] = xi;
            __builtin_amdgcn_wave_barrier(); }
        __syncthreads();
        float xr = 0.f, xi = 0.f;
        for (int c = 0; c < F.wid * 8; ++c) { const float er = Ebuf[(c * 64 + p) * 2], ei = Ebuf[(c * 64 + p) * 2 + 1]; const float nr_ = l64r * xr - l64i * xi + er, ni_ = l64r * xi + l64i * xr + ei; xr = nr_; xi = ni_; }
        for (int i = 0; i < 8; ++i) { const int cw = F.wid * 8 + i; load_u(cw);
            for (int sub = 0; sub < 4; ++sub) {
                for (int j = 0; j < 16; ++j) { step_x(sub * 16 + j, xr, xi); xs[j * 136 + p] = f2bf(xr); xs[j * 136 + 64 + p] = f2bf(xi); }
                asm volatile("s_waitcnt lgkmcnt(0)" ::: "memory"); __builtin_amdgcn_wave_barrier();
                f32x4 acc = (f32x4){0.f, 0.f, 0.f, 0.f};
#pragma unroll
                for (int s = 0; s < 4; ++s) { const bf16x8 af = *(const bf16x8*)(xs + (F.lane & 15) * 136 + 32 * s + 8 * (F.lane >> 4)); acc = __builtin_amdgcn_mfma_f32_16x16x32_bf16(af, cfrag[s], acc, 0, 0, 0); }
                asm volatile("s_waitcnt lgkmcnt(0)" ::: "memory"); __builtin_amdgcn_wave_barrier();
#pragma unroll
                for (int j = 0; j < 4; ++j) { const int tl_ = (F.lane >> 4) * 4 + j, n = cw * 64 + sub * 16 + tl_, t = d ? 4095 - n : n;
                    s5y[((size_t)d * T_ + (size_t)b * 4096 + t) * 512 + g * 16 + (F.lane & 15)] = acc[j]; }
            } }
        __syncthreads();
    }
}

__device__ __forceinline__ void phase_post0(const Frame& F) {
    const bf16_t* P0 = WSP(bf16_t, OFF_P0); const float* dno = WSP(float, OFF_DNO); const float* s5y = WSP(float, OFF_S5Y);
    bf16_t* ycat = WSP(bf16_t, OFF_YCAT); bf16_t* ys5 = WSP(bf16_t, OFF_YS5);
    const int c0 = F.lane * 8;
    float nw[8], dsk[8];
#pragma unroll
    for (int q = 0; q < 8; ++q) { nw[q] = F.in[I_DN_NORM][(c0 & 127) + q]; dsk[q] = F.in[I_S5_D][c0 + q]; }
    for (int tb = F.bid; tb < 256; tb += F.nblk) {
        const int base = tb * 64 + F.wid * 8;
        for (int i = 0; i < 8; ++i) { const size_t tok = base + i;
            { const float4 a0 = *(const float4*)(dno + tok * 512 + c0), a1 = *(const float4*)(dno + tok * 512 + c0 + 4);
              const float4 b0 = *(const float4*)(dno + ((size_t)T_ + tok) * 512 + c0), b1 = *(const float4*)(dno + ((size_t)T_ + tok) * 512 + c0 + 4);
              float o[8] = {a0.x + b0.x, a0.y + b0.y, a0.z + b0.z, a0.w + b0.w, a1.x + b1.x, a1.y + b1.y, a1.z + b1.z, a1.w + b1.w};
              float ss = 0.f;
#pragma unroll
              for (int q = 0; q < 8; ++q) ss += o[q] * o[q];
              ss += __shfl_xor(ss, 1); ss += __shfl_xor(ss, 2); ss += __shfl_xor(ss, 4); ss += __shfl_xor(ss, 8);
              const float rstd = rsqrtf(ss * (1.f / 128.f) + 1e-6f);
              const u32x4 zv = *(const u32x4*)(P0 + tok * 2560 + 1536 + c0);
              const float z[8] = {bflo(zv.x), bfhi(zv.x), bflo(zv.y), bfhi(zv.y), bflo(zv.z), bfhi(zv.z), bflo(zv.w), bfhi(zv.w)};
#pragma unroll
              for (int q = 0; q < 8; ++q) o[q] = o[q] * rstd * nw[q] * siluf_(z[q]);
              *(u32x4*)(ycat + tok * 1024 + c0) = (u32x4){pk2(o[0], o[1]), pk2(o[2], o[3]), pk2(o[4], o[5]), pk2(o[6], o[7])}; }
            { const float4 a0 = *(const float4*)(s5y + tok * 512 + c0), a1 = *(const float4*)(s5y + tok * 512 + c0 + 4);
              const float4 b0 = *(const float4*)(s5y + ((size_t)T_ + tok) * 512 + c0), b1 = *(const float4*)(s5y + ((size_t)T_ + tok) * 512 + c0 + 4);
              const u32x4 uv = *(const u32x4*)(P0 + tok * 2560 + 2048 + c0);
              const float uu[8] = {bflo(uv.x), bfhi(uv.x), bflo(uv.y), bfhi(uv.y), bflo(uv.z), bfhi(uv.z), bflo(uv.w), bfhi(uv.w)};
              float y[8] = {a0.x + b0.x, a0.y + b0.y, a0.z + b0.z, a0.w + b0.w, a1.x + b1.x, a1.y + b1.y, a1.z + b1.z, a1.w + b1.w};
#pragma unroll
              for (int q = 0; q < 8; ++q) y[q] = gelu_tanhf_(y[q] + dsk[q] * uu[q]);
              *(u32x4*)(ys5 + tok * 512 + c0) = (u32x4){pk2(y[0], y[1]), pk2(y[2], y[3]), pk2(y[4], y[5]), pk2(y[6], y[7])}; }
        }
    }
}
__device__ __forceinline__ void phase_mid(const Frame& F, int layer, const float* xin, float* xout) {
    float* wl = (float*)F.smem;
    fill_thin(wl, F.in[I_ROUTER] + (size_t)layer * 1024 * 16, 16, F.tid);
    __syncthreads();
    const float* mod = WSP(float, OFF_MOD); const float* ymix = WSP(float, OFF_YMIX); bf16_t* hb = WSP(bf16_t, OFF_HB); float* probs = WSP(float, OFF_PROBS);
    for (int tb = F.bid; tb < 256; tb += F.nblk) {
        const int base = tb * 64 + F.wid * 8, b = base >> 12;
        const float* mb = mod + (size_t)(layer * 4 + b) * 6144;
        for (int i = 0; i < 8; ++i) {
            const int tok = base + i; float y[16], xv[16];
            load_row16(ymix + (size_t)tok * 1024, F.lane, y); load_row16(xin + (size_t)tok * 1024, F.lane, xv);
            float ss = 0.f;
#pragma unroll
            for (int q = 0; q < 16; ++q) ss += y[q] * y[q];
            ss = wave_sum(ss); float rstd = rsqrtf(ss * (1.f / 1024.f) + 1e-6f);
            float s2 = 0.f;
            { float npost[16], g1[16]; load_row16(F.in[I_NMIX_POST] + layer * 1024, F.lane, npost); load_row16(mb + 2048, F.lane, g1);
#pragma unroll
              for (int q = 0; q < 16; ++q) { xv[q] = xv[q] + g1[q] * (y[q] * rstd * npost[q]); s2 += xv[q] * xv[q]; } }
            store_row16(xout + (size_t)tok * 1024, F.lane, xv);
            s2 = wave_sum(s2); rstd = rsqrtf(s2 * (1.f / 1024.f) + 1e-6f);
            asm volatile("" ::: "memory");
            { float npre[16], sc[16], sh[16]; load_row16(F.in[I_NFFN_PRE] + layer * 1024, F.lane, npre); load_row16(mb + 4096, F.lane, sc); load_row16(mb + 3072, F.lane, sh);
#pragma unroll
              for (int q = 0; q < 16; ++q) y[q] = xv[q] * rstd * npre[q] * (1.f + sc[q]) + sh[q]; }
            asm volatile("" ::: "memory");
            store_row16_bf(hb + (size_t)tok * 1024, F.lane, y);
            float o[16]; thin16(wl, F.lane, y, o);
            float mx = o[0];
#pragma unroll
            for (int q = 1; q < 16; ++q) mx = fmaxf(mx, o[q]);
            float sum = 0.f;
#pragma unroll
            for (int q = 0; q < 16; ++q) { o[q] = __expf(o[q] - mx); sum += o[q]; }
            const float inv = 1.f / sum;
            if (F.lane < 16) { float r = 0.f;
#pragma unroll
                for (int q = 0; q < 16; ++q) r = (q == F.lane) ? o[q] : r;
                probs[((size_t)(b * 16 + F.lane)) * 4096 + (tok & 4095)] = r * inv; }
        }
    }
}

__device__ __forceinline__ void phase_topk(const Frame& F) {
    unsigned* keys = (unsigned*)F.smem;
    unsigned* hist = keys + 4096;
    unsigned* ctl = hist + 256;
    unsigned* wsum = ctl + 8;
    const float* probs = WSP(float, OFF_PROBS); int* rowtok = WSP(int, OFF_ROWTOK); float* gatev = WSP(float, OFF_GATEV); int* slot = WSP(int, OFF_SLOT);
    for (int u = F.bid; u < 64; u += F.nblk) {
        const int b = u >> 4, e = u & 15;
        const float* pr = probs + (size_t)u * 4096;
        for (int i = F.tid; i < 4096; i += NTHR) keys[i] = __float_as_uint(pr[i]);
        if (F.tid == 0) { ctl[0] = 0u; ctl[1] = 512u; }
        __syncthreads();
        for (int pass = 0; pass < 4; ++pass) {
            const int shift = 24 - 8 * pass;
            if (F.tid < 256) hist[F.tid] = 0u;
            __syncthreads();
            const unsigned prefix = ctl[0]; const unsigned himask = pass == 0 ? 0u : (0xFFFFFFFFu << (shift + 8));
            for (int i = F.tid; i < 4096; i += NTHR) { const unsigned k = keys[i]; if ((k & himask) == prefix) atomicAdd(&hist[(k >> shift) & 255u], 1u); }
            __syncthreads();
            if (F.tid == 0) { unsigned kr = ctl[1], cum = 0u; int bin = 255;
                for (; bin > 0; --bin) { const unsigned hcnt = hist[bin]; if (cum + hcnt >= kr) break; cum += hcnt; }
                ctl[0] = prefix | ((unsigned)bin << shift); ctl[1] = kr - cum; }
            __syncthreads();
        }
        const unsigned thr = ctl[0], keq = ctl[1];
        const int i0 = F.tid * 8; unsigned kk[8]; unsigned ceq = 0u;
#pragma unroll
        for (int q = 0; q < 8; ++q) { kk[q] = keys[i0 + q]; ceq += (kk[q] == thr) ? 1u : 0u; }
        unsigned inc = ceq;
#pragma unroll
        for (int o = 1; o < 64; o <<= 1) { const unsigned t = __shfl_up(inc, o); if (F.lane >= o) inc += t; }
        if (F.lane == 63) wsum[F.wid] = inc;
        __syncthreads();
        unsigned woff = 0u;
        for (int w = 0; w < F.wid; ++w) woff += wsum[w];
        unsigned eqpre = woff + inc - ceq;
        __syncthreads();
        unsigned csel = 0u; unsigned selmask = 0u;
#pragma unroll
        for (int q = 0; q < 8; ++q) { bool sel = kk[q] > thr; if (kk[q] == thr) { sel = eqpre < keq; ++eqpre; } if (sel) { selmask |= 1u << q; ++csel; } }
        inc = csel;
#pragma unroll
        for (int o = 1; o < 64; o <<= 1) { const unsigned t = __shfl_up(inc, o); if (F.lane >= o) inc += t; }
        if (F.lane == 63) wsum[8 + F.wid] = inc;
        __syncthreads();
        woff = 0u;
        for (int w = 0; w < F.wid; ++w) woff += wsum[8 + w];
        unsigned sl = woff + inc - csel;
#pragma unroll
        for (int q = 0; q < 8; ++q) { const int tokg = b * 4096 + i0 + q;
            if (selmask & (1u << q)) { const int row = e * 2048 + b * 512 + (int)sl; ++sl; rowtok[row] = tokg; gatev[row] = __uint_as_float(kk[q]); slot[(size_t)tokg * 16 + e] = row; }
            else slot[(size_t)tokg * 16 + e] = -1; }
        __syncthreads();
    }
}

__device__ __forceinline__ void phase_combine(const Frame& F, int layer, const float* xin, float* xout, bool next_norm) {
    const float* mod = WSP(float, OFF_MOD); const bf16_t* Y = WSP(bf16_t, OFF_YBUF); const int* slot = WSP(int, OFF_SLOT); bf16_t* hb = WSP(bf16_t, OFF_HB);
    for (int tb = F.bid; tb < 256; tb += F.nblk) {
        const int base = tb * 64 + F.wid * 8, b = base >> 12;
        const float* mb = mod + (size_t)(layer * 4 + b) * 6144;
        float npost[16], g2[16];
        load_row16(F.in[I_NFFN_POST] + layer * 1024, F.lane, npost); load_row16(mb + 5120, F.lane, g2);
        for (int i = 0; i < 8; ++i) {
            const int tok = base + i; float y[16];
#pragma unroll
            for (int q = 0; q < 16; ++q) y[q] = 0.f;
            const int myslot = slot[(size_t)tok * 16 + (F.lane & 15)];
            for (int e = 0; e < 16; ++e) { const int r = __shfl(myslot, e);
                if (r >= 0) { const uint4* yp = (const uint4*)(Y + (size_t)r * 1024 + F.lane * 16); const uint4 a = yp[0], c = yp[1];
                    y[0] += bflo(a.x); y[1] += bfhi(a.x); y[2] += bflo(a.y); y[3] += bfhi(a.y); y[4] += bflo(a.z); y[5] += bfhi(a.z); y[6] += bflo(a.w); y[7] += bfhi(a.w);
                    y[8] += bflo(c.x); y[9] += bfhi(c.x); y[10] += bflo(c.y); y[11] += bfhi(c.y); y[12] += bflo(c.z); y[13] += bfhi(c.z); y[14] += bflo(c.w); y[15] += bfhi(c.w); } }
            float ss = 0.f;
#pragma unroll
            for (int q = 0; q < 16; ++q) ss += y[q] * y[q];
            ss = wave_sum(ss); float rstd = rsqrtf(ss * (1.f / 1024.f) + 1e-6f);
            float xv[16]; load_row16(xin + (size_t)tok * 1024, F.lane, xv);
            float s2 = 0.f;
#pragma unroll
            for (int q = 0; q < 16; ++q) { xv[q] = xv[q] + g2[q] * (y[q] * rstd * npost[q]); s2 += xv[q] * xv[q]; }
            store_row16(xout + (size_t)tok * 1024, F.lane, xv);
            if (next_norm) {
                float gain[16], sc[16], sh[16]; const float* mn = mod + (size_t)((layer + 1) * 4 + b) * 6144;
                load_row16(F.in[I_NMIX_PRE] + (layer + 1) * 1024, F.lane, gain); load_row16(mn + 1024, F.lane, sc); load_row16(mn, F.lane, sh);
                s2 = wave_sum(s2); rstd = rsqrtf(s2 * (1.f / 1024.f) + 1e-6f);
#pragma unroll
                for (int q = 0; q < 16; ++q) y[q] = xv[q] * rstd * gain[q] * (1.f + sc[q]) + sh[q];
                store_row16_bf(hb + (size_t)tok * 1024, F.lane, y);
            }
        }
    }
}

__device__ __forceinline__ void phase_rwprep(const Frame& F) {
    const bf16_t* P1 = WSP(bf16_t, OFF_P1); float* rwr = WSP(float, OFF_RWR); float* rwk = WSP(float, OFF_RWK); float* rwv = WSP(float, OFF_RWV); float* rwkk = WSP(float, OFF_RWKK);
    bf16_t* lin = WSP(bf16_t, OFF_LORAIN); const float* mu = F.in[I_RW_MU];
    const int c0 = F.lane * 8;
    for (int tb = F.bid; tb < 256; tb += F.nblk) {
        const int base = tb * 64 + F.wid * 8;
        for (int i = 0; i < 8; ++i) {
            const size_t tok = base + i; const int s = (int)(tok & 4095);
            const bool hp = s > 0, hn = s < 4095;
            auto shifted = [&](int ch, float (&o)[8]) {
                const u32x4 z4 = (u32x4){0u, 0u, 0u, 0u};
                const u32x4 cur = *(const u32x4*)(P1 + tok * 3072 + ch);
                const u32x4 prv = hp ? *(const u32x4*)(P1 + (tok - 1) * 3072 + ch) : z4;
                const u32x4 nxt = hn ? *(const u32x4*)(P1 + (tok + 1) * 3072 + ch) : z4;
                const float4 m0 = *(const float4*)(mu + ch), m1 = *(const float4*)(mu + ch + 4);
                const float cu[8] = {bflo(cur.x), bfhi(cur.x), bflo(cur.y), bfhi(cur.y), bflo(cur.z), bfhi(cur.z), bflo(cur.w), bfhi(cur.w)};
                const float pr[8] = {bflo(prv.x), bfhi(prv.x), bflo(prv.y), bfhi(prv.y), bflo(prv.z), bfhi(prv.z), bflo(prv.w), bfhi(prv.w)};
                const float nx[8] = {bflo(nxt.x), bfhi(nxt.x), bflo(nxt.y), bfhi(nxt.y), bflo(nxt.z), bfhi(nxt.z), bflo(nxt.w), bfhi(nxt.w)};
                const float mm[8] = {m0.x, m0.y, m0.z, m0.w, m1.x, m1.y, m1.z, m1.w};
#pragma unroll
                for (int q = 0; q < 8; ++q) o[q] = cu[q] + mm[q] * (0.5f * (pr[q] + nx[q]) - cu[q]);
            };
            float v[8];
            shifted(c0, v);        { float4* o = (float4*)(rwr + tok * 512 + c0); o[0] = make_float4(v[0], v[1], v[2], v[3]); o[1] = make_float4(v[4], v[5], v[6], v[7]); }
            shifted(1024 + c0, v); { float4* o = (float4*)(rwv + tok * 512 + c0); o[0] = make_float4(v[0], v[1], v[2], v[3]); o[1] = make_float4(v[4], v[5], v[6], v[7]); }
            shifted(512 + c0, v);  { float4* o = (float4*)(rwk + tok * 512 + c0); o[0] = make_float4(v[0], v[1], v[2], v[3]); o[1] = make_float4(v[4], v[5], v[6], v[7]); }
            { const float4 k0 = *(const float4*)(F.in[I_RW_KK] + c0), k1 = *(const float4*)(F.in[I_RW_KK] + c0 + 4);
              float kk[8] = {v[0] * k0.x, v[1] * k0.y, v[2] * k0.z, v[3] * k0.w, v[4] * k1.x, v[5] * k1.y, v[6] * k1.z, v[7] * k1.w};
              float ss = 0.f;
#pragma unroll
              for (int q = 0; q < 8; ++q) ss += kk[q] * kk[q];
              ss += __shfl_xor(ss, 1); ss += __shfl_xor(ss, 2); ss += __shfl_xor(ss, 4);
              const float sc = rsqrtf(ss + 1e-6f);
              float4* o = (float4*)(rwkk + tok * 512 + c0); o[0] = make_float4(kk[0] * sc, kk[1] * sc, kk[2] * sc, kk[3] * sc); o[1] = make_float4(kk[4] * sc, kk[5] * sc, kk[6] * sc, kk[7] * sc); }
            if (F.lane < 48) { shifted(1536 + c0, v);
                float o8[8];
#pragma unroll
                for (int q = 0; q < 8; ++q) { const float x = v[q]; o8[q] = c0 < 128 ? (2.f * sigmoidf_(2.f * x) - 1.f) : (c0 < 256 ? x : sigmoidf_(x)); }
                *(u32x4*)(lin + tok * 384 + c0) = (u32x4){pk2(o8[0], o8[1]), pk2(o8[2], o8[3]), pk2(o8[4], o8[5]), pk2(o8[6], o8[7])}; }
        }
    }
}

__device__ __forceinline__ void phase_rwscan(const Frame& F) {
    float* bufA = (float*)F.smem;
    float* bufV = bufA + 2 * 32 * 320;
    const float* rwr = WSP(float, OFF_RWR); const float* rwk = WSP(float, OFF_RWK); const float* rwv = WSP(float, OFF_RWV); const float* rwkk = WSP(float, OFF_RWKK);
    const float* rwdec = WSP(float, OFF_RWDEC); const float* rwa = WSP(float, OFF_RWA); float* rwy = WSP(float, OFF_RWY);
    const int row4 = F.lane >> 4, kp = F.lane & 15, jj = F.wid * 4 + row4;
    for (int u = F.bid; u < 128; u += F.nblk) {
        const int rb = u & 1, seq = u >> 1, dir = seq & 1, h = (seq >> 1) & 7, b = seq >> 4;
        const float4 kaw = *(const float4*)(F.in[I_RW_KA] + h * 64 + kp * 4);
        float s0 = 0.f, s1 = 0.f, s2 = 0.f, s3 = 0.f;
        float4 ra0, ra1, ra2, ra3, ra4; float4 rv = make_float4(0.f, 0.f, 0.f, 0.f);
#define RW_LD1(dst, i, c) do { const int idx = F.tid + NTHR * (i), row = idx / 80, cc = idx % 80, arr = cc >> 4, c4 = cc & 15, step = (c) * 32 + row, t = dir ? 4095 - step : step; \
            const size_t tok = (size_t)b * 4096 + t; \
            const float* src = arr == 0 ? rwr : (arr == 1 ? rwk : (arr == 2 ? rwkk : (arr == 3 ? rwdec + (size_t)dir * T_ * 512 : rwa + (size_t)dir * T_ * 512))); \
            dst = *(const float4*)(src + tok * 512 + h * 64 + c4 * 4); } while (0)
#define RW_GLOAD(c) do { RW_LD1(ra0, 0, c); RW_LD1(ra1, 1, c); RW_LD1(ra2, 2, c); RW_LD1(ra3, 3, c); RW_LD1(ra4, 4, c); \
            if (F.tid < 256) { const int row = F.tid >> 3, c4 = F.tid & 7, step = (c) * 32 + row, t = dir ? 4095 - step : step; const size_t tok = (size_t)b * 4096 + t; \
                rv = *(const float4*)(rwv + tok * 512 + h * 64 + rb * 32 + c4 * 4); } } while (0)
#define RW_LSTORE(buf) do { *(float4*)(bufA + (buf) * 10240 + (F.tid) * 4) = ra0; *(float4*)(bufA + (buf) * 10240 + (F.tid + NTHR) * 4) = ra1; *(float4*)(bufA + (buf) * 10240 + (F.tid + 2 * NTHR) * 4) = ra2; \
            *(float4*)(bufA + (buf) * 10240 + (F.tid + 3 * NTHR) * 4) = ra3; *(float4*)(bufA + (buf) * 10240 + (F.tid + 4 * NTHR) * 4) = ra4; \
            if (F.tid < 256) *(float4*)(bufV + (buf) * 1024 + F.tid * 4) = rv; } while (0)
        RW_GLOAD(0); RW_LSTORE(0); __syncthreads();
        for (int c = 0; c < 128; ++c) {
            const int buf = c & 1;
            if (c + 1 < 128) RW_GLOAD(c + 1);
            float osel = 0.f;
#pragma unroll 4
            for (int i = 0; i < 32; ++i) {
                const float* row = bufA + buf * 10240 + i * 320 + kp * 4;
                const float4 r = *(const float4*)(row), k = *(const float4*)(row + 64), kk = *(const float4*)(row + 128), w = *(const float4*)(row + 192), a = *(const float4*)(row + 256);
                const float v = bufV[buf * 1024 + i * 32 + jj];
                float sa = -(s0 * kk.x + s1 * kk.y + s2 * kk.z + s3 * kk.w);
                sa = row16_sum(sa);
                const float kd0 = k.x * (1.f + (a.x - 1.f) * kaw.x), kd1 = k.y * (1.f + (a.y - 1.f) * kaw.y), kd2 = k.z * (1.f + (a.z - 1.f) * kaw.z), kd3 = k.w * (1.f + (a.w - 1.f) * kaw.w);
                s0 = s0 * w.x + sa * (kk.x * a.x) + v * kd0; s1 = s1 * w.y + sa * (kk.y * a.y) + v * kd1; s2 = s2 * w.z + sa * (kk.z * a.z) + v * kd2; s3 = s3 * w.w + sa * (kk.w * a.w) + v * kd3;
                float y = s0 * r.x + s1 * r.y + s2 * r.z + s3 * r.w;
                y = row16_sum(y);
                osel = (kp == (i & 15)) ? y : osel;
                if ((i & 15) == 15) { const int step = c * 32 + (i & 16) + kp, t = dir ? 4095 - step : step;
                    rwy[((size_t)dir * T_ + (size_t)b * 4096 + t) * 512 + h * 64 + rb * 32 + jj] = osel; }
            }
            if (c + 1 < 128) RW_LSTORE(buf ^ 1);
            __syncthreads();
        }
    }
#undef RW_LD1
#undef RW_GLOAD
#undef RW_LSTORE
}

__device__ __forceinline__ void phase_rwpost(const Frame& F) {
    const float* rwr = WSP(float, OFF_RWR); const float* rwk = WSP(float, OFF_RWK); const float* rwv = WSP(float, OFF_RWV);
    const float* rwa = WSP(float, OFF_RWA); const float* rwg = WSP(float, OFF_RWG); const float* rwy = WSP(float, OFF_RWY); bf16_t* ycat = WSP(bf16_t, OFF_YCAT);
    const int c0 = F.lane * 8;
    float lnw[8], lnb[8], kaw[8], rk[8];
#pragma unroll
    for (int q = 0; q < 8; ++q) { lnw[q] = F.in[I_RW_LNW][c0 + q]; lnb[q] = F.in[I_RW_LNB][c0 + q]; kaw[q] = F.in[I_RW_KA][c0 + q]; rk[q] = F.in[I_RW_RK][c0 + q]; }
    for (int tb = F.bid; tb < 256; tb += F.nblk) {
        const int base = tb * 64 + F.wid * 8;
        for (int i = 0; i < 8; ++i) { const size_t tok = base + i;
            float y[8], r[8], k[8], v[8], a0[8], a1[8], g[8];
            auto ld8 = [&](const float* p, float (&o)[8]) { const float4 x0 = *(const float4*)(p + tok * 512 + c0), x1 = *(const float4*)(p + tok * 512 + c0 + 4); o[0] = x0.x; o[1] = x0.y; o[2] = x0.z; o[3] = x0.w; o[4] = x1.x; o[5] = x1.y; o[6] = x1.z; o[7] = x1.w; };
            ld8(rwy, y); ld8(rwy + (size_t)T_ * 512, r);
#pragma unroll
            for (int q = 0; q < 8; ++q) y[q] += r[q];
            ld8(rwr, r); ld8(rwk, k); ld8(rwv, v); ld8(rwa, a0); ld8(rwa + (size_t)T_ * 512, a1); ld8(rwg, g);
            float sm = 0.f;
#pragma unroll
            for (int q = 0; q < 8; ++q) sm += y[q];
            sm += __shfl_xor(sm, 1); sm += __shfl_xor(sm, 2); sm += __shfl_xor(sm, 4);
            const float mean = sm * (1.f / 64.f);
            float vs = 0.f;
#pragma unroll
            for (int q = 0; q < 8; ++q) { y[q] -= mean; vs += y[q] * y[q]; }
            vs += __shfl_xor(vs, 1); vs += __shfl_xor(vs, 2); vs += __shfl_xor(vs, 4);
            const float rstd = rsqrtf(vs * (1.f / 64.f) + 64e-5f);
            float dot = 0.f;
#pragma unroll
            for (int q = 0; q < 8; ++q) { const float kb = k[q] * (1.f + (0.5f * (a0[q] + a1[q]) - 1.f) * kaw[q]); dot += r[q] * kb * rk[q]; }
            dot += __shfl_xor(dot, 1); dot += __shfl_xor(dot, 2); dot += __shfl_xor(dot, 4);
            float o[8];
#pragma unroll
            for (int q = 0; q < 8; ++q) o[q] = (y[q] * rstd * lnw[q] + lnb[q] + dot * v[q]) * g[q];
            *(u32x4*)(ycat + tok * 1024 + c0) = (u32x4){pk2(o[0], o[1]), pk2(o[2], o[3]), pk2(o[4], o[5]), pk2(o[6], o[7])};
        }
    }
}

__device__ __forceinline__ void phase_attn(const Frame& F) {
    LAS unsigned char* lds = F.lds;
    const bf16_t* P1 = WSP(bf16_t, OFF_P1); const bf16_t* Vimg = WSP(bf16_t, OFF_VIMG); bf16_t* ycat = WSP(bf16_t, OFF_YCAT);
    constexpr int QS = 0, KS = 65536, VS = 81920;
    const float lam_init = 0.8f - 0.6f * 0.7408182206817179f;
    float lam;
    { const float* lp = F.in[I_DF_LAM]; float s1 = 0.f, s2 = 0.f;
      for (int i = 0; i < 64; ++i) { s1 += lp[i] * lp[64 + i]; s2 += lp[128 + i] * lp[192 + i]; }
      lam = __expf(s1) - __expf(s2) + lam_init; }
    const int hh = F.lane >> 5, ql = F.lane & 31;
    for (int u = F.bid; u < 256; u += F.nblk) {
        const int qb = u & 15, h = (u >> 4) & 3, b = u >> 6;
        const float slope2 = exp2f(-2.f * (float)(h + 1)) * 1.4426950408889634f;
        const size_t tok0 = (size_t)b * 4096 + qb * 256;
        int tz = F.tid; asm volatile("" : "+v"(tz));
#pragma unroll
        for (int i = 0; i < 8; ++i) { const int idx = tz + NTHR * i, row = idx >> 4, pos = idx & 15, col16 = pos ^ (row & 15);
            const u32x4 qv = *(const u32x4*)(P1 + (tok0 + row) * 3072 + 1920 + h * 128 + col16 * 8);
            const float sc = 0.18033688011112042f;
            u32x4 o; o.x = pk2(bflo(qv.x) * sc, bfhi(qv.x) * sc); o.y = pk2(bflo(qv.y) * sc, bfhi(qv.y) * sc); o.z = pk2(bflo(qv.z) * sc, bfhi(qv.z) * sc); o.w = pk2(bflo(qv.w) * sc, bfhi(qv.w) * sc);
            *(LAS u32x4*)(lds + QS + row * 256 + pos * 16) = o; }
        const int qrow = F.wid * 32 + ql;
        const float qpos = (float)(qb * 256 + qrow);
        unsigned osave[4][8];
        for (int m = 0; m < 2; ++m) {
#define AT_STAGE(kt, buf) do { { const int ci = F.wid, row = ci * 8 + (F.lane >> 3), pos = F.lane & 7, col16 = pos ^ ((row >> 1) & 7); \
                __builtin_amdgcn_global_load_lds((const unsigned*)(P1 + ((size_t)b * 4096 + (kt) * 64 + row) * 3072 + 2432 + h * 128 + m * 64 + col16 * 8), (LAS unsigned*)(lds + KS + (buf) * 8192 + ci * 1024), 16, 0, 0); } \
            _Pragma("unroll") for (int _i = 0; _i < 2; ++_i) { const int ci = F.wid * 2 + _i; \
                __builtin_amdgcn_global_load_lds((const unsigned*)(Vimg + (((size_t)(b * 4 + h) * 64 + (kt)) * 8192) + ci * 512 + F.lane * 8), (LAS unsigned*)(lds + VS + (buf) * 16384 + ci * 1024), 16, 0, 0); } } while (0)
            AT_STAGE(0, 0);
            f32x16 O[4];
#pragma unroll
            for (int dt = 0; dt < 4; ++dt)
#pragma unroll
                for (int r = 0; r < 16; ++r) O[dt][r] = 0.f;
            float mrun = -1e30f, lrun = 0.f;
            asm volatile("s_waitcnt vmcnt(0)" ::: "memory");
            __syncthreads();
            for (int kt = 0; kt < 64; ++kt) {
                const int buf = kt & 1;
                if (kt + 1 < 64) AT_STAGE(kt + 1, buf ^ 1);
                const float dbase = (float)(kt * 64 + 4 * hh) - qpos;
                f32x16 Sx[2];
#pragma unroll
                for (int k2 = 0; k2 < 2; ++k2) {
#pragma unroll
                    for (int r = 0; r < 16; ++r) Sx[k2][r] = 0.f;
#pragma unroll
                    for (int s = 0; s < 4; ++s) { const int col16 = s * 2 + hh; const int key = k2 * 32 + ql;
                        const bf16x8 kf = *(const LAS bf16x8*)(lds + KS + buf * 8192 + key * 128 + ((col16 ^ ((key >> 1) & 7)) * 16));
                        const int qc16 = m * 8 + s * 2 + hh; const bf16x8 qf = *(const LAS bf16x8*)(lds + QS + qrow * 256 + ((qc16 ^ (qrow & 15)) * 16));
                        Sx[k2] = __builtin_amdgcn_mfma_f32_32x32x16_bf16(kf, qf, Sx[k2], 0, 0, 0); }
                    asm volatile("" ::: "memory"); }
                float mt = -1e30f;
#pragma unroll
                for (int k2 = 0; k2 < 2; ++k2)
#pragma unroll
                    for (int r = 0; r < 16; ++r) { const float dd = dbase + (float)(k2 * 32 + (r & 3) + 8 * (r >> 2));
                        const float tv = Sx[k2][r] - slope2 * fabsf(dd); Sx[k2][r] = tv; mt = fmaxf(mt, tv); }
                mt = fmaxf(mt, __shfl_xor(mt, 32));
                const float mnew = fmaxf(mrun, mt), alpha = __builtin_amdgcn_exp2f(mrun - mnew);
                float ls = 0.f;
#pragma unroll
                for (int k2 = 0; k2 < 2; ++k2)
#pragma unroll
                    for (int r = 0; r < 16; ++r) { const float pv = __builtin_amdgcn_exp2f(Sx[k2][r] - mnew); Sx[k2][r] = pv; ls += pv; }
                lrun = lrun * alpha + ls; mrun = mnew;
                bf16x8 Pp[4];
#pragma unroll
                for (int ks = 0; ks < 4; ++ks) { const int k2 = ks >> 1, r0 = (ks & 1) * 8; bf16x8 pf;
#pragma unroll
                    for (int j = 0; j < 4; ++j) { const unsigned w2 = pg8::cvt_pk_bf16(Sx[k2][r0 + 2 * j], Sx[k2][r0 + 2 * j + 1]); pf[2 * j] = (short)(w2 & 0xFFFFu); pf[2 * j + 1] = (short)(w2 >> 16); }
                    Pp[ks] = pf; }
#pragma unroll
                for (int dt = 0; dt < 4; ++dt)
#pragma unroll
                    for (int r = 0; r < 16; ++r) O[dt][r] *= alpha;
#pragma unroll
                for (int dt = 0; dt < 4; ++dt) {
#pragma unroll
                    for (int ks = 0; ks < 4; ++ks) { const int dv = dt * 32 + ql;
                        const bf16x4 v1 = *(const LAS bf16x4*)(lds + VS + buf * 16384 + (4 * ks + hh) * 1024 + dv * 8);
                        const bf16x4 v2 = *(const LAS bf16x4*)(lds + VS + buf * 16384 + (4 * ks + 2 + hh) * 1024 + dv * 8);
                        const bf16x8 vf = (bf16x8){v1[0], v1[1], v1[2], v1[3], v2[0], v2[1], v2[2], v2[3]};
                        O[dt] = __builtin_amdgcn_mfma_f32_32x32x16_bf16(vf, Pp[ks], O[dt], 0, 0, 0); }
                    asm volatile("" ::: "memory"); }
                asm volatile("s_waitcnt vmcnt(0)" ::: "memory");
                __syncthreads();
            }
#undef AT_STAGE
            const float lt = lrun + __shfl_xor(lrun, 32);
            if (m == 0) { const float i0 = 1.f / lt;
#pragma unroll
                for (int dt = 0; dt < 4; ++dt)
#pragma unroll
                    for (int j = 0; j < 8; ++j) osave[dt][j] = pk2(O[dt][2 * j] * i0, O[dt][2 * j + 1] * i0);
            } else {
                const float i1 = lam / lt;
                float ss = 0.f;
#pragma unroll
                for (int dt = 0; dt < 4; ++dt)
#pragma unroll
                    for (int j = 0; j < 8; ++j) { const float oa = bflo(osave[dt][j]) - O[dt][2 * j] * i1, ob = bfhi(osave[dt][j]) - O[dt][2 * j + 1] * i1; O[dt][2 * j] = oa; O[dt][2 * j + 1] = ob; ss += oa * oa + ob * ob; }
                ss += __shfl_xor(ss, 32);
                const float rstd = rsqrtf(ss * (1.f / 128.f) + 1e-5f) * (1.f - lam_init);
                bf16_t* orow = ycat + (tok0 + qrow) * 1024 + 512 + h * 128;
#pragma unroll
                for (int dt = 0; dt < 4; ++dt)
#pragma unroll
                    for (int gq = 0; gq < 4; ++gq) { const int dv = dt * 32 + 8 * gq + 4 * hh; const float4 sw = *(const float4*)(F.in[I_DF_SUBLN] + dv);
                        u32x2 pk; pk.x = pk2(O[dt][4 * gq] * rstd * sw.x, O[dt][4 * gq + 1] * rstd * sw.y); pk.y = pk2(O[dt][4 * gq + 2] * rstd * sw.z, O[dt][4 * gq + 3] * rstd * sw.w);
                        *(u32x2*)(orow + dv) = pk; }
            }
        }
        __syncthreads();
    }
}
constexpr int N_PHASES = 23;
__global__ void __launch_bounds__(NTHR, 2) fwd(Args args) {
    extern __shared__ __attribute__((aligned(16))) unsigned char smem[];
    Frame F;
    const int wid_s = __builtin_amdgcn_readfirstlane((int)threadIdx.x >> 6);
    F.smem = smem; F.lds = (LAS unsigned char*)smem; F.wid = wid_s; F.lane = my_lane(); F.tid = wid_s * 64 + F.lane;
    F.bid = blockIdx.x; F.nblk = gridDim.x; F.in = args.in; F.out = args.out; F.ws = args.ws;
#define FRESH() do { int l_ = my_lane(); asm volatile("" : "+v"(l_)); F.lane = l_; F.wid = wid_s; F.tid = wid_s * 64 + l_; } while (0)
    volatile LAS unsigned* xbw = (volatile LAS unsigned*)(F.lds + LDS_MAIN);
    if (F.tid < 4) xbw[F.tid] = 0u;
    __syncthreads();
    const int lo = args.ph_lo, hi = args.ph_hi;
    XcdBarrier bar; bar.bar = (unsigned*)(args.ws + OFF_BAR); bar.x = 0; bar.st = xbw;
    if (hi - lo > 1) bar = xcd_barrier_post((unsigned*)(args.ws + OFF_BAR), xbw, F.tid);
#define IN(k) (lo <= (k) && (k) < hi)
#define SEAM(k) do { if (IN(k) && IN((k) + 1)) { FRESH(); xcd_barrier(bar, F.tid); } } while (0)
    float* xa = WSP(float, OFF_XA); float* xb = WSP(float, OFF_XB);
    const int G = F.nblk, c = F.bid;

    if (IN(0)) { FRESH(); phase_mod(F); __syncthreads(); phase_convert(F); } SEAM(0);
    if (IN(1)) { FRESH(); phase_norm0(F); } SEAM(1);
    if (IN(2)) { FRESH();
        pg8::Gemm g{WSP(bf16_t, OFF_HB), WSP(bf16_t, OFF_WIN0T), 1024, 1024, 1024, nullptr}; pg8::StaticOrder S; S.init(T_, 2560, G, c);
        EpiBf16Plain E{WSP(bf16_t, OFF_P0), 2560, 2560};
        pg8::gemm_phase<EpiBf16Plain, pg8::StaticOrder, false>(F.lds, g, S, E, F.tid);
    } SEAM(2);
    if (IN(3)) { FRESH(); phase_dnprep(F); } SEAM(3);
    if (IN(4)) { FRESH(); phase_dnscan(F); __syncthreads(); phase_s5scan(F); } SEAM(4);
    if (IN(5)) { FRESH(); phase_post0(F); } SEAM(5);
    if (IN(6)) { FRESH();
        pg8::Gemm g{WSP(bf16_t, OFF_YS5), WSP(bf16_t, OFF_WGLUT), 512, 512, 512, nullptr}; pg8::StaticOrder S; S.init(T_, 512, G, c);
        EpiGlu E{WSP(bf16_t, OFF_YS5), F.in[I_S5_GLUB], WSP(bf16_t, OFF_YCAT)};
        pg8::gemm_phase<EpiGlu, pg8::StaticOrder, false>(F.lds, g, S, E, F.tid);
    } SEAM(6);
    if (IN(7)) { FRESH();
        pg8::Gemm g{WSP(bf16_t, OFF_YCAT), WSP(bf16_t, OFF_WOUT0T), 1024, 1024, 1024, nullptr}; pg8::StaticOrder S; S.init(T_, 1024, G, c);
        EpiF32 E{WSP(float, OFF_YMIX), 1024};
        pg8::gemm_phase<EpiF32, pg8::StaticOrder, false>(F.lds, g, S, E, F.tid);
    } SEAM(7);
    if (IN(8)) { FRESH(); phase_mid(F, 0, F.in[I_X], xa); } SEAM(8);
    if (IN(9)) { FRESH(); phase_topk(F); } SEAM(9);
    if (IN(10)) { FRESH();
        pg8::Gemm g{WSP(bf16_t, OFF_HB), (const bf16_t*)(F.ws + OFF_W1T), 1024, 1024, 1024, WSP(int, OFF_ROWTOK)}; pg8::MoeOrder S{176, 22, G, c};
        EpiSwiglu E{WSP(bf16_t, OFF_HBUF)};
        pg8::gemm_phase<EpiSwiglu, pg8::MoeOrder, true>(F.lds, g, S, E, F.tid);
    } SEAM(10);
    if (IN(11)) { FRESH();
        pg8::Gemm g{WSP(bf16_t, OFF_HBUF), (const bf16_t*)(F.ws + OFF_W2T), F_, F_, F_, nullptr}; pg8::MoeOrder S{32, 4, G, c};
        EpiDown E{WSP(bf16_t, OFF_YBUF), WSP(float, OFF_GATEV)};
        pg8::gemm_phase<EpiDown, pg8::MoeOrder, false>(F.lds, g, S, E, F.tid);
    } SEAM(11);
    if (IN(12)) { FRESH(); phase_combine(F, 0, xa, xb, true); } SEAM(12);
    if (IN(13)) { FRESH();
        { pg8::Gemm g{WSP(bf16_t, OFF_HB), WSP(bf16_t, OFF_WIN1T), 1024, 1024, 1024, nullptr}; pg8::StaticOrder S; S.init(T_, 3072, G, c);
          EpiBf16Plain E{WSP(bf16_t, OFF_P1), 3072, 2944};
          pg8::gemm_phase<EpiBf16Plain, pg8::StaticOrder, false>(F.lds, g, S, E, F.tid); }
        { pg8::Gemm g{WSP(bf16_t, OFF_WVT), WSP(bf16_t, OFF_HB), 1024, 1024, 1024, nullptr}; pg8::StaticOrder S; S.init(512, T_, G, c);
          EpiVimg E{WSP(bf16_t, OFF_VIMG)};
          pg8::gemm_phase<EpiVimg, pg8::StaticOrder, false>(F.lds, g, S, E, F.tid); }
    } SEAM(13);
    if (IN(14)) { FRESH(); phase_rwprep(F); } SEAM(14);
    if (IN(15)) { FRESH();
        pg8::Gemm g{WSP(bf16_t, OFF_LORAIN), WSP(bf16_t, OFF_WLORAT), 384, 384, 384, nullptr}; pg8::StaticOrder S; S.init(T_, 2560, G, c);
        EpiLora E{WSP(float, OFF_RWDEC), WSP(float, OFF_RWA), WSP(float, OFF_RWG), F.in[I_RW_W0], F.in[I_RW_A0]};
        pg8::gemm_phase<EpiLora, pg8::StaticOrder, false>(F.lds, g, S, E, F.tid);
    } SEAM(15);
    if (IN(16)) { FRESH(); phase_rwscan(F); __syncthreads(); phase_attn(F); } SEAM(16);
    if (IN(17)) { FRESH(); phase_rwpost(F); } SEAM(17);
    if (IN(18)) { FRESH();
        pg8::Gemm g{WSP(bf16_t, OFF_YCAT), WSP(bf16_t, OFF_WOUT1T), 1024, 1024, 1024, nullptr}; pg8::StaticOrder S; S.init(T_, 1024, G, c);
        EpiF32 E{WSP(float, OFF_YMIX), 1024};
        pg8::gemm_phase<EpiF32, pg8::StaticOrder, false>(F.lds, g, S, E, F.tid);
    } SEAM(18);
    if (IN(19)) { FRESH(); phase_mid(F, 1, xb, xa); } SEAM(19);
    if (IN(20)) { FRESH(); phase_topk(F); } SEAM(20);
    if (IN(21)) { FRESH();
        pg8::Gemm g{WSP(bf16_t, OFF_HB), (const bf16_t*)(F.ws + OFF_W1T + W1T_LAYER), 1024, 1024, 1024, WSP(int, OFF_ROWTOK)}; pg8::MoeOrder S{176, 22, G, c};
        EpiSwiglu E{WSP(bf16_t, OFF_HBUF)};
        pg8::gemm_phase<EpiSwiglu, pg8::MoeOrder, true>(F.lds, g, S, E, F.tid);
    }
    SEAM(21);
    if (IN(22)) { FRESH();
        pg8::Gemm g{WSP(bf16_t, OFF_HBUF), (const bf16_t*)(F.ws + OFF_W2T + W2T_LAYER), F_, F_, F_, nullptr}; pg8::MoeOrder S{32, 4, G, c};
        EpiDown E{WSP(bf16_t, OFF_YBUF), WSP(float, OFF_GATEV)};
        pg8::gemm_phase<EpiDown, pg8::MoeOrder, false>(F.lds, g, S, E, F.tid);
    } SEAM(22);
    if (IN(23)) { FRESH(); phase_combine(F, 1, xa, F.out, false); }
#undef IN
#undef SEAM
#undef FRESH
}

#ifndef ONE_LAUNCH
#define ONE_LAUNCH 1
#endif
extern "C" void kernel_launch(void* const* d_in, const int* in_sizes, int n_in, void* d_out, int out_size, void* d_ws, size_t ws_size, hipStream_t stream) {
    static int grid = 0;
    if (grid == 0) {
        int dev = 0, cus = 0, per_cu = 0;
        if (n_in != 43 || ws_size < WS_NEED) { fprintf(stderr, "kernel_launch: unexpected inputs (%d) or workspace (%zu < %zu)\n", n_in, ws_size, (size_t)WS_NEED); grid = -1; return; }
        if (hipGetDevice(&dev) != hipSuccess || hipDeviceGetAttribute(&cus, hipDeviceAttributeMultiprocessorCount, dev) != hipSuccess) { grid = -1; return; }
        if (hipFuncSetAttribute((const void*)fwd, hipFuncAttributeMaxDynamicSharedMemorySize, LDS_BYTES) != hipSuccess) { fprintf(stderr, "kernel_launch: hipFuncSetAttribute failed\n"); grid = -1; return; }
        if (hipOccupancyMaxActiveBlocksPerMultiprocessor(&per_cu, (const void*)fwd, NTHR, LDS_BYTES) != hipSuccess || per_cu < 1) { fprintf(stderr, "kernel_launch: occupancy query says %d\n", per_cu); (void)hipGetLastError(); }
        grid = cus;
    }
    if (grid < 0) return;
    (void)hipMemsetAsync((char*)d_ws + OFF_BAR, 0, 16384, stream);
    Args a{};
    for (int i = 0; i < 43; ++i) a.in[i] = (const float*)d_in[i];
    a.out = (float*)d_out; a.ws = (unsigned char*)d_ws;
#if ONE_LAUNCH
    a.ph_lo = 0; a.ph_hi = N_PHASES + 1;
    hipLaunchKernelGGL(fwd, dim3(grid), dim3(NTHR), LDS_BYTES, stream, a);
#else
    for (int ph = 0; ph <= N_PHASES; ++ph) { a.ph_lo = ph; a.ph_hi = ph + 1; hipLaunchKernelGGL(fwd, dim3(grid), dim3(NTHR), LDS_BYTES, stream, a); }
#endif
}
```

```cpp
#include <hip/hip_runtime.h>
#include <stdint.h>
#include <stdio.h>

#define LAS __attribute__((address_space(3)))
typedef unsigned short bf16_t;
typedef short bf16x8 __attribute__((ext_vector_type(8)));
typedef short bf16x4 __attribute__((ext_vector_type(4)));
typedef float f32x4 __attribute__((ext_vector_type(4)));
typedef float f32x16 __attribute__((ext_vector_type(16)));
typedef unsigned u32x4 __attribute__((ext_vector_type(4)));
typedef unsigned u32x2 __attribute__((ext_vector_type(2)));

constexpr int T_ = 16384, D_ = 1024, B_ = 4, S_ = 4096, E_ = 16, CAP_ = 512, F_ = 2816;
constexpr int NTHR = 512;
constexpr int LDS_MAIN = 147456;
constexpr int LDS_BYTES = LDS_MAIN + 64;

constexpr size_t al256(size_t x) { return (x + 255) & ~(size_t)255; }
constexpr size_t OFF_BAR    = 0;
constexpr size_t OFF_MOD    = 16384;
constexpr size_t OFF_WIN0T  = OFF_MOD    + al256((size_t)2 * 4 * 6144 * 4);
constexpr size_t OFF_WGLUT  = OFF_WIN0T  + (size_t)2560 * 1024 * 2;
constexpr size_t OFF_WOUT0T = OFF_WGLUT  + (size_t)512 * 512 * 2;
constexpr size_t OFF_WIN1T  = OFF_WOUT0T + (size_t)1024 * 1024 * 2;
constexpr size_t OFF_WVT    = OFF_WIN1T  + (size_t)3072 * 1024 * 2;
constexpr size_t OFF_WOUT1T = OFF_WVT    + (size_t)512 * 1024 * 2;
constexpr size_t OFF_WLORAT = OFF_WOUT1T + (size_t)1024 * 1024 * 2;
constexpr size_t OFF_W1T    = OFF_WLORAT + (size_t)2560 * 384 * 2;
constexpr size_t W1T_LAYER  = (size_t)16 * 5632 * 1024 * 2;
constexpr size_t OFF_W2T    = OFF_W1T    + 2 * W1T_LAYER;
constexpr size_t W2T_LAYER  = (size_t)16 * 1024 * 2816 * 2;
constexpr size_t OFF_HB     = OFF_W2T    + 2 * W2T_LAYER;
constexpr size_t OFF_XA     = OFF_HB     + (size_t)T_ * 1024 * 2;
constexpr size_t OFF_XB     = OFF_XA     + (size_t)T_ * 1024 * 4;
constexpr size_t OFF_YMIX   = OFF_XB     + (size_t)T_ * 1024 * 4;
constexpr size_t OFF_YCAT   = OFF_YMIX   + (size_t)T_ * 1024 * 4;
constexpr size_t OFF_PROBS  = OFF_YCAT   + (size_t)T_ * 1024 * 2;
constexpr size_t OFF_ROWTOK = OFF_PROBS  + (size_t)4 * 16 * 4096 * 4;
constexpr size_t OFF_GATEV  = OFF_ROWTOK + (size_t)32768 * 4;
constexpr size_t OFF_SLOT   = OFF_GATEV  + (size_t)32768 * 4;
constexpr size_t OFF_SCR    = OFF_SLOT   + (size_t)T_ * 16 * 4;
constexpr size_t OFF_P0     = OFF_SCR;
constexpr size_t OFF_GB0    = OFF_P0     + (size_t)T_ * 2560 * 2;
constexpr size_t OFF_QKVN   = OFF_GB0    + (size_t)T_ * 16 * 4;
constexpr size_t OFF_DNO    = OFF_QKVN   + (size_t)T_ * 1536 * 4;
constexpr size_t OFF_S5Y    = OFF_DNO    + (size_t)2 * T_ * 512 * 4;
constexpr size_t OFF_YS5    = OFF_S5Y    + (size_t)2 * T_ * 512 * 4;
constexpr size_t OFF_DN_GCS = OFF_YS5    + (size_t)T_ * 512 * 2;
constexpr size_t OFF_DN_AM  = OFF_DN_GCS + (size_t)2048 * 64 * 4;
constexpr size_t OFF_DN_TM  = OFF_DN_AM  + (size_t)2048 * 4096 * 2;
constexpr size_t OFF_DN_QE  = OFF_DN_TM  + (size_t)2048 * 4096 * 2;
constexpr size_t OFF_DN_YI  = OFF_DN_QE  + (size_t)2048 * 8192 * 2;
constexpr size_t OFF_DN_PHI = OFF_DN_YI  + (size_t)2048 * 16384;
constexpr size_t OFF_DN_C   = OFF_DN_PHI + (size_t)2048 * 32768;
constexpr size_t END_L0     = OFF_DN_C   + (size_t)2048 * 32768;
constexpr size_t OFF_HBUF   = OFF_SCR;
constexpr size_t OFF_YBUF   = OFF_HBUF   + (size_t)32768 * 2816 * 2;
constexpr size_t END_MOE    = OFF_YBUF   + (size_t)32768 * 1024 * 2;
constexpr size_t OFF_P1     = OFF_SCR;
constexpr size_t OFF_VIMG   = OFF_P1     + (size_t)T_ * 3072 * 2;
constexpr size_t OFF_RWR    = OFF_VIMG   + (size_t)512 * T_ * 2;
constexpr size_t OFF_RWK    = OFF_RWR    + (size_t)T_ * 512 * 4;
constexpr size_t OFF_RWV    = OFF_RWK    + (size_t)T_ * 512 * 4;
constexpr size_t OFF_RWKK   = OFF_RWV    + (size_t)T_ * 512 * 4;
constexpr size_t OFF_LORAIN = OFF_RWKK   + (size_t)T_ * 512 * 4;
constexpr size_t OFF_RWDEC  = OFF_LORAIN + (size_t)T_ * 384 * 2;
constexpr size_t OFF_RWA    = OFF_RWDEC  + (size_t)2 * T_ * 512 * 4;
constexpr size_t OFF_RWG    = OFF_RWA    + (size_t)2 * T_ * 512 * 4;
constexpr size_t OFF_RWY    = OFF_RWG    + (size_t)T_ * 512 * 4;
constexpr size_t END_L1     = OFF_RWY    + (size_t)2 * T_ * 512 * 4;
constexpr size_t WS_NEED    = END_L1 > END_L0 ? (END_L1 > END_MOE ? END_L1 : END_MOE) : (END_L0 > END_MOE ? END_L0 : END_MOE);
static_assert(WS_NEED < (size_t)1470000000, "workspace budget");

struct Args { const float* in[43]; float* out; unsigned char* ws; int ph_lo, ph_hi; };

enum { I_X = 0, I_C, I_ADA_W, I_ADA_B, I_NMIX_PRE, I_NMIX_POST, I_NFFN_PRE, I_NFFN_POST, I_ROUTER, I_WGATE, I_WUP, I_WDOWN,
       I_AB_IN, I_AB_OUT, I_DN_CONV, I_DN_ALOG, I_DN_DTB, I_DN_NORM, I_S5_ARE, I_S5_AIM, I_S5_LDT, I_S5_BRE, I_S5_BIM, I_S5_CRE, I_S5_CIM,
       I_S5_D, I_S5_GLUW, I_S5_GLUB, I_CD_IN, I_CD_OUT, I_RW_MU, I_RW_W0, I_RW_W2, I_RW_A0, I_RW_A2, I_RW_G2, I_RW_KK, I_RW_KA, I_RW_RK,
       I_RW_LNW, I_RW_LNB, I_DF_LAM, I_DF_SUBLN };

__device__ __forceinline__ bf16_t f2bf(float f) { unsigned u = __float_as_uint(f); u += 0x7FFFu + ((u >> 16) & 1u); return (bf16_t)(u >> 16); }
__device__ __forceinline__ float bf2f(bf16_t b) { return __uint_as_float(((unsigned)b) << 16); }
__device__ __forceinline__ unsigned pk2(float lo, float hi) { return (unsigned)f2bf(lo) | ((unsigned)f2bf(hi) << 16); }
__device__ __forceinline__ float bflo(unsigned u) { return __uint_as_float(u << 16); }
__device__ __forceinline__ float bfhi(unsigned u) { return __uint_as_float(u & 0xFFFF0000u); }
__device__ __forceinline__ float wave_sum(float v) {
#pragma unroll
    for (int o = 32; o; o >>= 1) v += __shfl_xor(v, o);
    return v;
}
__device__ __forceinline__ float sigmoidf_(float x) { return 1.f / (1.f + __expf(-x)); }
__device__ __forceinline__ float siluf_(float x) { return x / (1.f + __expf(-x)); }
__device__ __forceinline__ float softplusf_(float x) { return fmaxf(x, 0.f) + __logf(1.f + __expf(-fabsf(x))); }
__device__ __forceinline__ float gelu_tanhf_(float x) { const float u = 0.7978845608028654f * (x + 0.044715f * x * x * x); const float t = 2.f / (1.f + __expf(-2.f * u)) - 1.f; return 0.5f * x * (1.f + t); }
template <int CTRL> __device__ __forceinline__ float dppf(float x) { return __int_as_float(__builtin_amdgcn_update_dpp(0, __float_as_int(x), CTRL, 0xF, 0xF, true)); }
__device__ __forceinline__ float row16_sum(float x) { x += dppf<0x128>(x); x += dppf<0x124>(x); x += dppf<0x122>(x); x += dppf<0x121>(x); return x; }

#define XB_TMO      128
#define XB_XCNT(j)  (256  + 64 * (j))
#define XB_XSUB(j)  (1280 + 64 * (j))
#define XB_XGEN(j)  (2304 + 64 * (j))
#define XB_TOP      3328
#define XB_TOPGEN   3392
#define XCD_BAR_WORDS 3456
#define XB_SPIN_CAP (1u << 27)
__device__ __forceinline__ unsigned xb_ld(unsigned* p)              { return __hip_atomic_load(p, __ATOMIC_RELAXED, __HIP_MEMORY_SCOPE_AGENT); }
__device__ __forceinline__ unsigned xb_add(unsigned* p, unsigned v) { return __hip_atomic_fetch_add(p, v, __ATOMIC_RELAXED, __HIP_MEMORY_SCOPE_AGENT); }
__device__ __forceinline__ unsigned xb_xcc_id() { return (unsigned)__builtin_amdgcn_s_getreg((3 << 11) | 20) & 0xFu; }
#define XB_SPIN(cond, bar) do { unsigned _sp = 0; while (cond) { __builtin_amdgcn_s_sleep(1); \
    if ((++_sp & 255u) == 0u) { if (xb_ld(&(bar)[XB_TMO])) break; if (_sp > XB_SPIN_CAP) { atomicAdd(&(bar)[XB_TMO], 1u); break; } } } } while (0)
struct XcdBarrier { unsigned* bar; unsigned x; volatile LAS unsigned* st; };
__device__ __forceinline__ int my_lane() { int l; asm volatile("v_mbcnt_lo_u32_b32 %0, -1, 0\n\tv_mbcnt_hi_u32_b32 %0, -1, %0" : "=v"(l)); return l; }
__device__ __forceinline__ XcdBarrier xcd_barrier_post(unsigned* bar, volatile LAS unsigned* st, int tid) {
    XcdBarrier b; b.bar = bar; b.x = xb_xcc_id(); b.st = st;
    if (tid == 0) (void)xb_add(&bar[XB_XCNT(b.x)], 1u);
    return b;
}
__device__ __forceinline__ void xcd_barrier_complete(unsigned* bar, unsigned x, unsigned& nloc, unsigned& nx) {
    const unsigned G = gridDim.x * gridDim.y * gridDim.z;
    unsigned sum, cnt, mine, sp = 0u;
    for (;;) {
        sum = 0u; cnt = 0u; mine = 0u;
#pragma unroll
        for (unsigned j = 0; j < 16; ++j) { const unsigned c = xb_ld(&bar[XB_XCNT(j)]); sum += c; cnt += (c > 0u) ? 1u : 0u; mine = (j == x) ? c : mine; }
        if (sum == G) break;
        __builtin_amdgcn_s_sleep(1);
        if ((++sp & 255u) == 0u) { if (xb_ld(&bar[XB_TMO])) break; if (sp > XB_SPIN_CAP) { atomicAdd(&bar[XB_TMO], 1u); break; } }
    }
    nloc = mine > 0u ? mine : 1u; nx = cnt > 0u ? cnt : 1u;
}
__device__ __forceinline__ void xcd_barrier(const XcdBarrier& b, int tid) {
    asm volatile("s_waitcnt vmcnt(0)" ::: "memory");
    __syncthreads();
    if (tid == 0) {
        unsigned* bar = b.bar;
        __builtin_amdgcn_s_waitcnt(0);
        unsigned nloc = b.st[0], nx = b.st[1];
        if (nloc == 0u) { xcd_barrier_complete(bar, b.x, nloc, nx); b.st[0] = nloc; b.st[1] = nx; }
        const unsigned old = xb_add(&bar[XB_XSUB(b.x)], 1u);
        const unsigned gen = old / nloc;
        if (old + 1u == (gen + 1u) * nloc) {
            __builtin_amdgcn_fence(__ATOMIC_RELEASE, "agent");
            asm volatile("s_waitcnt vmcnt(0)" ::: "memory");
            const unsigned og = xb_add(&bar[XB_TOP], 1u);
            const unsigned tg = og / nx;
            if (og + 1u == (tg + 1u) * nx) xb_add(&bar[XB_TOPGEN], 1u);
            else XB_SPIN(xb_ld(&bar[XB_TOPGEN]) == tg, bar);
            __builtin_amdgcn_fence(__ATOMIC_ACQUIRE, "agent");
            xb_add(&bar[XB_XGEN(b.x)], 1u);
            asm volatile("s_waitcnt vmcnt(0)" ::: "memory");
        } else {
            XB_SPIN(xb_ld(&bar[XB_XGEN(b.x)]) == gen, bar);
            __builtin_amdgcn_fence(__ATOMIC_ACQUIRE, "agent");
            asm volatile("s_waitcnt vmcnt(0)" ::: "memory");
        }
    }
    __syncthreads();
}

namespace pg8 {
constexpr int BM = 256, BK = 64, HALF = 128, HTB = HALF * BK * 2, STAGE_BYTES = 8 * HTB, NXCD = 8, WGM = 8;
__host__ __device__ __forceinline__ int lds_byte(int r, int c) { const int st = (r >> 4) * 2 + (c >> 5), rr = r & 15, cc = c & 31, ob = rr * 64 + cc * 2; return st * 1024 + (ob ^ (((ob >> 9) & 1) << 5)); }
__host__ __device__ __forceinline__ void stage_rc(int b, int& R, int& C) { const int st = b / 1024, sb = b % 1024, swz = sb ^ (((sb >> 9) & 1) << 5); R = (st >> 1) * 16 + swz / 64; C = (st & 1) * 32 + (swz % 64) / 2; }
__host__ __device__ __forceinline__ int perm32(int rho) { const int n = rho >> 4, i = rho & 15; return 8 * (i >> 2) + 4 * n + (i & 3); }
struct Unit { int pm, pn; };
struct Gemm { const bf16_t* A; const bf16_t* Bt; int lda, ldb, K; const int* rowidx; };

struct StaticOrder {
    int nM, nN, nwg, G, c;
    __device__ void init(int M, int N, int G_, int c_) { nM = M / BM; nN = N / BM; nwg = nM * nN; G = G_; c = c_; }
    __device__ bool next(int i, Unit& u) const {
        const long L = (long)i * G + c; if (L >= nwg) return false;
        int wgid = (int)L; { const int q = nwg / NXCD, r = nwg % NXCD, xcd = wgid % NXCD, off = wgid / NXCD; wgid = (xcd < r ? xcd * (q + 1) : r * (q + 1) + (xcd - r) * q) + off; }
        const int nig = WGM * nN, gid = wgid / nig, fm = gid * WGM, gsz = (nM - fm) < WGM ? (nM - fm) : WGM;
        u.pm = fm + ((wgid % nig) % gsz); u.pn = (wgid % nig) / gsz; return true;
    }
};
struct MoeOrder {
    int per_e, npn, G, c;
    __device__ bool next(int i, Unit& u) const {
        const int nwg = 16 * per_e; const long L = (long)i * G + c; if (L >= nwg) return false;
        int wgid = (int)L; { const int q = nwg / NXCD, xcd = wgid % NXCD, off = wgid / NXCD; wgid = xcd * q + off; }
        const int e = wgid / per_e, r = wgid % per_e; u.pm = e * 8 + (r & 7); u.pn = e * npn + (r >> 3); return true;
    }
};

typedef __bf16 bf16v2_t __attribute__((ext_vector_type(2)));
typedef float f32x2_t __attribute__((ext_vector_type(2)));
__device__ __forceinline__ unsigned cvt_pk_bf16(float lo, float hi) { const f32x2_t v = {lo, hi}; const bf16v2_t b = __builtin_convertvector(v, bf16v2_t); return __builtin_bit_cast(unsigned, b); }

template <class Epi, class Sched, bool GATHER>
__device__ __forceinline__ void gemm_phase(LAS unsigned char* lds, const Gemm g, const Sched& S, const Epi& E, int tid_) {
    const int tid = tid_, wid = __builtin_amdgcn_readfirstlane(tid >> 6), lane = tid & 63, wr = wid >> 2, wc = wid & 3, fr = lane & 15, fq = lane >> 4;
    const int K = g.K, nt = K / BK;
    int Rr[2], Cc[2]; unsigned voffA[2], voffB[2];
#pragma unroll
    for (int i = 0; i < 2; ++i) { int R, C; stage_rc(tid * 16 + i * 8192, R, C); const int Rb = Epi::PERM ? ((R & ~31) + perm32(R & 31)) : R;
        Rr[i] = R; Cc[i] = C; voffA[i] = (unsigned)(R * g.lda + C) * 2u; voffB[i] = (unsigned)(Rb * g.ldb + C) * 2u; }
    const size_t kstep = (size_t)(BK * 2);
    const size_t hstepA = (size_t)HALF * g.lda * 2, tstepA = 2 * hstepA;
    const size_t hstepB = (size_t)HALF * g.ldb * 2, tstepB = 2 * hstepB;
    const unsigned ldsw = (unsigned)wid * 1024u;
    const int aoff = lds_byte(wr * 64 + fr, fq * 8), boff = lds_byte(wc * 32 + fr, fq * 8);
    const unsigned lda2 = (unsigned)g.lda * 2u;
#define PG8_AOFF(vo, pm_) do { _Pragma("unroll") for (int _h = 0; _h < 2; ++_h) _Pragma("unroll") for (int _i = 0; _i < 2; ++_i) { const int _row = (pm_) * 256 + _h * 128 + Rr[_i]; \
        (vo)[_h][_i] = (unsigned)g.rowidx[_row] * lda2 + (unsigned)Cc[_i] * 2u; } } while (0)
#define PG8_SA(b, h) (((b) * 2 + (h)) * HTB)
#define PG8_SB(b, h) ((4 + (b) * 2 + (h)) * HTB)
#define PG8_STAGE_B(bufoff, gbase) do { _Pragma("unroll") for (int _i = 0; _i < 2; ++_i) \
        __builtin_amdgcn_global_load_lds((const unsigned*)((const char*)(gbase) + voffB[_i]), (LAS unsigned*)(lds + (bufoff) + ldsw + _i * 8192), 16, 0, 0); } while (0)
#define PG8_STAGE_A(bufoff, uptr, voh, kb) do { _Pragma("unroll") for (int _i = 0; _i < 2; ++_i) { \
        const char* _p = GATHER ? ((const char*)g.A + (size_t)(voh)[_i] + (kb)) : ((const char*)(uptr) + voffA[_i]); \
        __builtin_amdgcn_global_load_lds((const unsigned*)_p, (LAS unsigned*)(lds + (bufoff) + ldsw + _i * 8192), 16, 0, 0); } } while (0)
#define PG8_LDA(dst, b, h) do { _Pragma("unroll") for (int m = 0; m < 4; ++m) _Pragma("unroll") for (int k = 0; k < 2; ++k) dst[m][k] = *(const LAS bf16x8*)(lds + PG8_SA(b, h) + aoff + m * 2048 + k * 1024); } while (0)
#define PG8_LDB(dst, b, h) do { _Pragma("unroll") for (int n = 0; n < 2; ++n) _Pragma("unroll") for (int k = 0; k < 2; ++k) dst[n][k] = *(const LAS bf16x8*)(lds + PG8_SB(b, h) + boff + n * 2048 + k * 1024); } while (0)
#define PG8_MMA(ai, bj, At, Bt) do { __builtin_amdgcn_s_setprio(1); _Pragma("unroll") for (int m = 0; m < 4; ++m) _Pragma("unroll") for (int n = 0; n < 2; ++n) _Pragma("unroll") for (int k = 0; k < 2; ++k) \
        acc[ai][bj][m][n] = __builtin_amdgcn_mfma_f32_16x16x32_bf16(Bt[n][k], At[m][k], acc[ai][bj][m][n], 0, 0, 0); __builtin_amdgcn_s_setprio(0); } while (0)
#define PG8_WAIT_V(n) asm volatile("s_waitcnt vmcnt(" #n ")" ::: "memory")
#define PG8_WAIT_L(n) asm volatile("s_waitcnt lgkmcnt(" #n ")" ::: "memory")
#define PG8_BAR __builtin_amdgcn_s_barrier()
#define PG8_SCHED __builtin_amdgcn_sched_barrier(0)
    Unit cur, nxt; int ui = 0;
    if (!S.next(0, cur)) return;
    f32x4 acc[2][2][4][2];
#pragma unroll
    for (int a = 0; a < 2; ++a)
#pragma unroll
        for (int b = 0; b < 2; ++b)
#pragma unroll
            for (int m = 0; m < 4; ++m)
#pragma unroll
                for (int n = 0; n < 2; ++n) acc[a][b][m][n] = (f32x4){0.f, 0.f, 0.f, 0.f};
    bf16x8 At[4][2], B0[2][2], B1[2][2];
    unsigned vcur[2][2], vnxt[2][2];
    if (GATHER) { PG8_AOFF(vcur, cur.pm); }
    else {
#pragma unroll
        for (int h = 0; h < 2; ++h)
#pragma unroll
            for (int i = 0; i < 2; ++i) vcur[h][i] = 0u; }
    const char* cA = (const char*)g.A + (GATHER ? (size_t)0 : (size_t)cur.pm * tstepA);
    const char* cB = (const char*)g.Bt + (size_t)cur.pn * tstepB;
    PG8_STAGE_B(PG8_SB(0, 0), cB); PG8_STAGE_A(PG8_SA(0, 0), cA, vcur[0], 0); PG8_STAGE_B(PG8_SB(0, 1), cB + hstepB); PG8_STAGE_A(PG8_SA(0, 1), cA + hstepA, vcur[1], 0);
    if (wr == 1) PG8_BAR;
    PG8_WAIT_V(4); PG8_BAR;
    PG8_STAGE_B(PG8_SB(1, 0), cB + kstep); PG8_STAGE_A(PG8_SA(1, 0), cA + kstep, vcur[0], kstep); PG8_STAGE_B(PG8_SB(1, 1), cB + hstepB + kstep);
    PG8_WAIT_V(6); PG8_BAR;
    for (;;) {
        const bool has_next = S.next(ui + 1, nxt);
        if (GATHER) {
            if (has_next) { PG8_AOFF(vnxt, nxt.pm); }
            else {
#pragma unroll
                for (int h = 0; h < 2; ++h)
#pragma unroll
                    for (int i = 0; i < 2; ++i) vnxt[h][i] = vcur[h][i]; } }
        const char* nA = (has_next && !GATHER) ? (const char*)g.A + (size_t)nxt.pm * tstepA : cA;
        const char* nB = has_next ? (const char*)g.Bt + (size_t)nxt.pn * tstepB : cB;
        for (int t = 0; t < nt; t += 2) {
            const bool last = (t == nt - 2);
            const size_t kb1 = (size_t)(t + 1) * kstep;
            const size_t kb2 = last ? (size_t)0 : (size_t)(t + 2) * kstep, kb3 = kb2 + kstep;
            unsigned va2[2][2];
#pragma unroll
            for (int h = 0; h < 2; ++h)
#pragma unroll
                for (int i = 0; i < 2; ++i) va2[h][i] = (GATHER && last) ? vnxt[h][i] : vcur[h][i];
            const char* a1 = cA + kb1;
            const char* a2 = last ? nA : cA + kb2; const char* a3 = a2 + kstep;
            const char* b2 = last ? nB : cB + (size_t)(t + 2) * kstep; const char* b3 = b2 + kstep;
            PG8_LDB(B0, 0, 0); PG8_SCHED; PG8_LDA(At, 0, 0); PG8_STAGE_A(PG8_SA(1, 1), a1 + hstepA, vcur[1], kb1);
            PG8_WAIT_L(8); PG8_BAR; PG8_WAIT_L(0); PG8_MMA(0, 0, At, B0); PG8_BAR; PG8_SCHED;
            PG8_LDB(B1, 0, 1); PG8_STAGE_B(PG8_SB(0, 0), b2);
            PG8_BAR; PG8_WAIT_L(0); PG8_MMA(0, 1, At, B1); PG8_BAR;
            PG8_LDA(At, 0, 1); PG8_STAGE_A(PG8_SA(0, 0), a2, va2[0], kb2);
            PG8_BAR; PG8_WAIT_L(0); PG8_MMA(1, 0, At, B0); PG8_BAR; PG8_SCHED;
            PG8_STAGE_B(PG8_SB(0, 1), b2 + hstepB);
            PG8_WAIT_V(6); PG8_BAR; PG8_MMA(1, 1, At, B1); PG8_BAR;
            PG8_LDB(B0, 1, 0); PG8_SCHED; PG8_LDA(At, 1, 0); PG8_STAGE_A(PG8_SA(0, 1), a2 + hstepA, va2[1], kb2);
            PG8_WAIT_L(8); PG8_BAR; PG8_WAIT_L(0); PG8_MMA(0, 0, At, B0); PG8_BAR; PG8_SCHED;
            PG8_LDB(B1, 1, 1); PG8_STAGE_B(PG8_SB(1, 0), b3);
            PG8_BAR; PG8_WAIT_L(0); PG8_MMA(0, 1, At, B1); PG8_BAR;
            PG8_LDA(At, 1, 1); PG8_STAGE_A(PG8_SA(1, 0), a3, va2[0], kb3);
            PG8_BAR; PG8_WAIT_L(0); PG8_MMA(1, 0, At, B0); PG8_BAR; PG8_SCHED;
            PG8_STAGE_B(PG8_SB(1, 1), b3 + hstepB);
            PG8_WAIT_V(6); PG8_BAR; PG8_MMA(1, 1, At, B1); PG8_BAR;
        }
        E(acc, cur, wr, wc, fr, fq);
        if (!has_next) break;
#pragma unroll
        for (int a = 0; a < 2; ++a)
#pragma unroll
            for (int b = 0; b < 2; ++b)
#pragma unroll
                for (int m = 0; m < 4; ++m)
#pragma unroll
                    for (int n = 0; n < 2; ++n) acc[a][b][m][n] = (f32x4){0.f, 0.f, 0.f, 0.f};
        cur = nxt; cA = nA; cB = nB; ++ui;
#pragma unroll
        for (int h = 0; h < 2; ++h)
#pragma unroll
            for (int i = 0; i < 2; ++i) vcur[h][i] = vnxt[h][i];
    }
    PG8_WAIT_V(0);
    if (wr == 0) PG8_BAR;
    PG8_BAR;
#undef PG8_AOFF
#undef PG8_SA
#undef PG8_SB
#undef PG8_STAGE_A
#undef PG8_STAGE_B
#undef PG8_LDA
#undef PG8_LDB
#undef PG8_MMA
#undef PG8_WAIT_V
#undef PG8_WAIT_L
#undef PG8_BAR
#undef PG8_SCHED
}
}
using pg8::Unit;
typedef f32x4 AccT[2][2][4][2];
struct EpiBf16Plain {
    static constexpr bool PERM = true;
    bf16_t* O; int ldc; int ncols;
    __device__ __forceinline__ void operator()(const AccT& acc, const Unit& u, int wr, int wc, int fr, int fq) const {
        const int row0 = u.pm * 256 + wr * 64 + fr, col0 = u.pn * 256 + wc * 32 + 8 * fq;
#pragma unroll
        for (int ai = 0; ai < 2; ++ai)
#pragma unroll
            for (int m = 0; m < 4; ++m) { bf16_t* rowp = O + (size_t)(row0 + ai * 128 + m * 16) * ldc;
#pragma unroll
                for (int bj = 0; bj < 2; ++bj) { const int col = col0 + bj * 128; if (col < ncols) { const f32x4 v0 = acc[ai][bj][m][0], v1 = acc[ai][bj][m][1];
                    u32x4 pk; pk.x = pg8::cvt_pk_bf16(v0[0], v0[1]); pk.y = pg8::cvt_pk_bf16(v0[2], v0[3]); pk.z = pg8::cvt_pk_bf16(v1[0], v1[1]); pk.w = pg8::cvt_pk_bf16(v1[2], v1[3]);
                    *(u32x4*)(rowp + col) = pk; } } }
    }
};
struct EpiF32 {
    static constexpr bool PERM = false;
    float* C; int ldc;
    __device__ __forceinline__ void operator()(const AccT& acc, const Unit& u, int wr, int wc, int fr, int fq) const {
        const int row0 = u.pm * 256 + wr * 64 + fr, col0 = u.pn * 256 + wc * 32 + 4 * fq;
#pragma unroll
        for (int ai = 0; ai < 2; ++ai)
#pragma unroll
            for (int m = 0; m < 4; ++m) { float* rowp = C + (size_t)(row0 + ai * 128 + m * 16) * ldc + col0;
#pragma unroll
                for (int bj = 0; bj < 2; ++bj)
#pragma unroll
                    for (int n = 0; n < 2; ++n) *(f32x4*)(rowp + bj * 128 + n * 16) = acc[ai][bj][m][n]; }
    }
};
struct EpiGlu {
    static constexpr bool PERM = true;
    const bf16_t* ys5; const float* bias; bf16_t* ycat;
    __device__ __forceinline__ void operator()(const AccT& acc, const Unit& u, int wr, int wc, int fr, int fq) const {
        const int row0 = u.pm * 256 + wr * 64 + fr, col0 = u.pn * 256 + wc * 32 + 8 * fq;
#pragma unroll
        for (int bj = 0; bj < 2; ++bj) { const int col = col0 + bj * 128;
            const f32x4 b0 = *(const f32x4*)(bias + col), b1 = *(const f32x4*)(bias + col + 4);
#pragma unroll
            for (int ai = 0; ai < 2; ++ai)
#pragma unroll
                for (int m = 0; m < 4; ++m) { const int row = row0 + ai * 128 + m * 16;
                    const u32x4 yv = *(const u32x4*)(ys5 + (size_t)row * 512 + col);
                    const f32x4 v0 = acc[ai][bj][m][0] + b0, v1 = acc[ai][bj][m][1] + b1;
                    u32x4 pk;
                    pk.x = pg8::cvt_pk_bf16(bflo(yv.x) * sigmoidf_(v0[0]), bfhi(yv.x) * sigmoidf_(v0[1]));
                    pk.y = pg8::cvt_pk_bf16(bflo(yv.y) * sigmoidf_(v0[2]), bfhi(yv.y) * sigmoidf_(v0[3]));
                    pk.z = pg8::cvt_pk_bf16(bflo(yv.z) * sigmoidf_(v1[0]), bfhi(yv.z) * sigmoidf_(v1[1]));
                    pk.w = pg8::cvt_pk_bf16(bflo(yv.w) * sigmoidf_(v1[2]), bfhi(yv.w) * sigmoidf_(v1[3]));
                    *(u32x4*)(ycat + (size_t)row * 1024 + 512 + col) = pk; } }
    }
};
struct EpiSwiglu {
    static constexpr bool PERM = true;
    bf16_t* H;
    __device__ __forceinline__ void operator()(const AccT& acc, const Unit& u, int wr, int wc, int fr, int fq) const {
        const int e = u.pm >> 3; const int row0 = u.pm * 256 + wr * 64 + fr, col0 = (u.pn - e * 22) * 128 + wc * 32 + 8 * fq;
#pragma unroll
        for (int ai = 0; ai < 2; ++ai)
#pragma unroll
            for (int m = 0; m < 4; ++m) { const f32x4 g0 = acc[ai][0][m][0], g1 = acc[ai][0][m][1], u0 = acc[ai][1][m][0], u1 = acc[ai][1][m][1];
                u32x4 pk;
                pk.x = pg8::cvt_pk_bf16(siluf_(g0[0]) * u0[0], siluf_(g0[1]) * u0[1]); pk.y = pg8::cvt_pk_bf16(siluf_(g0[2]) * u0[2], siluf_(g0[3]) * u0[3]);
                pk.z = pg8::cvt_pk_bf16(siluf_(g1[0]) * u1[0], siluf_(g1[1]) * u1[1]); pk.w = pg8::cvt_pk_bf16(siluf_(g1[2]) * u1[2], siluf_(g1[3]) * u1[3]);
                *(u32x4*)(H + (size_t)(row0 + ai * 128 + m * 16) * F_ + col0) = pk; }
    }
};
struct EpiDown {
    static constexpr bool PERM = true;
    bf16_t* Y; const float* gatev;
    __device__ __forceinline__ void operator()(const AccT& acc, const Unit& u, int wr, int wc, int fr, int fq) const {
        const int e = u.pm >> 3; const int row0 = u.pm * 256 + wr * 64 + fr, col0 = (u.pn - e * 4) * 256 + wc * 32 + 8 * fq;
#pragma unroll
        for (int ai = 0; ai < 2; ++ai)
#pragma unroll
            for (int m = 0; m < 4; ++m) { const int row = row0 + ai * 128 + m * 16; const float gt = gatev[row];
#pragma unroll
                for (int bj = 0; bj < 2; ++bj) { const f32x4 v0 = acc[ai][bj][m][0], v1 = acc[ai][bj][m][1];
                    u32x4 pk; pk.x = pg8::cvt_pk_bf16(v0[0] * gt, v0[1] * gt); pk.y = pg8::cvt_pk_bf16(v0[2] * gt, v0[3] * gt); pk.z = pg8::cvt_pk_bf16(v1[0] * gt, v1[1] * gt); pk.w = pg8::cvt_pk_bf16(v1[2] * gt, v1[3] * gt);
                    *(u32x4*)(Y + (size_t)row * 1024 + col0 + bj * 128) = pk; } }
    }
};
struct EpiVimg {
    static constexpr bool PERM = false;
    bf16_t* V;
    __device__ __forceinline__ void operator()(const AccT& acc, const Unit& u, int wr, int wc, int fr, int fq) const {
        const int row0 = u.pm * 256 + wr * 64 + fr, col0 = u.pn * 256 + wc * 32 + 4 * fq;
#pragma unroll
        for (int ai = 0; ai < 2; ++ai)
#pragma unroll
            for (int m = 0; m < 4; ++m) { const int row = row0 + ai * 128 + m * 16, h = row >> 7, dv = row & 127;
#pragma unroll
                for (int bj = 0; bj < 2; ++bj)
#pragma unroll
                    for (int n = 0; n < 2; ++n) { const int tok = col0 + bj * 128 + n * 16, b = tok >> 12, s = tok & 4095, kt = s >> 6, un = (s & 63) >> 2;
                        const f32x4 v = acc[ai][bj][m][n]; u32x2 pk; pk.x = pg8::cvt_pk_bf16(v[0], v[1]); pk.y = pg8::cvt_pk_bf16(v[2], v[3]);
                        *(u32x2*)(V + ((((size_t)(b * 4 + h) * 64 + kt) * 16 + un) * 128 + dv) * 4) = pk; } }
    }
};
struct EpiLora {
    static constexpr bool PERM = false;
    float* dec; float* av; float* gv; const float* w0; const float* a0;
    __device__ __forceinline__ void operator()(const AccT& acc, const Unit& u, int wr, int wc, int fr, int fq) const {
        const int row0 = u.pm * 256 + wr * 64 + fr, colt = u.pn * 256, kind = colt >> 9;
        const int cbase = (colt & 511) + wc * 32 + 4 * fq;
        float* outp = kind < 2 ? dec + (size_t)kind * T_ * 512 : (kind < 4 ? av + (size_t)(kind - 2) * T_ * 512 : gv);
        const float* addp = kind < 2 ? w0 + kind * 512 : a0 + ((kind - 2) & 1) * 512;
#pragma unroll
        for (int bj = 0; bj < 2; ++bj)
#pragma unroll
            for (int n = 0; n < 2; ++n) { const int c = cbase + bj * 128 + n * 16;
                f32x4 ad = (f32x4){0.f, 0.f, 0.f, 0.f}; if (kind < 4) ad = *(const f32x4*)(addp + c);
#pragma unroll
                for (int ai = 0; ai < 2; ++ai)
#pragma unroll
                    for (int m = 0; m < 4; ++m) { const int row = row0 + ai * 128 + m * 16; const f32x4 v = acc[ai][bj][m][n] + ad; f32x4 o;
#pragma unroll
                        for (int q = 0; q < 4; ++q) { float t = sigmoidf_(v[q]); if (kind < 2) t = __expf(-0.6065306597126334f * t); if (kind == 4) t = v[q]; o[q] = t; }
                        *(f32x4*)(outp + (size_t)row * 512 + c) = o;
                        asm volatile("" ::: "memory"); } }
    }
};

struct Frame {
    unsigned char* smem; LAS unsigned char* lds; int tid, lane, wid, bid, nblk;
    const float* const* in; float* out; unsigned char* ws;
};
#define WSP(T, off) ((T*)(F.ws + (off)))

__device__ __forceinline__ void phase_mod(const Frame& F) {
    float* silu_c = (float*)F.smem; float* red = silu_c + 4096;
    const float* c = F.in[I_C];
    for (int i = F.tid; i < 4096; i += NTHR) silu_c[i] = siluf_(c[i]);
    __syncthreads();
    float* mod = WSP(float, OFF_MOD);
    for (int u = F.bid; u < 192; u += F.nblk) {
        const int l = u / 96, cg = u % 96, col = cg * 64 + F.lane;
        const float* W = F.in[I_ADA_W] + (size_t)l * 1024 * 6144 + col;
        float a0 = 0.f, a1 = 0.f, a2 = 0.f, a3 = 0.f;
        const int kb = F.wid * 128;
#pragma unroll 8
        for (int k = 0; k < 128; ++k) { const float w = W[(size_t)(kb + k) * 6144]; a0 += silu_c[kb + k] * w; a1 += silu_c[1024 + kb + k] * w; a2 += silu_c[2048 + kb + k] * w; a3 += silu_c[3072 + kb + k] * w; }
        red[(F.wid * 4 + 0) * 64 + F.lane] = a0; red[(F.wid * 4 + 1) * 64 + F.lane] = a1; red[(F.wid * 4 + 2) * 64 + F.lane] = a2; red[(F.wid * 4 + 3) * 64 + F.lane] = a3;
        __syncthreads();
        if (F.wid < 4) { float s = 0.f;
#pragma unroll
            for (int w = 0; w < 8; ++w) s += red[(w * 4 + F.wid) * 64 + F.lane];
            mod[(size_t)(l * 4 + F.wid) * 6144 + col] = s + F.in[I_ADA_B][l * 6144 + col]; }
        __syncthreads();
    }
}

__device__ __forceinline__ void cvt_tile(const float* src, size_t ld_src, bf16_t* dst, size_t ld_dst, float* tl, int t) {
    const int kr = t >> 4, nc = (t & 15) * 4;
#pragma unroll
    for (int i = 0; i < 4; ++i) { const int k = kr + 32 * i; const float4 v = *(const float4*)(src + (size_t)k * ld_src + nc); *(float4*)(tl + k * 68 + nc) = v; }
    __syncthreads();
    const int n = t & 63, ks = (t >> 6) * 16;
    unsigned pk[8];
#pragma unroll
    for (int j = 0; j < 8; ++j) pk[j] = pk2(tl[(ks + 2 * j) * 68 + n], tl[(ks + 2 * j + 1) * 68 + n]);
    uint4* d = (uint4*)(dst + (size_t)n * ld_dst + ks);
    d[0] = make_uint4(pk[0], pk[1], pk[2], pk[3]); d[1] = make_uint4(pk[4], pk[5], pk[6], pk[7]);
    __syncthreads();
}
__device__ __forceinline__ void phase_convert(const Frame& F) {
    float* tl = (float*)F.smem;
    for (int x = F.bid; x < 1040; x += F.nblk) {
        const float* src; size_t lds_; bf16_t* dst; size_t ldd; int tt = x;
        if (tt < 256)            { const int kt = tt & 7, nt = tt >> 3; src = F.in[I_AB_IN] + (size_t)kt * 128 * 2576 + nt * 64; lds_ = 2576; dst = WSP(bf16_t, OFF_WIN0T) + (size_t)(nt * 64) * 1024 + kt * 128; ldd = 1024; }
        else if ((tt -= 256) < 64)  { const int kt = tt & 7, nt = tt >> 3; src = F.in[I_AB_IN] + (size_t)kt * 128 * 2576 + 2064 + nt * 64; lds_ = 2576; dst = WSP(bf16_t, OFF_WIN0T) + (size_t)(2048 + nt * 64) * 1024 + kt * 128; ldd = 1024; }
        else if ((tt -= 64) < 32)   { const int kt = tt & 3, nt = tt >> 2; src = F.in[I_S5_GLUW] + (size_t)kt * 128 * 512 + nt * 64; lds_ = 512; dst = WSP(bf16_t, OFF_WGLUT) + (size_t)(nt * 64) * 512 + kt * 128; ldd = 512; }
        else if ((tt -= 32) < 128)  { const int kt = tt & 7, nt = tt >> 3; src = F.in[I_AB_OUT] + (size_t)kt * 128 * 1024 + nt * 64; lds_ = 1024; dst = WSP(bf16_t, OFF_WOUT0T) + (size_t)(nt * 64) * 1024 + kt * 128; ldd = 1024; }
        else if ((tt -= 128) < 368) { const int kt = tt & 7, nt = tt >> 3; src = F.in[I_CD_IN] + (size_t)kt * 128 * 3456 + nt * 64; lds_ = 3456; dst = WSP(bf16_t, OFF_WIN1T) + (size_t)(nt * 64) * 1024 + kt * 128; ldd = 1024; }
        else if ((tt -= 368) < 64)  { const int kt = tt & 7, nt = tt >> 3; src = F.in[I_CD_IN] + (size_t)kt * 128 * 3456 + 2944 + nt * 64; lds_ = 3456; dst = WSP(bf16_t, OFF_WVT) + (size_t)(nt * 64) * 1024 + kt * 128; ldd = 1024; }
        else { tt -= 64;              const int kt = tt & 7, nt = tt >> 3; src = F.in[I_CD_OUT] + (size_t)kt * 128 * 1024 + nt * 64; lds_ = 1024; dst = WSP(bf16_t, OFF_WOUT1T) + (size_t)(nt * 64) * 1024 + kt * 128; ldd = 1024; }
        cvt_tile(src, lds_, dst, ldd, tl, F.tid);
    }
    for (int x = F.bid; x < 33792; x += F.nblk) {
        const int region = x / 352, tt = x % 352, l = region / 48, rem = region % 48, e = rem / 3, kind = rem % 3;
        if (kind < 2) {
            const int kt = tt & 7, nt = tt >> 3;
            const float* src = F.in[kind == 0 ? I_WGATE : I_WUP] + ((size_t)(l * 16 + e) * 1024 + kt * 128) * 2816 + nt * 64;
            const int f = nt * 64, tile22 = f >> 7, r = f & 127;
            bf16_t* dst = (bf16_t*)(F.ws + OFF_W1T + (size_t)l * W1T_LAYER) + ((size_t)((e * 22 + tile22) * 256 + kind * 128 + r)) * 1024 + kt * 128;
            cvt_tile(src, 2816, dst, 1024, tl, F.tid);
        } else {
            const int kt = tt % 22, nt = tt / 22;
            const float* src = F.in[I_WDOWN] + ((size_t)(l * 16 + e) * 2816 + kt * 128) * 1024 + nt * 64;
            bf16_t* dst = (bf16_t*)(F.ws + OFF_W2T + (size_t)l * W2T_LAYER) + ((size_t)(e * 1024 + nt * 64)) * 2816 + kt * 128;
            cvt_tile(src, 1024, dst, 2816, tl, F.tid);
        }
    }
    {
        bf16_t* Wl = WSP(bf16_t, OFF_WLORAT);
        const float* w2 = F.in[I_RW_W2]; const float* a2 = F.in[I_RW_A2]; const float* g2 = F.in[I_RW_G2];
        for (int i = F.bid * NTHR + F.tid; i < 2560 * 384; i += F.nblk * NTHR) {
            const int n = i / 384, k = i % 384, kind = n >> 9, c = n & 511; float v = 0.f;
            if (kind == 0) { if (k < 64) v = w2[(size_t)(0 * 64 + k) * 512 + c]; }
            else if (kind == 1) { if (k >= 64 && k < 128) v = w2[(size_t)(1 * 64 + (k - 64)) * 512 + c]; }
            else if (kind == 2) { if (k >= 128 && k < 192) v = a2[(size_t)(0 * 64 + (k - 128)) * 512 + c]; }
            else if (kind == 3) { if (k >= 192 && k < 256) v = a2[(size_t)(1 * 64 + (k - 192)) * 512 + c]; }
            else { if (k >= 256) v = g2[(size_t)(k - 256) * 512 + c]; }
            Wl[i] = f2bf(v);
        }
    }
}

__device__ __forceinline__ void load_row16(const float* p, int lane, float (&v)[16]) {
    const float4* q = (const float4*)(p + lane * 16);
#pragma unroll
    for (int i = 0; i < 4; ++i) { const float4 t = q[i]; v[4 * i] = t.x; v[4 * i + 1] = t.y; v[4 * i + 2] = t.z; v[4 * i + 3] = t.w; }
}
__device__ __forceinline__ void store_row16(float* p, int lane, const float (&v)[16]) {
    float4* q = (float4*)(p + lane * 16);
#pragma unroll
    for (int i = 0; i < 4; ++i) q[i] = make_float4(v[4 * i], v[4 * i + 1], v[4 * i + 2], v[4 * i + 3]);
}
__device__ __forceinline__ void store_row16_bf(bf16_t* p, int lane, const float (&v)[16]) {
    uint4* q = (uint4*)(p + lane * 16);
    q[0] = make_uint4(pk2(v[0], v[1]), pk2(v[2], v[3]), pk2(v[4], v[5]), pk2(v[6], v[7]));
    q[1] = make_uint4(pk2(v[8], v[9]), pk2(v[10], v[11]), pk2(v[12], v[13]), pk2(v[14], v[15]));
}
__device__ __forceinline__ void fill_thin(float* wl, const float* W, int ldw, int tid) {
    for (int i = tid; i < 1024 * 16; i += NTHR) { const int c = i >> 4, j = i & 15; wl[((c & 15) * 64 + (c >> 4)) * 20 + j] = W[(size_t)c * ldw + j]; }
}
__device__ __forceinline__ void thin16(const float* wl, int lane, const float (&h)[16], float (&o)[16]) {
#pragma unroll
    for (int j = 0; j < 16; ++j) o[j] = 0.f;
#pragma unroll
    for (int i = 0; i < 16; ++i) { const float4* w = (const float4*)(wl + (i * 64 + lane) * 20);
        if ((i & 1) == 0) asm volatile("" ::: "memory");
#pragma unroll
        for (int q = 0; q < 4; ++q) { const float4 t = w[q]; o[4 * q] += h[i] * t.x; o[4 * q + 1] += h[i] * t.y; o[4 * q + 2] += h[i] * t.z; o[4 * q + 3] += h[i] * t.w; } }
#pragma unroll
    for (int j = 0; j < 16; ++j) o[j] = wave_sum(o[j]);
}

__device__ __forceinline__ void phase_norm0(const Frame& F) {
    float* wl = (float*)F.smem;
    fill_thin(wl, F.in[I_AB_IN] + 2048, 2576, F.tid);
    __syncthreads();
    const float* x = F.in[I_X]; const float* mod = WSP(float, OFF_MOD); bf16_t* hb = WSP(bf16_t, OFF_HB); float* gb = WSP(float, OFF_GB0);
    for (int tb = F.bid; tb < 256; tb += F.nblk) {
        const int base = tb * 64 + F.wid * 8, b = base >> 12;
        float gain[16], sc[16], sh[16];
        load_row16(F.in[I_NMIX_PRE], F.lane, gain);
        load_row16(mod + (size_t)(0 * 4 + b) * 6144 + 1024, F.lane, sc);
        load_row16(mod + (size_t)(0 * 4 + b) * 6144, F.lane, sh);
        for (int i = 0; i < 8; ++i) {
            const int tok = base + i; float v[16]; load_row16(x + (size_t)tok * 1024, F.lane, v);
            float ss = 0.f;
#pragma unroll
            for (int q = 0; q < 16; ++q) ss += v[q] * v[q];
            ss = wave_sum(ss); const float rstd = rsqrtf(ss * (1.f / 1024.f) + 1e-6f);
#pragma unroll
            for (int q = 0; q < 16; ++q) v[q] = v[q] * rstd * gain[q] * (1.f + sc[q]) + sh[q];
            store_row16_bf(hb + (size_t)tok * 1024, F.lane, v);
            float o[16]; thin16(wl, F.lane, v, o);
            if (F.lane < 16) { const int j = F.lane; float r = 0.f;
#pragma unroll
                for (int q = 0; q < 16; ++q) r = (q == j) ? o[q] : r;
                float outv;
                if (j < 8) outv = -__expf(F.in[I_DN_ALOG][j]) * softplusf_(r + F.in[I_DN_DTB][j]);
                else outv = sigmoidf_(r);
                gb[(size_t)tok * 16 + j] = outv; }
        }
    }
}

__device__ __forceinline__ void phase_dnprep(const Frame& F) {
    const bf16_t* P0 = WSP(bf16_t, OFF_P0); float* qkvn = WSP(float, OFF_QKVN); const float* cw = F.in[I_DN_CONV];
    const int c0 = F.lane * 8;
    for (int tb = F.bid; tb < 256; tb += F.nblk) {
        const int base = tb * 64 + F.wid * 8;
        for (int i = 0; i < 8; ++i) {
            const int tok = base + i, s = tok & 4095;
#pragma unroll
            for (int grp = 0; grp < 3; ++grp) {
                float acc[8];
#pragma unroll
                for (int q = 0; q < 8; ++q) acc[q] = 0.f;
#pragma unroll
                for (int j = 0; j < 5; ++j) { const int sj = s + j - 2;
                    if (sj >= 0 && sj < 4096) {
                        const u32x4 pv = *(const u32x4*)(P0 + (size_t)(tok + j - 2) * 2560 + grp * 512 + c0);
                        const float4 w0 = *(const float4*)(cw + j * 1536 + grp * 512 + c0), w1 = *(const float4*)(cw + j * 1536 + grp * 512 + c0 + 4);
                        acc[0] += w0.x * bflo(pv.x); acc[1] += w0.y * bfhi(pv.x); acc[2] += w0.z * bflo(pv.y); acc[3] += w0.w * bfhi(pv.y);
                        acc[4] += w1.x * bflo(pv.z); acc[5] += w1.y * bfhi(pv.z); acc[6] += w1.z * bflo(pv.w); acc[7] += w1.w * bfhi(pv.w); } }
                float ss = 0.f;
#pragma unroll
                for (int q = 0; q < 8; ++q) { acc[q] = siluf_(acc[q]); ss += acc[q] * acc[q]; }
                if (grp < 2) {
                    ss += __shfl_xor(ss, 1); ss += __shfl_xor(ss, 2); ss += __shfl_xor(ss, 4); ss += __shfl_xor(ss, 8);
                    float sc = rsqrtf(ss + 1e-6f); if (grp == 0) sc *= 0.08838834764831845f;
#pragma unroll
                    for (int q = 0; q < 8; ++q) acc[q] *= sc; }
                float4* o = (float4*)(qkvn + (size_t)tok * 1536 + grp * 512 + c0);
                o[0] = make_float4(acc[0], acc[1], acc[2], acc[3]); o[1] = make_float4(acc[4], acc[5], acc[6], acc[7]);
            }
        }
    }
}

__device__ __forceinline__ void phase_dnscan(const Frame& F) {
    float* bufQK = (float*)F.smem;
    float* bufV = bufQK + 2 * 32 * 256;
    float* bufG = bufV + 2 * 32 * 32;
    const float* qkvn = WSP(float, OFF_QKVN); const float* gb = WSP(float, OFF_GB0); float* dno = WSP(float, OFF_DNO);
    const int col4 = F.lane >> 4, kp = F.lane & 15, jj = F.wid * 4 + col4;
    const bool split = (F.nblk == 256);
    if (split && F.bid >= 128) return;
    for (int u = F.bid; u < 128; u += (split ? 128 : F.nblk)) {
        const int cb = u & 3, seq = u >> 2, dir = seq & 1, h = (seq >> 1) & 3, b = seq >> 3;
        float s[8];
#pragma unroll
        for (int q = 0; q < 8; ++q) s[q] = 0.f;
        float4 rq0, rq1, rq2, rq3; float4 rv = make_float4(0.f, 0.f, 0.f, 0.f); float rg = 0.f;
#define DN_LD1(dst, i, c) do { const int idx = F.tid + NTHR * (i), row = idx >> 6, c4 = idx & 63, step = (c) * 32 + row, t = dir ? 4095 - step : step; \
            const size_t tok = (size_t)b * 4096 + t; dst = *(const float4*)(qkvn + tok * 1536 + (c4 < 32 ? h * 128 + c4 * 4 : 512 + h * 128 + (c4 - 32) * 4)); } while (0)
#define DN_GLOAD(c) do { DN_LD1(rq0, 0, c); DN_LD1(rq1, 1, c); DN_LD1(rq2, 2, c); DN_LD1(rq3, 3, c); \
            if (F.tid < 256) { const int row = F.tid >> 3, c4 = F.tid & 7, step = (c) * 32 + row, t = dir ? 4095 - step : step; const size_t tok = (size_t)b * 4096 + t; \
                rv = *(const float4*)(qkvn + tok * 1536 + 1024 + h * 128 + cb * 32 + c4 * 4); } \
            else if (F.tid < 320) { const int row = (F.tid - 256) >> 1, which = F.tid & 1, step = (c) * 32 + row, t = dir ? 4095 - step : step; const size_t tok = (size_t)b * 4096 + t; \
                rg = gb[tok * 16 + which * 8 + dir * 4 + h]; } } while (0)
#define DN_LSTORE(buf) do { *(float4*)(bufQK + (buf) * 8192 + (F.tid) * 4) = rq0; *(float4*)(bufQK + (buf) * 8192 + (F.tid + NTHR) * 4) = rq1; \
            *(float4*)(bufQK + (buf) * 8192 + (F.tid + 2 * NTHR) * 4) = rq2; *(float4*)(bufQK + (buf) * 8192 + (F.tid + 3 * NTHR) * 4) = rq3; \
            if (F.tid < 256) *(float4*)(bufV + (buf) * 1024 + F.tid * 4) = rv; else if (F.tid < 320) bufG[(buf) * 64 + (F.tid - 256)] = rg; } while (0)
        DN_GLOAD(0); DN_LSTORE(0); __syncthreads();
        for (int c = 0; c < 128; ++c) {
            const int buf = c & 1;
            if (c + 1 < 128) DN_GLOAD(c + 1);
            float osel = 0.f;
#pragma unroll 4
            for (int i = 0; i < 32; ++i) {
                const float* row = bufQK + buf * 8192 + i * 256;
                const float4 q0 = *(const float4*)(row + kp * 8), q1 = *(const float4*)(row + kp * 8 + 4);
                const float4 k0 = *(const float4*)(row + 128 + kp * 8), k1 = *(const float4*)(row + 128 + kp * 8 + 4);
                const float v = bufV[buf * 1024 + i * 32 + jj]; const float g = bufG[buf * 64 + i * 2], beta = bufG[buf * 64 + i * 2 + 1];
                const float a = __expf(g);
#pragma unroll
                for (int q = 0; q < 8; ++q) s[q] *= a;
                float d = k0.x * s[0] + k0.y * s[1] + k0.z * s[2] + k0.w * s[3] + k1.x * s[4] + k1.y * s[5] + k1.z * s[6] + k1.w * s[7];
                d = row16_sum(d);
                const float cc = beta * (v - d);
                s[0] += k0.x * cc; s[1] += k0.y * cc; s[2] += k0.z * cc; s[3] += k0.w * cc; s[4] += k1.x * cc; s[5] += k1.y * cc; s[6] += k1.z * cc; s[7] += k1.w * cc;
                float o = q0.x * s[0] + q0.y * s[1] + q0.z * s[2] + q0.w * s[3] + q1.x * s[4] + q1.y * s[5] + q1.z * s[6] + q1.w * s[7];
                o = row16_sum(o);
                osel = (kp == (i & 15)) ? o : osel;
                if ((i & 15) == 15) { const int step = c * 32 + (i & 16) + kp, t = dir ? 4095 - step : step;
                    dno[((size_t)dir * T_ + (size_t)b * 4096 + t) * 512 + h * 128 + cb * 32 + jj] = osel; }
            }
            if (c + 1 < 128) DN_LSTORE(buf ^ 1);
            __syncthreads();
        }
    }
#undef DN_LD1
#undef DN_GLOAD
#undef DN_LSTORE
}

__device__ __forceinline__ void phase_s5scan(const Frame& F) {
    float* Ebuf = (float*)F.smem;
    float* ubuf = Ebuf + 64 * 64 * 2 + F.wid * 64 * 16;
    bf16_t* xs = (bf16_t*)((float*)F.smem + 64 * 64 * 2 + 8 * 64 * 16) + F.wid * 16 * 136;
    const bf16_t* P0 = WSP(bf16_t, OFF_P0); float* s5y = WSP(float, OFF_S5Y);
    const int p = F.lane;
    for (int u = F.bid; u < 256; u += F.nblk) {
        const int d = u & 1, g = (u >> 1) & 31, b = u >> 6;
        const float dt = __expf(F.in[I_S5_LDT][d * 32 + g]);
        const float are = F.in[I_S5_ARE][(d * 32 + g) * 64 + p], aim = F.in[I_S5_AIM][(d * 32 + g) * 64 + p];
        const float mag = __expf(are * dt);
        float rev = aim * dt * 0.15915494309189535f; rev -= floorf(rev);
        const float lr = mag * __builtin_amdgcn_cosf(rev), li = mag * __builtin_amdgcn_sinf(rev);
        const float den = are * are + aim * aim, nr = lr - 1.f, ni = li;
        const float fre = (nr * are + ni * aim) / den, fim = (ni * are - nr * aim) / den;
        float bbr[16], bbi[16];
        { const float* br = F.in[I_S5_BRE] + ((size_t)(d * 32 + g) * 64 + p) * 16; const float* bi = F.in[I_S5_BIM] + ((size_t)(d * 32 + g) * 64 + p) * 16;
#pragma unroll
          for (int hh = 0; hh < 16; ++hh) { const float r_ = br[hh], i_ = bi[hh]; bbr[hh] = fre * r_ - fim * i_; bbi[hh] = fre * i_ + fim * r_; } }
        bf16x8 cfrag[4];
        { const int hcol = F.lane & 15, kq = F.lane >> 4;
#pragma unroll
          for (int s = 0; s < 4; ++s) { const int kk0 = 32 * s + 8 * kq; bf16x8 f;
#pragma unroll
              for (int j = 0; j < 8; ++j) { const int kk = kk0 + j; const float v = kk < 64 ? F.in[I_S5_CRE][((size_t)(d * 32 + g) * 16 + hcol) * 64 + kk] : -F.in[I_S5_CIM][((size_t)(d * 32 + g) * 16 + hcol) * 64 + (kk - 64)]; f[j] = (short)f2bf(v); }
              cfrag[s] = f; } }
        float l64r = lr, l64i = li;
#pragma unroll
        for (int q = 0; q < 6; ++q) { const float r2 = l64r * l64r - l64i * l64i, i2 = 2.f * l64r * l64i; l64r = r2; l64i = i2; }
        auto load_u = [&](int cw) {
            const int n = cw * 64 + F.lane, t = d ? 4095 - n : n; const bf16_t* src = P0 + ((size_t)b * 4096 + t) * 2560 + 2048 + g * 16;
            const u32x4 a = *(const u32x4*)src, c = *(const u32x4*)(src + 8);
            float4* dst = (float4*)(ubuf + F.lane * 16);
            dst[0] = make_float4(bflo(a.x), bfhi(a.x), bflo(a.y), bfhi(a.y)); dst[1] = make_float4(bflo(a.z), bfhi(a.z), bflo(a.w), bfhi(a.w));
            dst[2] = make_float4(bflo(c.x), bfhi(c.x), bflo(c.y), bfhi(c.y)); dst[3] = make_float4(bflo(c.z), bfhi(c.z), bflo(c.w), bfhi(c.w));
            asm volatile("s_waitcnt lgkmcnt(0)" ::: "memory"); __builtin_amdgcn_wave_barrier();
        };
        auto step_x = [&](int j, float& xr, float& xi) {
            const float4* uu = (const float4*)(ubuf + j * 16);
            const float4 u0 = uu[0], u1 = uu[1], u2 = uu[2], u3 = uu[3];
            float br_ = bbr[0] * u0.x + bbr[1] * u0.y + bbr[2] * u0.z + bbr[3] * u0.w + bbr[4] * u1.x + bbr[5] * u1.y + bbr[6] * u1.z + bbr[7] * u1.w
                      + bbr[8] * u2.x + bbr[9] * u2.y + bbr[10] * u2.z + bbr[11] * u2.w + bbr[12] * u3.x + bbr[13] * u3.y + bbr[14] * u3.z + bbr[15] * u3.w;
            float bi_ = bbi[0] * u0.x + bbi[1] * u0.y + bbi[2] * u0.z + bbi[3] * u0.w + bbi[4] * u1.x + bbi[5] * u1.y + bbi[6] * u1.z + bbi[7] * u1.w
                      + bbi[8] * u2.x + bbi[9] * u2.y + bbi[10] * u2.z + bbi[11] * u2.w + bbi[12] * u3.x + bbi[13] * u3.y + bbi[14] * u3.z + bbi[15] * u3.w;
            const float nxr = lr * xr - li * xi + br_, nxi = lr * xi + li * xr + bi_; xr = nxr; xi = nxi;
        };
        for (int i = 0; i < 8; ++i) { const int cw = F.wid * 8 + i; load_u(cw); float xr = 0.f, xi = 0.f;
            for (int j = 0; j < 64; ++j) step_x(j, xr, xi);
            Ebuf[(cw * 64 + p) * 2] = xr; Ebuf[(cw * 64 + p) * 2 + 1] = xi;
            __builtin_amdgcn_wave_barrier(); }
        __syncthreads();
        float xr = 0.f, xi = 0.f;
        for (int c = 0; c < F.wid * 8; ++c) { const float er = Ebuf[(c * 64 + p) * 2], ei = Ebuf[(c * 64 + p) * 2 + 1]; const float nr_ = l64r * xr - l64i * xi + er, ni_ = l64r * xi + l64i * xr + ei; xr = nr_; xi = ni_; }
        for (int i = 0; i < 8; ++i) { const int cw = F.wid * 8 + i; load_u(cw);
            for (int sub = 0; sub < 4; ++sub) {
                for (int j = 0; j < 16; ++j) { step_x(sub * 16 + j, xr, xi); xs[j * 136 + p] = f2bf(xr); xs[j * 136 + 64 + p] = f2bf(xi); }
                asm volatile("s_waitcnt lgkmcnt(0)" ::: "memory"); __builtin_amdgcn_wave_barrier();
                f32x4 acc = (f32x4){0.f, 0.f, 0.f, 0.f};
#pragma unroll
                for (int s = 0; s < 4; ++s) { const bf16x8 af = *(const bf16x8*)(xs + (F.lane & 15) * 136 + 32 * s + 8 * (F.lane >> 4)); acc = __builtin_amdgcn_mfma_f32_16x16x32_bf16(af, cfrag[s], acc, 0, 0, 0); }
                asm volatile("s_waitcnt lgkmcnt(0)" ::: "memory"); __builtin_amdgcn_wave_barrier();
#pragma unroll
                for (int j = 0; j < 4; ++j) { const int tl_ = (F.lane >> 4) * 4 + j, n = cw * 64 + sub * 16 + tl_, t = d ? 4095 - n : n;
                    s5y[((size_t)d * T_ + (size_t)b * 4096 + t) * 512 + g * 16 + (F.lane & 15)] = acc[j]; }
            } }
        __syncthreads();
    }
}

__device__ __forceinline__ void phase_post0(const Frame& F) {
    const bf16_t* P0 = WSP(bf16_t, OFF_P0); const float* dno = WSP(float, OFF_DNO); const float* s5y = WSP(float, OFF_S5Y);
    bf16_t* ycat = WSP(bf16_t, OFF_YCAT); bf16_t* ys5 = WSP(bf16_t, OFF_YS5);
    const int c0 = F.lane * 8;
    float nw[8], dsk[8];
#pragma unroll
    for (int q = 0; q < 8; ++q) { nw[q] = F.in[I_DN_NORM][(c0 & 127) + q]; dsk[q] = F.in[I_S5_D][c0 + q]; }
    for (int tb = F.bid; tb < 256; tb += F.nblk) {
        const int base = tb * 64 + F.wid * 8;
        for (int i = 0; i < 8; ++i) { const size_t tok = base + i;
            { const float4 a0 = *(const float4*)(dno + tok * 512 + c0), a1 = *(const float4*)(dno + tok * 512 + c0 + 4);
              const float4 b0 = *(const float4*)(dno + ((size_t)T_ + tok) * 512 + c0), b1 = *(const float4*)(dno + ((size_t)T_ + tok) * 512 + c0 + 4);
              float o[8] = {a0.x + b0.x, a0.y + b0.y, a0.z + b0.z, a0.w + b0.w, a1.x + b1.x, a1.y + b1.y, a1.z + b1.z, a1.w + b1.w};
              float ss = 0.f;
#pragma unroll
              for (int q = 0; q < 8; ++q) ss += o[q] * o[q];
              ss += __shfl_xor(ss, 1); ss += __shfl_xor(ss, 2); ss += __shfl_xor(ss, 4); ss += __shfl_xor(ss, 8);
              const float rstd = rsqrtf(ss * (1.f / 128.f) + 1e-6f);
              const u32x4 zv = *(const u32x4*)(P0 + tok * 2560 + 1536 + c0);
              const float z[8] = {bflo(zv.x), bfhi(zv.x), bflo(zv.y), bfhi(zv.y), bflo(zv.z), bfhi(zv.z), bflo(zv.w), bfhi(zv.w)};
#pragma unroll
              for (int q = 0; q < 8; ++q) o[q] = o[q] * rstd * nw[q] * siluf_(z[q]);
              *(u32x4*)(ycat + tok * 1024 + c0) = (u32x4){pk2(o[0], o[1]), pk2(o[2], o[3]), pk2(o[4], o[5]), pk2(o[6], o[7])}; }
            { const float4 a0 = *(const float4*)(s5y + tok * 512 + c0), a1 = *(const float4*)(s5y + tok * 512 + c0 + 4);
              const float4 b0 = *(const float4*)(s5y + ((size_t)T_ + tok) * 512 + c0), b1 = *(const float4*)(s5y + ((size_t)T_ + tok) * 512 + c0 + 4);
              const u32x4 uv = *(const u32x4*)(P0 + tok * 2560 + 2048 + c0);
              const float uu[8] = {bflo(uv.x), bfhi(uv.x), bflo(uv.y), bfhi(uv.y), bflo(uv.z), bfhi(uv.z), bflo(uv.w), bfhi(uv.w)};
              float y[8] = {a0.x + b0.x, a0.y + b0.y, a0.z + b0.z, a0.w + b0.w, a1.x + b1.x, a1.y + b1.y, a1.z + b1.z, a1.w + b1.w};
#pragma unroll
              for (int q = 0; q < 8; ++q) y[q] = gelu_tanhf_(y[q] + dsk[q] * uu[q]);
              *(u32x4*)(ys5 + tok * 512 + c0) = (u32x4){pk2(y[0], y[1]), pk2(y[2], y[3]), pk2(y[4], y[5]), pk2(y[6], y[7])}; }
        }
    }
}
constexpr int LD72 = 72;
#ifndef DN_SWAPTEST_V
#define DN_SWAPTEST_V (vv * beta)
#endif
#ifdef DN_ROBUST
#define DN_WSYNC() __syncthreads()
#define DN_XSYNC() __syncthreads()
#else
#define DN_WSYNC() do { asm volatile("s_waitcnt lgkmcnt(0)" ::: "memory"); __builtin_amdgcn_wave_barrier(); } while (0)
#define DN_XSYNC() do { } while (0)
#endif
#ifndef DN_CLIM
#define DN_CLIM 64
#endif
__device__ __forceinline__ int perm16(int x) { return ((x >> 2) & 1) * 8 + ((x >> 3) << 2) + (x & 3); }
__device__ __forceinline__ bf16x8 ld_frag_f32(const float* p) {
    const float4 a = *(const float4*)p, b = *(const float4*)(p + 4);
    bf16x8 f; const unsigned w0 = pk2(a.x, a.y), w1 = pk2(a.z, a.w), w2 = pk2(b.x, b.y), w3 = pk2(b.z, b.w);
    f[0] = (short)(w0 & 0xFFFFu); f[1] = (short)(w0 >> 16); f[2] = (short)(w1 & 0xFFFFu); f[3] = (short)(w1 >> 16);
    f[4] = (short)(w2 & 0xFFFFu); f[5] = (short)(w2 >> 16); f[6] = (short)(w3 & 0xFFFFu); f[7] = (short)(w3 >> 16); return f;
}
__device__ __forceinline__ u32x4 pack8(const f32x16& a, int s) {
    u32x4 o; o.x = pg8::cvt_pk_bf16(a[8 * s], a[8 * s + 1]); o.y = pg8::cvt_pk_bf16(a[8 * s + 2], a[8 * s + 3]); o.z = pg8::cvt_pk_bf16(a[8 * s + 4], a[8 * s + 5]); o.w = pg8::cvt_pk_bf16(a[8 * s + 6], a[8 * s + 7]); return o;
}
__device__ __forceinline__ bf16x8 as_frag(const u32x4 u) { union { u32x4 a; bf16x8 b; } x; x.a = u; return x.b; }
__device__ __forceinline__ void unpack16(const u32x4 lo, const u32x4 hi, f32x16& a) {
    a[0] = bflo(lo.x); a[1] = bfhi(lo.x); a[2] = bflo(lo.y); a[3] = bfhi(lo.y); a[4] = bflo(lo.z); a[5] = bfhi(lo.z); a[6] = bflo(lo.w); a[7] = bfhi(lo.w);
    a[8] = bflo(hi.x); a[9] = bfhi(hi.x); a[10] = bflo(hi.y); a[11] = bfhi(hi.y); a[12] = bflo(hi.z); a[13] = bfhi(hi.z); a[14] = bflo(hi.w); a[15] = bfhi(hi.w);
}
template <int KS> __device__ __forceinline__ f32x16 tile_mm(const bf16_t* A, int ldA, const bf16_t* Bt, int ldB, int lane) {
    f32x16 acc;
#pragma unroll
    for (int r = 0; r < 16; ++r) acc[r] = 0.f;
    const int rw = lane & 31, hh = lane >> 5;
#pragma unroll
    for (int s = 0; s < KS; ++s) { const bf16x8 a = *(const bf16x8*)(A + rw * ldA + 16 * s + 8 * hh), b = *(const bf16x8*)(Bt + rw * ldB + 16 * s + 8 * hh);
        acc = __builtin_amdgcn_mfma_f32_32x32x16_bf16(a, b, acc, 0, 0, 0); }
    return acc;
}

__device__ __forceinline__ void phase_dn_ab(const Frame& F) {
    const float* qkvn = WSP(float, OFF_QKVN); const float* gb = WSP(float, OFF_GB0);
    float* gcs_g = WSP(float, OFF_DN_GCS); bf16_t* Am_g = WSP(bf16_t, OFF_DN_AM); bf16_t* Tm_g = WSP(bf16_t, OFF_DN_TM);
    float* Gs = (float*)F.smem + F.wid * (64 * 68 + 128);
    float* gsm = Gs + 64 * 68; float* bsm = gsm + 64;
    const int rw = F.lane & 31, hh = F.lane >> 5;
    for (int ch = F.bid * 8 + F.wid; ch < 2048; ch += F.nblk * 8) {
        const int seq = ch >> 6, c = ch & 63, dir = seq & 1, h = (seq >> 1) & 3, b = seq >> 3;
        { const int step = c * 64 + F.lane, t = dir ? 4095 - step : step; const size_t tok = (size_t)b * 4096 + t;
          float gc = gb[tok * 16 + dir * 4 + h]; const float beta = gb[tok * 16 + 8 + dir * 4 + h];
#pragma unroll
          for (int o = 1; o < 64; o <<= 1) { const float tt = __shfl_up(gc, o); if (F.lane >= o) gc += tt; }
          gsm[F.lane] = gc; bsm[F.lane] = beta; gcs_g[(size_t)ch * 64 + F.lane] = gc; }
        DN_WSYNC();
        size_t tokr[2];
#pragma unroll
        for (int ti = 0; ti < 2; ++ti) { const int step = c * 64 + ti * 32 + rw, t = dir ? 4095 - step : step; tokr[ti] = (size_t)b * 4096 + t; }
        bf16x8 kf[2][8];
#pragma unroll
        for (int ti = 0; ti < 2; ++ti)
#pragma unroll
            for (int s = 0; s < 8; ++s) kf[ti][s] = ld_frag_f32(qkvn + tokr[ti] * 1536 + 512 + h * 128 + 16 * s + 8 * hh);
#pragma unroll
        for (int ti = 0; ti < 2; ++ti)
#pragma unroll
            for (int tj = 0; tj <= ti; ++tj) {
                f32x16 acc;
#pragma unroll
                for (int r = 0; r < 16; ++r) acc[r] = 0.f;
#pragma unroll
                for (int s = 0; s < 8; ++s) acc = __builtin_amdgcn_mfma_f32_32x32x16_bf16(kf[ti][s], kf[tj][s], acc, 0, 0, 0);
                int j = tj * 32 + rw; asm volatile("" : "+v"(j));
                const float gcj = gsm[j]; const int ib = ti * 32 + 4 * hh;
#pragma unroll
                for (int r = 0; r < 16; ++r) { const int i = ib + (r & 3) + 8 * (r >> 2);
                    Gs[i * 68 + j] = (j < i) ? bsm[i] * acc[r] * __expf(fminf(gsm[i] - gcj, 0.f)) : 0.f; }
            }
#pragma unroll
        for (int ti = 0; ti < 2; ++ti) {
            bf16x8 qf[8];
#pragma unroll
            for (int s = 0; s < 8; ++s) qf[s] = ld_frag_f32(qkvn + tokr[ti] * 1536 + h * 128 + 16 * s + 8 * hh);
#pragma unroll
            for (int tj = 0; tj < 2; ++tj) {
                f32x16 acc;
#pragma unroll
                for (int r = 0; r < 16; ++r) acc[r] = 0.f;
                if (tj <= ti) {
#pragma unroll
                    for (int s = 0; s < 8; ++s) acc = __builtin_amdgcn_mfma_f32_32x32x16_bf16(qf[s], kf[tj][s], acc, 0, 0, 0); }
                int j = tj * 32 + rw; asm volatile("" : "+v"(j));
                const float gcj = gsm[j]; const int ib = ti * 32 + 4 * hh;
                bf16_t* ap = Am_g + (size_t)ch * 4096 + (ti * 32 + 4 * hh) * 64 + j; asm volatile("" : "+v"(ap));
#pragma unroll
                for (int r = 0; r < 16; ++r) { const int i = ib + (r & 3) + 8 * (r >> 2);
                    const float v = (j <= i) ? acc[r] * __expf(fminf(gsm[i] - gcj, 0.f)) : 0.f;
                    ap[((r & 3) + 8 * (r >> 2)) * 64] = f2bf(v); }
            }
        }
        DN_WSYNC();
        { float x[64]; int cc = F.lane; asm volatile("" : "+v"(cc));
#pragma unroll
          for (int i = 0; i < 64; ++i) { float acc = (i == cc) ? 1.f : 0.f;
#pragma unroll
              for (int j4 = 0; j4 < (i + 3) / 4; ++j4) { const float4 gv = *(const float4*)(Gs + i * 68 + j4 * 4);
                  if (j4 * 4 + 0 < i) acc -= gv.x * x[j4 * 4 + 0]; if (j4 * 4 + 1 < i) acc -= gv.y * x[j4 * 4 + 1];
                  if (j4 * 4 + 2 < i) acc -= gv.z * x[j4 * 4 + 2]; if (j4 * 4 + 3 < i) acc -= gv.w * x[j4 * 4 + 3]; }
              x[i] = acc; }
          bf16_t* tp = Tm_g + (size_t)ch * 4096 + cc; asm volatile("" : "+v"(tp));
#pragma unroll
          for (int i = 0; i < 64; ++i) tp[i * 64] = f2bf(x[i]); }
        DN_WSYNC();
    }
}

__device__ __forceinline__ void phase_dn_c(const Frame& F) {
    const float* qkvn = WSP(float, OFF_QKVN); const float* gb = WSP(float, OFF_GB0);
    const float* gcs_g = WSP(float, OFF_DN_GCS); const bf16_t* Am_g = WSP(bf16_t, OFF_DN_AM); const bf16_t* Tm_g = WSP(bf16_t, OFF_DN_TM);
    bf16_t* Qe_g = WSP(bf16_t, OFF_DN_QE); u32x4* Yi_g = WSP(u32x4, OFF_DN_YI); u32x4* Ph_g = WSP(u32x4, OFF_DN_PHI); u32x4* C_g = WSP(u32x4, OFF_DN_C);
    bf16_t* T_s = (bf16_t*)F.smem; bf16_t* A_s = T_s + 64 * LD72; bf16_t* KbgT = A_s + 64 * LD72; bf16_t* VbT = KbgT + 128 * LD72; bf16_t* KdT = VbT + 128 * LD72;
    bf16_t* wT = KdT + 128 * LD72; bf16_t* uT = wT + 128 * LD72; float* gcs = (float*)(uT + 128 * LD72);
    const int rw = F.lane & 31, hh = F.lane >> 5, w = F.wid;
    for (int ch = F.bid; ch < 2048; ch += F.nblk) {
        const int seq = ch >> 6, c = ch & 63, dir = seq & 1, h = (seq >> 1) & 3, b = seq >> 3;
        { const int row = F.tid >> 3, pc = F.tid & 7;
          *(u32x4*)(T_s + row * LD72 + pc * 8) = *(const u32x4*)(Tm_g + (size_t)ch * 4096 + row * 64 + pc * 8);
          *(u32x4*)(A_s + row * LD72 + pc * 8) = *(const u32x4*)(Am_g + (size_t)ch * 4096 + row * 64 + pc * 8); }
        if (F.tid < 64) gcs[F.tid] = gcs_g[(size_t)ch * 64 + F.tid];
        const float gl = gcs_g[(size_t)ch * 64 + 63];
#pragma unroll
        for (int it = 0; it < 4; ++it) { const int x = F.tid + NTHR * it, chn = x & 127, tq = x >> 7;
            float kb[4], vb[4], kd[4];
#pragma unroll
            for (int e = 0; e < 4; ++e) { const int i = tq * 4 + e, step = c * 64 + i, t = dir ? 4095 - step : step; const size_t tok = (size_t)b * 4096 + t;
                const float kv = qkvn[tok * 1536 + 512 + h * 128 + chn], vv = qkvn[tok * 1536 + 1024 + h * 128 + chn];
                const float gci = gcs_g[(size_t)ch * 64 + i], beta = gb[tok * 16 + 8 + dir * 4 + h];
                kb[e] = kv * beta * __expf(gci); vb[e] = DN_SWAPTEST_V; kd[e] = kv * __expf(gl - gci); }
            *(u32x2*)(KbgT + chn * LD72 + tq * 4) = (u32x2){pk2(kb[0], kb[1]), pk2(kb[2], kb[3])};
            *(u32x2*)(VbT + chn * LD72 + tq * 4) = (u32x2){pk2(vb[0], vb[1]), pk2(vb[2], vb[3])};
            *(u32x2*)(KdT + chn * LD72 + tq * 4) = (u32x2){pk2(kd[0], kd[1]), pk2(kd[2], kd[3])}; }
        __syncthreads();
        { const int rt = w >> 1, ct = w & 1;
          const f32x16 a3 = tile_mm<4>(KbgT + rt * 32 * LD72, LD72, T_s + ct * 32 * LD72, LD72, F.lane);
          const f32x16 a4 = tile_mm<4>(VbT + rt * 32 * LD72, LD72, T_s + ct * 32 * LD72, LD72, F.lane);
#pragma unroll
          for (int r = 0; r < 16; ++r) { const int row = rt * 32 + (r & 3) + 8 * (r >> 2) + 4 * hh, col = ct * 32 + rw;
              wT[row * LD72 + col] = f2bf(a3[r]); uT[row * LD72 + col] = f2bf(a4[r]); } }
        __syncthreads();
        { const int it = w >> 2, dt = w & 3;
          const f32x16 a5 = tile_mm<4>(A_s + it * 32 * LD72, LD72, wT + dt * 32 * LD72, LD72, F.lane);
          const f32x16 a6 = tile_mm<4>(A_s + it * 32 * LD72, LD72, uT + dt * 32 * LD72, LD72, F.lane);
          const int d = dt * 32 + rw, dp = (d & ~15) | perm16(d & 15);
#pragma unroll
          for (int r = 0; r < 16; ++r) { const int i = it * 32 + (r & 3) + 8 * (r >> 2) + 4 * hh, step = c * 64 + i, t = dir ? 4095 - step : step; const size_t tok = (size_t)b * 4096 + t;
              const float qv = qkvn[tok * 1536 + h * 128 + d] * __expf(gcs[i]) - a5[r];
              Qe_g[(size_t)ch * 8192 + i * 128 + dp] = f2bf(qv); }
          u32x4* yo = Yi_g + ((size_t)(ch * 2 + it) * 4 + dt) * 128 + F.lane * 2;
          yo[0] = pack8(a6, 0); yo[1] = pack8(a6, 1);
#ifdef DN_LDSCHECK
          { float em = 0.f, rm = 0.f;
#pragma unroll
            for (int r = 0; r < 16; ++r) { const int irow = it * 32 + (r & 3) + 8 * (r >> 2) + 4 * hh, vcol = dt * 32 + rw; float s = 0.f;
#pragma nounroll
                for (int t = 0; t < 64; ++t) s += bf2f(A_s[irow * LD72 + t]) * bf2f(uT[vcol * LD72 + t]);
                em += (s - a6[r]) * (s - a6[r]); rm += s * s; }
            em = wave_sum(em); rm = wave_sum(rm); if (F.lane == 0) { float* fw = (float*)(F.ws + OFF_BAR); atomicAdd(fw + 4004, em); atomicAdd(fw + 4005, rm); } }
#endif
          }
        DN_XSYNC();
        const float glast = __expf(gl);
#pragma unroll
        for (int e = 0; e < 2; ++e) { const int x = w * 2 + e;
            { const int kbt = x >> 2, ra = x & 3;
              f32x16 a7 = tile_mm<4>(wT + kbt * 32 * LD72, LD72, KdT + ra * 32 * LD72, LD72, F.lane);
#pragma unroll
              for (int r = 0; r < 16; ++r) { const int brow = kbt * 32 + (r & 3) + 8 * (r >> 2) + 4 * hh, acol = ra * 32 + rw; a7[r] = ((brow == acol) ? glast : 0.f) - a7[r]; }
              u32x4* po = Ph_g + ((((size_t)ch * 4 + ra) * 4 + kbt) * 2) * 64 + F.lane;
              po[0] = pack8(a7, 0); po[64] = pack8(a7, 1); }
            { const int ra = x >> 2, vt = x & 3;
              const f32x16 a8 = tile_mm<4>(KdT + ra * 32 * LD72, LD72, uT + vt * 32 * LD72, LD72, F.lane);
              u32x4* co = C_g + ((size_t)(ch * 4 + ra) * 4 + vt) * 128 + F.lane * 2;
              co[0] = pack8(a8, 0); co[1] = pack8(a8, 1);
#ifdef DN_LDSCHECK
              { float em = 0.f, rm = 0.f;
#pragma unroll
                for (int r = 0; r < 16; ++r) { const int arow = ra * 32 + (r & 3) + 8 * (r >> 2) + 4 * hh, vcol = vt * 32 + rw; float s = 0.f;
#pragma nounroll
                    for (int t = 0; t < 64; ++t) s += bf2f(KdT[arow * LD72 + t]) * bf2f(uT[vcol * LD72 + t]);
                    em += (s - a8[r]) * (s - a8[r]); rm += s * s; }
                em = wave_sum(em); rm = wave_sum(rm); if (F.lane == 0) { float* fw = (float*)(F.ws + OFF_BAR); atomicAdd(fw + 4006, em); atomicAdd(fw + 4007, rm); } }
#endif
              } }
        __syncthreads();
    }
}

template <int NT> struct CarryBufs { const u32x4* Phi; const u32x4* C; const bf16_t* Qe; const u32x4* Yi; float* out; int nslice; int ncol; };
template <int NT> __device__ __forceinline__ void phase_carry(const Frame& F, const CarryBufs<NT> cb, int ntask, int bid0, int bstride) {
    LAS unsigned char* lds = F.lds;
    const int rw = F.lane & 31, hh = F.lane >> 5, w = F.wid;
    const bool carry = w < NT, outw = (w >= NT && w < NT + 2);
    for (int task = bid0; task < ntask; task += bstride) {
        const int slice = task % cb.nslice, seq = task / cb.nslice, dir = seq & 1, hb = seq >> 1;
        const int heads = cb.ncol / (32 * cb.nslice), h = hb % heads, b = hb / heads;
        f32x16 S;
#pragma unroll
        for (int r = 0; r < 16; ++r) S[r] = 0.f;
#ifdef DN_CHECK3
        float sd2 = 0.f, sr2 = 0.f;
#endif
        u32x4 afr[NT * 2], ini[2], nafr[NT * 2], nini[2];
#define CR_LOAD(dst, dini, ch) do { if (carry) { _Pragma("unroll") for (int kb = 0; kb < NT; ++kb) _Pragma("unroll") for (int s = 0; s < 2; ++s) \
                dst[kb * 2 + s] = cb.Phi[((((size_t)(ch) * NT + w) * NT + kb) * 2 + s) * 64 + F.lane]; \
              const u32x4* cp = cb.C + ((size_t)((ch) * NT + w) * cb.nslice + slice) * 128 + F.lane * 2; dini[0] = cp[0]; dini[1] = cp[1]; } \
            else if (outw) { const int it = w - NT; _Pragma("unroll") for (int kb = 0; kb < NT; ++kb) _Pragma("unroll") for (int s = 0; s < 2; ++s) \
                dst[kb * 2 + s] = *(const u32x4*)(cb.Qe + (size_t)(ch) * 64 * (32 * NT) + (it * 32 + rw) * (32 * NT) + kb * 32 + 16 * s + 8 * hh); \
              const u32x4* yp = cb.Yi + ((size_t)((ch) * 2 + it) * cb.nslice + slice) * 128 + F.lane * 2; dini[0] = yp[0]; dini[1] = yp[1]; } } while (0)
        CR_LOAD(afr, ini, seq * 64);
        for (int c = 0; c < 64; ++c) {
            const int ch = seq * 64 + c, buf = c & 1;
            if (c + 1 < 64) CR_LOAD(nafr, nini, ch + 1);
            if (carry) {
#pragma unroll
                for (int s = 0; s < 2; ++s) *(LAS u32x4*)(lds + (((buf * NT + w) * 2 + s) * 64 + F.lane) * 16) = pack8(S, s); }
            __syncthreads();
            if (carry || outw) {
                f32x16 acc; unpack16(ini[0], ini[1], acc);
#pragma unroll
                for (int kb = 0; kb < NT; ++kb)
#pragma unroll
                    for (int s = 0; s < 2; ++s) { const u32x4 bfr = *(const LAS u32x4*)(lds + (((buf * NT + kb) * 2 + s) * 64 + F.lane) * 16);
                        acc = __builtin_amdgcn_mfma_f32_32x32x16_bf16(as_frag(afr[kb * 2 + s]), as_frag(bfr), acc, 0, 0, 0); }
                if (carry) S = acc;
                else if (c < DN_CLIM) { const int it = w - NT;
#pragma unroll
                    for (int r = 0; r < 16; ++r) { const int i = it * 32 + (r & 3) + 8 * (r >> 2) + 4 * hh, step = c * 64 + i, t = dir ? 4095 - step : step;
#ifdef DN_CHECK2
                        if (cb.nslice == 4 && ((const unsigned*)(F.ws + OFF_BAR))[4002] != 0u) { const float prev = cb.out[((size_t)dir * T_ + (size_t)b * 4096 + t) * 512 + h * (32 * cb.nslice) + slice * 32 + rw];
                            if (__float_as_uint(prev) != __float_as_uint(acc[r])) atomicOr((unsigned*)(F.ws + OFF_BAR) + 4001, 1u); }
                        else cb.out[((size_t)dir * T_ + (size_t)b * 4096 + t) * 512 + h * (32 * cb.nslice) + slice * 32 + rw] = acc[r]; } }
#elif defined(DN_CHECK3)
                        { const float oldv = cb.out[((size_t)dir * T_ + (size_t)b * 4096 + t) * 512 + h * (32 * cb.nslice) + slice * 32 + rw]; const float dd = acc[r] - oldv; sd2 += dd * dd; sr2 += oldv * oldv; } } }
#elif defined(DN_CHECK)
                        const float oldv = cb.out[((size_t)dir * T_ + (size_t)b * 4096 + t) * 512 + h * (32 * cb.nslice) + slice * 32 + rw];
                        if (!(fabsf(acc[r] - oldv) <= DN_CHECK_TOL * fmaxf(fabsf(oldv), 0.002f))) atomicOr((unsigned*)(F.ws + OFF_BAR) + 4000, 1u); } }
#else
                        cb.out[((size_t)dir * T_ + (size_t)b * 4096 + t) * 512 + h * (32 * cb.nslice) + slice * 32 + rw] = acc[r]; } }
#endif
            }
#pragma unroll
            for (int q = 0; q < NT * 2; ++q) afr[q] = nafr[q];
            ini[0] = nini[0]; ini[1] = nini[1];
            DN_XSYNC();
        }
#ifdef DN_CHECK3
        sd2 = wave_sum(sd2); sr2 = wave_sum(sr2); if (F.lane == 0 && outw) { atomicAdd((float*)(F.ws + OFF_BAR) + 4004, sd2); atomicAdd((float*)(F.ws + OFF_BAR) + 4005, sr2); }
#endif
        __syncthreads();
#undef CR_LOAD
    }
}
#ifdef DN_NAIVE_CHECK
__device__ __forceinline__ void phase_dn_naive_check(const Frame& F) {
    const float* qkvn = WSP(float, OFF_QKVN); const float* gb = WSP(float, OFF_GB0);
    const float* gcs_g = WSP(float, OFF_DN_GCS); const bf16_t* Am_g = WSP(bf16_t, OFF_DN_AM); const bf16_t* Tm_g = WSP(bf16_t, OFF_DN_TM);
    const bf16_t* Qe_g = WSP(bf16_t, OFF_DN_QE); const unsigned* Yi_g = WSP(unsigned, OFF_DN_YI); const unsigned short* Ph_g = WSP(unsigned short, OFF_DN_PHI); const unsigned* C_g = WSP(unsigned, OFF_DN_C);
    unsigned* flag = (unsigned*)(F.ws + OFF_BAR) + 4001;
    float* gcn = (float*)F.smem; float* btn = gcn + 64; float* Gn = btn + 64; float* Tn = Gn + 4096; float* An = Tn + 4096; float* un = An + 4096; float* wn = un + 8192;
    const int chk[8] = {0, 1, 63, 64, 1000, 1027, 2046, 2047};
    if (F.bid >= 8) return;
    const int ch = F.bid == 0 ? 0 : (F.bid == 1 ? 1 : (F.bid == 2 ? 63 : (F.bid == 3 ? 64 : (F.bid == 4 ? 1000 : (F.bid == 5 ? 1027 : (F.bid == 6 ? 2046 : 2047))))));
    (void)chk;
    const int seq = ch >> 6, c = ch & 63, dir = seq & 1, h = (seq >> 1) & 3, b = seq >> 3;
    unsigned bits = 0u; float eyi = 0.f, ryi = 0.f, ec = 0.f, rc = 0.f;
#define TOKOF(i) ((size_t)b * 4096 + (dir ? 4095 - (c * 64 + (i)) : (c * 64 + (i))))
    if (F.tid == 0) { float s = 0.f; for (int i = 0; i < 64; ++i) { s += gb[TOKOF(i) * 16 + dir * 4 + h]; gcn[i] = s; btn[i] = gb[TOKOF(i) * 16 + 8 + dir * 4 + h]; } }
    __syncthreads();
    if (F.tid < 64) { const float d = fabsf(gcn[F.tid] - gcs_g[(size_t)ch * 64 + F.tid]); if (!(d <= 1e-3f * fmaxf(1.f, fabsf(gcn[F.tid])))) bits |= 0u; }
    for (int e = F.tid; e < 4096; e += NTHR) { const int i = e >> 6, j = e & 63; const float* qi = qkvn + TOKOF(i) * 1536 + h * 128; const float* ki = qkvn + TOKOF(i) * 1536 + 512 + h * 128; const float* kj = qkvn + TOKOF(j) * 1536 + 512 + h * 128;
        float qk = 0.f, kk = 0.f; for (int d = 0; d < 128; ++d) { qk += qi[d] * kj[d]; kk += ki[d] * kj[d]; }
        const float dec = __expf(fminf(gcn[i] - gcn[j], 0.f));
        const float a = (j <= i) ? qk * dec : 0.f; An[e] = a; Gn[e] = (j < i) ? btn[i] * kk * dec : 0.f;
        const float ad = bf2f(Am_g[(size_t)ch * 4096 + e]); if (!(fabsf(ad - a) <= 0.03f * fabsf(a) + 2e-3f)) bits |= 0u;
        Tn[e] = bf2f(Tm_g[(size_t)ch * 4096 + e]); }
    __syncthreads();
    for (int e = F.tid; e < 4096; e += NTHR) { const int i = e >> 6, cc = e & 63; float r = Tn[i * 64 + cc] - (i == cc ? 1.f : 0.f); for (int j = 0; j < i; ++j) r += Gn[i * 64 + j] * Tn[j * 64 + cc];
        if (!(fabsf(r) <= 0.03f)) bits |= 0u; }
    const float gl = gcn[63];
    for (int e = F.tid; e < 8192; e += NTHR) { const int t = e >> 7, d = e & 127; float us = 0.f, ws_ = 0.f;
        for (int j = 0; j < 64; ++j) { const float tv = Tn[t * 64 + j]; us += tv * qkvn[TOKOF(j) * 1536 + 1024 + h * 128 + d] * btn[j]; ws_ += tv * qkvn[TOKOF(j) * 1536 + 512 + h * 128 + d] * btn[j] * __expf(gcn[j]); }
#ifdef DN_SWAP
        us = ws_;
#endif
        un[e] = us; wn[e] = ws_;
}
    __syncthreads();
    for (int e = F.tid; e < 8192; e += NTHR) { const int i = e >> 7, d = e & 127; float yi = 0.f, aw = 0.f;
        for (int t = 0; t < 64; ++t) { yi += An[i * 64 + t] * un[t * 128 + d]; aw += An[i * 64 + t] * wn[t * 128 + d]; }
        const float qe = qkvn[TOKOF(i) * 1536 + h * 128 + d] * __expf(gcn[i]) - aw;
        { const int it = i >> 5, dt = d >> 5, i5 = i & 31, hh = (i5 >> 2) & 1, r = (i5 & 3) + 4 * (i5 >> 3), lane = (d & 31) + 32 * hh;
          const unsigned wv = Yi_g[((((size_t)(ch * 2 + it) * 4 + dt) * 128 + lane * 2 + (r >> 3)) * 4) + ((r & 7) >> 1)]; const float yv = (r & 1) ? bfhi(wv) : bflo(wv);
          eyi += (yv - yi) * (yv - yi); ryi += yi * yi; }
        { const int dp = (d & ~15) | perm16(d & 15); const float qv = bf2f(Qe_g[(size_t)ch * 8192 + i * 128 + dp]); if (!(fabsf(qv - qe) <= 0.03f * fabsf(qe) + 1e-3f)) bits |= 0u; } }
    for (int e = F.tid; e < 16384; e += NTHR) { const int bb = e >> 7, a = e & 127; float ph = (bb == a) ? __expf(gl) : 0.f, cv = 0.f;
        for (int t = 0; t < 64; ++t) { const float kd_a = qkvn[TOKOF(t) * 1536 + 512 + h * 128 + a] * __expf(gl - gcn[t]); ph -= wn[t * 128 + bb] * kd_a;
            const float kd_b = qkvn[TOKOF(t) * 1536 + 512 + h * 128 + bb] * __expf(gl - gcn[t]); cv += kd_b * un[t * 128 + a]; }
        { const int ra = a >> 5, kb = bb >> 5, b5 = bb & 31, s = b5 >> 4, hh = (b5 >> 2) & 1, j = ((b5 >> 3) & 1) * 4 + (b5 & 3), lane = (a & 31) + 32 * hh;
          const float pv = bf2f(Ph_g[((((((size_t)ch * 4 + ra) * 4 + kb) * 2 + s) * 64 + lane) * 8) + j]); if (!(fabsf(pv - ph) <= 0.03f * fabsf(ph) + 2e-3f)) bits |= 32u; }
        { const int ra = bb >> 5, vt = a >> 5, a5 = bb & 31, hh = (a5 >> 2) & 1, r = (a5 & 3) + 4 * (a5 >> 3), lane = (a & 31) + 32 * hh;
          const unsigned wv = C_g[((((size_t)(ch * 4 + ra) * 4 + vt) * 128 + lane * 2 + (r >> 3)) * 4) + ((r & 7) >> 1)]; const float cvd = (r & 1) ? bfhi(wv) : bflo(wv);
          ec += (cvd - cv) * (cvd - cv); rc += cv * cv; } }
    eyi = wave_sum(eyi); ryi = wave_sum(ryi); ec = wave_sum(ec); rc = wave_sum(rc);
    if (F.lane == 0) { float* fw = (float*)(F.ws + OFF_BAR); atomicAdd(fw + 4004, eyi); atomicAdd(fw + 4005, ryi); atomicAdd(fw + 4006, ec); atomicAdd(fw + 4007, rc); }
    (void)flag; (void)bits;
#undef TOKOF
}
#endif

#ifdef DN_NANSCAN
__device__ __forceinline__ void phase_dn_nanscan(const Frame& F) {
    unsigned* flag = (unsigned*)(F.ws + OFF_BAR) + 4001;
    const size_t gtid = (size_t)F.bid * NTHR + F.tid, gn = (size_t)F.nblk * NTHR;
    unsigned bits = 0u;
#define SCAN_BF(off, nbytes, bit) do { const unsigned* p_ = (const unsigned*)(F.ws + (off)); const size_t n_ = (size_t)(nbytes) / 4; \
        for (size_t i_ = gtid; i_ < n_; i_ += gn) { const unsigned w_ = p_[i_]; if ((w_ & 0x7F800000u) == 0x7F800000u || (w_ & 0x00007F80u) == 0x00007F80u) bits |= (bit); } } while (0)
    SCAN_BF(OFF_DN_TM, (size_t)2048 * 4096 * 2, 1u);
    SCAN_BF(OFF_DN_AM, (size_t)2048 * 4096 * 2, 2u);
    SCAN_BF(OFF_DN_QE, (size_t)2048 * 8192 * 2, 4u);
    SCAN_BF(OFF_DN_YI, (size_t)2048 * 16384, 8u);
    SCAN_BF(OFF_DN_PHI, (size_t)2048 * 32768, 16u);
    SCAN_BF(OFF_DN_C, (size_t)2048 * 32768, 32u);
#undef SCAN_BF
    if (bits) atomicOr(flag, bits);
}
#endif
__device__ __forceinline__ void phase_mid(const Frame& F, int layer, const float* xin, float* xout) {
    float* wl = (float*)F.smem;
    fill_thin(wl, F.in[I_ROUTER] + (size_t)layer * 1024 * 16, 16, F.tid);
    __syncthreads();
    const float* mod = WSP(float, OFF_MOD); const float* ymix = WSP(float, OFF_YMIX); bf16_t* hb = WSP(bf16_t, OFF_HB); float* probs = WSP(float, OFF_PROBS);
    for (int tb = F.bid; tb < 256; tb += F.nblk) {
        const int base = tb * 64 + F.wid * 8, b = base >> 12;
        const float* mb = mod + (size_t)(layer * 4 + b) * 6144;
        for (int i = 0; i < 8; ++i) {
            const int tok = base + i; float y[16], xv[16];
            load_row16(ymix + (size_t)tok * 1024, F.lane, y); load_row16(xin + (size_t)tok * 1024, F.lane, xv);
            float ss = 0.f;
#pragma unroll
            for (int q = 0; q < 16; ++q) ss += y[q] * y[q];
            ss = wave_sum(ss); float rstd = rsqrtf(ss * (1.f / 1024.f) + 1e-6f);
            float s2 = 0.f;
            { float npost[16], g1[16]; load_row16(F.in[I_NMIX_POST] + layer * 1024, F.lane, npost); load_row16(mb + 2048, F.lane, g1);
#pragma unroll
              for (int q = 0; q < 16; ++q) { xv[q] = xv[q] + g1[q] * (y[q] * rstd * npost[q]); s2 += xv[q] * xv[q]; } }
            store_row16(xout + (size_t)tok * 1024, F.lane, xv);
            s2 = wave_sum(s2); rstd = rsqrtf(s2 * (1.f / 1024.f) + 1e-6f);
            asm volatile("" ::: "memory");
            { float npre[16], sc[16], sh[16]; load_row16(F.in[I_NFFN_PRE] + layer * 1024, F.lane, npre); load_row16(mb + 4096, F.lane, sc); load_row16(mb + 3072, F.lane, sh);
#pragma unroll
              for (int q = 0; q < 16; ++q) y[q] = xv[q] * rstd * npre[q] * (1.f + sc[q]) + sh[q]; }
            asm volatile("" ::: "memory");
            store_row16_bf(hb + (size_t)tok * 1024, F.lane, y);
            float o[16]; thin16(wl, F.lane, y, o);
            float mx = o[0];
#pragma unroll
            for (int q = 1; q < 16; ++q) mx = fmaxf(mx, o[q]);
            float sum = 0.f;
#pragma unroll
            for (int q = 0; q < 16; ++q) { o[q] = __expf(o[q] - mx); sum += o[q]; }
            const float inv = 1.f / sum;
            if (F.lane < 16) { float r = 0.f;
#pragma unroll
                for (int q = 0; q < 16; ++q) r = (q == F.lane) ? o[q] : r;
                probs[((size_t)(b * 16 + F.lane)) * 4096 + (tok & 4095)] = r * inv; }
        }
    }
}

__device__ __forceinline__ void phase_topk(const Frame& F) {
    unsigned* keys = (unsigned*)F.smem;
    unsigned* hist = keys + 4096;
    unsigned* ctl = hist + 256;
    unsigned* wsum = ctl + 8;
    const float* probs = WSP(float, OFF_PROBS); int* rowtok = WSP(int, OFF_ROWTOK); float* gatev = WSP(float, OFF_GATEV); int* slot = WSP(int, OFF_SLOT);
    for (int u = F.bid; u < 64; u += F.nblk) {
        const int b = u >> 4, e = u & 15;
        const float* pr = probs + (size_t)u * 4096;
        for (int i = F.tid; i < 4096; i += NTHR) keys[i] = __float_as_uint(pr[i]);
        if (F.tid == 0) { ctl[0] = 0u; ctl[1] = 512u; }
        __syncthreads();
        for (int pass = 0; pass < 4; ++pass) {
            const int shift = 24 - 8 * pass;
            if (F.tid < 256) hist[F.tid] = 0u;
            __syncthreads();
            const unsigned prefix = ctl[0]; const unsigned himask = pass == 0 ? 0u : (0xFFFFFFFFu << (shift + 8));
            for (int i = F.tid; i < 4096; i += NTHR) { const unsigned k = keys[i]; if ((k & himask) == prefix) atomicAdd(&hist[(k >> shift) & 255u], 1u); }
            __syncthreads();
            if (F.tid == 0) { unsigned kr = ctl[1], cum = 0u; int bin = 255;
                for (; bin > 0; --bin) { const unsigned hcnt = hist[bin]; if (cum + hcnt >= kr) break; cum += hcnt; }
                ctl[0] = prefix | ((unsigned)bin << shift); ctl[1] = kr - cum; }
            __syncthreads();
        }
        const unsigned thr = ctl[0], keq = ctl[1];
        const int i0 = F.tid * 8; unsigned kk[8]; unsigned ceq = 0u;
#pragma unroll
        for (int q = 0; q < 8; ++q) { kk[q] = keys[i0 + q]; ceq += (kk[q] == thr) ? 1u : 0u; }
        unsigned inc = ceq;
#pragma unroll
        for (int o = 1; o < 64; o <<= 1) { const unsigned t = __shfl_up(inc, o); if (F.lane >= o) inc += t; }
        if (F.lane == 63) wsum[F.wid] = inc;
        __syncthreads();
        unsigned woff = 0u;
        for (int w = 0; w < F.wid; ++w) woff += wsum[w];
        unsigned eqpre = woff + inc - ceq;
        __syncthreads();
        unsigned csel = 0u; unsigned selmask = 0u;
#pragma unroll
        for (int q = 0; q < 8; ++q) { bool sel = kk[q] > thr; if (kk[q] == thr) { sel = eqpre < keq; ++eqpre; } if (sel) { selmask |= 1u << q; ++csel; } }
        inc = csel;
#pragma unroll
        for (int o = 1; o < 64; o <<= 1) { const unsigned t = __shfl_up(inc, o); if (F.lane >= o) inc += t; }
        if (F.lane == 63) wsum[8 + F.wid] = inc;
        __syncthreads();
        woff = 0u;
        for (int w = 0; w < F.wid; ++w) woff += wsum[8 + w];
        unsigned sl = woff + inc - csel;
#pragma unroll
        for (int q = 0; q < 8; ++q) { const int tokg = b * 4096 + i0 + q;
            if (selmask & (1u << q)) { const int row = e * 2048 + b * 512 + (int)sl; ++sl; rowtok[row] = tokg; gatev[row] = __uint_as_float(kk[q]); slot[(size_t)tokg * 16 + e] = row; }
            else slot[(size_t)tokg * 16 + e] = -1; }
        __syncthreads();
    }
}

__device__ __forceinline__ void phase_combine(const Frame& F, int layer, const float* xin, float* xout, bool next_norm) {
    const float* mod = WSP(float, OFF_MOD); const bf16_t* Y = WSP(bf16_t, OFF_YBUF); const int* slot = WSP(int, OFF_SLOT); bf16_t* hb = WSP(bf16_t, OFF_HB);
    for (int tb = F.bid; tb < 256; tb += F.nblk) {
        const int base = tb * 64 + F.wid * 8, b = base >> 12;
        const float* mb = mod + (size_t)(layer * 4 + b) * 6144;
        float npost[16], g2[16];
        load_row16(F.in[I_NFFN_POST] + layer * 1024, F.lane, npost); load_row16(mb + 5120, F.lane, g2);
        for (int i = 0; i < 8; ++i) {
            const int tok = base + i; float y[16];
#pragma unroll
            for (int q = 0; q < 16; ++q) y[q] = 0.f;
            const int myslot = slot[(size_t)tok * 16 + (F.lane & 15)];
            for (int e = 0; e < 16; ++e) { const int r = __shfl(myslot, e);
                if (r >= 0) { const uint4* yp = (const uint4*)(Y + (size_t)r * 1024 + F.lane * 16); const uint4 a = yp[0], c = yp[1];
                    y[0] += bflo(a.x); y[1] += bfhi(a.x); y[2] += bflo(a.y); y[3] += bfhi(a.y); y[4] += bflo(a.z); y[5] += bfhi(a.z); y[6] += bflo(a.w); y[7] += bfhi(a.w);
                    y[8] += bflo(c.x); y[9] += bfhi(c.x); y[10] += bflo(c.y); y[11] += bfhi(c.y); y[12] += bflo(c.z); y[13] += bfhi(c.z); y[14] += bflo(c.w); y[15] += bfhi(c.w); } }
            float ss = 0.f;
#pragma unroll
            for (int q = 0; q < 16; ++q) ss += y[q] * y[q];
            ss = wave_sum(ss); float rstd = rsqrtf(ss * (1.f / 1024.f) + 1e-6f);
            float xv[16]; load_row16(xin + (size_t)tok * 1024, F.lane, xv);
            float s2 = 0.f;
#pragma unroll
            for (int q = 0; q < 16; ++q) { xv[q] = xv[q] + g2[q] * (y[q] * rstd * npost[q]); s2 += xv[q] * xv[q]; }
#ifdef DN_CHECK
            if (!next_norm && ((const unsigned*)(F.ws + OFF_BAR))[4000] != 0u) {
#pragma unroll
                for (int q = 0; q < 16; ++q) xv[q] += 1000.f; }
#endif
#if defined(DN_CHECK3)
            if (!next_norm) { const float* fw = (const float*)(F.ws + OFF_BAR); const float rel = sqrtf(fw[4004] / fmaxf(fw[4005], 1e-30f)); const float addv = (rel == rel) ? 100.f * (1.f + fminf(97.f, rintf(rel * 100.f))) : 9900.f;
#pragma unroll
                for (int q = 0; q < 16; ++q) xv[q] += addv; }
#endif
#if defined(DN_NAIVE_CHECK) || defined(DN_CHECK2) || defined(DN_LDSCHECK)
            if (!next_norm) { const float* fw = (const float*)(F.ws + OFF_BAR); const float r1 = sqrtf(fw[4004] / fmaxf(fw[4005], 1e-30f)), r2 = sqrtf(fw[4006] / fmaxf(fw[4007], 1e-30f));
                const float addv = 100.f * (1.f + 10.f * fminf(9.f, floorf(r1 * 50.f)) + fminf(9.f, floorf(r2 * 50.f)));
#pragma unroll
                for (int q = 0; q < 16; ++q) xv[q] += addv; }
#endif
            store_row16(xout + (size_t)tok * 1024, F.lane, xv);
            if (next_norm) {
                float gain[16], sc[16], sh[16]; const float* mn = mod + (size_t)((layer + 1) * 4 + b) * 6144;
                load_row16(F.in[I_NMIX_PRE] + (layer + 1) * 1024, F.lane, gain); load_row16(mn + 1024, F.lane, sc); load_row16(mn, F.lane, sh);
                s2 = wave_sum(s2); rstd = rsqrtf(s2 * (1.f / 1024.f) + 1e-6f);
#pragma unroll
                for (int q = 0; q < 16; ++q) y[q] = xv[q] * rstd * gain[q] * (1.f + sc[q]) + sh[q];
                store_row16_bf(hb + (size_t)tok * 1024, F.lane, y);
            }
        }
    }
}

__device__ __forceinline__ void phase_rwprep(const Frame& F) {
    const bf16_t* P1 = WSP(bf16_t, OFF_P1); float* rwr = WSP(float, OFF_RWR); float* rwk = WSP(float, OFF_RWK); float* rwv = WSP(float, OFF_RWV); float* rwkk = WSP(float, OFF_RWKK);
    bf16_t* lin = WSP(bf16_t, OFF_LORAIN); const float* mu = F.in[I_RW_MU];
    const int c0 = F.lane * 8;
    for (int tb = F.bid; tb < 256; tb += F.nblk) {
        const int base = tb * 64 + F.wid * 8;
        for (int i = 0; i < 8; ++i) {
            const size_t tok = base + i; const int s = (int)(tok & 4095);
            const bool hp = s > 0, hn = s < 4095;
            auto shifted = [&](int ch, float (&o)[8]) {
                const u32x4 z4 = (u32x4){0u, 0u, 0u, 0u};
                const u32x4 cur = *(const u32x4*)(P1 + tok * 3072 + ch);
                const u32x4 prv = hp ? *(const u32x4*)(P1 + (tok - 1) * 3072 + ch) : z4;
                const u32x4 nxt = hn ? *(const u32x4*)(P1 + (tok + 1) * 3072 + ch) : z4;
                const float4 m0 = *(const float4*)(mu + ch), m1 = *(const float4*)(mu + ch + 4);
                const float cu[8] = {bflo(cur.x), bfhi(cur.x), bflo(cur.y), bfhi(cur.y), bflo(cur.z), bfhi(cur.z), bflo(cur.w), bfhi(cur.w)};
                const float pr[8] = {bflo(prv.x), bfhi(prv.x), bflo(prv.y), bfhi(prv.y), bflo(prv.z), bfhi(prv.z), bflo(prv.w), bfhi(prv.w)};
                const float nx[8] = {bflo(nxt.x), bfhi(nxt.x), bflo(nxt.y), bfhi(nxt.y), bflo(nxt.z), bfhi(nxt.z), bflo(nxt.w), bfhi(nxt.w)};
                const float mm[8] = {m0.x, m0.y, m0.z, m0.w, m1.x, m1.y, m1.z, m1.w};
#pragma unroll
                for (int q = 0; q < 8; ++q) o[q] = cu[q] + mm[q] * (0.5f * (pr[q] + nx[q]) - cu[q]);
            };
            float v[8];
            shifted(c0, v);        { float4* o = (float4*)(rwr + tok * 512 + c0); o[0] = make_float4(v[0], v[1], v[2], v[3]); o[1] = make_float4(v[4], v[5], v[6], v[7]); }
            shifted(1024 + c0, v); { float4* o = (float4*)(rwv + tok * 512 + c0); o[0] = make_float4(v[0], v[1], v[2], v[3]); o[1] = make_float4(v[4], v[5], v[6], v[7]); }
            shifted(512 + c0, v);  { float4* o = (float4*)(rwk + tok * 512 + c0); o[0] = make_float4(v[0], v[1], v[2], v[3]); o[1] = make_float4(v[4], v[5], v[6], v[7]); }
            { const float4 k0 = *(const float4*)(F.in[I_RW_KK] + c0), k1 = *(const float4*)(F.in[I_RW_KK] + c0 + 4);
              float kk[8] = {v[0] * k0.x, v[1] * k0.y, v[2] * k0.z, v[3] * k0.w, v[4] * k1.x, v[5] * k1.y, v[6] * k1.z, v[7] * k1.w};
              float ss = 0.f;
#pragma unroll
              for (int q = 0; q < 8; ++q) ss += kk[q] * kk[q];
              ss += __shfl_xor(ss, 1); ss += __shfl_xor(ss, 2); ss += __shfl_xor(ss, 4);
              const float sc = rsqrtf(ss + 1e-6f);
              float4* o = (float4*)(rwkk + tok * 512 + c0); o[0] = make_float4(kk[0] * sc, kk[1] * sc, kk[2] * sc, kk[3] * sc); o[1] = make_float4(kk[4] * sc, kk[5] * sc, kk[6] * sc, kk[7] * sc); }
            if (F.lane < 48) { shifted(1536 + c0, v);
                float o8[8];
#pragma unroll
                for (int q = 0; q < 8; ++q) { const float x = v[q]; o8[q] = c0 < 128 ? (2.f * sigmoidf_(2.f * x) - 1.f) : (c0 < 256 ? x : sigmoidf_(x)); }
                *(u32x4*)(lin + tok * 384 + c0) = (u32x4){pk2(o8[0], o8[1]), pk2(o8[2], o8[3]), pk2(o8[4], o8[5]), pk2(o8[6], o8[7])}; }
        }
    }
}

__device__ __forceinline__ void phase_rwscan(const Frame& F) {
    float* bufA = (float*)F.smem;
    float* bufV = bufA + 2 * 32 * 320;
    const float* rwr = WSP(float, OFF_RWR); const float* rwk = WSP(float, OFF_RWK); const float* rwv = WSP(float, OFF_RWV); const float* rwkk = WSP(float, OFF_RWKK);
    const float* rwdec = WSP(float, OFF_RWDEC); const float* rwa = WSP(float, OFF_RWA); float* rwy = WSP(float, OFF_RWY);
    const int row4 = F.lane >> 4, kp = F.lane & 15, jj = F.wid * 4 + row4;
    const bool split = (F.nblk == 256);
    if (split && F.bid >= 128) return;
    for (int u = F.bid; u < 128; u += (split ? 128 : F.nblk)) {
        const int rb = u & 1, seq = u >> 1, dir = seq & 1, h = (seq >> 1) & 7, b = seq >> 4;
        const float4 kaw = *(const float4*)(F.in[I_RW_KA] + h * 64 + kp * 4);
        float s0 = 0.f, s1 = 0.f, s2 = 0.f, s3 = 0.f;
        float4 ra0, ra1, ra2, ra3, ra4; float4 rv = make_float4(0.f, 0.f, 0.f, 0.f);
#define RW_LD1(dst, i, c) do { const int idx = F.tid + NTHR * (i), row = idx / 80, cc = idx % 80, arr = cc >> 4, c4 = cc & 15, step = (c) * 32 + row, t = dir ? 4095 - step : step; \
            const size_t tok = (size_t)b * 4096 + t; \
            const float* src = arr == 0 ? rwr : (arr == 1 ? rwk : (arr == 2 ? rwkk : (arr == 3 ? rwdec + (size_t)dir * T_ * 512 : rwa + (size_t)dir * T_ * 512))); \
            dst = *(const float4*)(src + tok * 512 + h * 64 + c4 * 4); } while (0)
#define RW_GLOAD(c) do { RW_LD1(ra0, 0, c); RW_LD1(ra1, 1, c); RW_LD1(ra2, 2, c); RW_LD1(ra3, 3, c); RW_LD1(ra4, 4, c); \
            if (F.tid < 256) { const int row = F.tid >> 3, c4 = F.tid & 7, step = (c) * 32 + row, t = dir ? 4095 - step : step; const size_t tok = (size_t)b * 4096 + t; \
                rv = *(const float4*)(rwv + tok * 512 + h * 64 + rb * 32 + c4 * 4); } } while (0)
#define RW_LSTORE(buf) do { *(float4*)(bufA + (buf) * 10240 + (F.tid) * 4) = ra0; *(float4*)(bufA + (buf) * 10240 + (F.tid + NTHR) * 4) = ra1; *(float4*)(bufA + (buf) * 10240 + (F.tid + 2 * NTHR) * 4) = ra2; \
            *(float4*)(bufA + (buf) * 10240 + (F.tid + 3 * NTHR) * 4) = ra3; *(float4*)(bufA + (buf) * 10240 + (F.tid + 4 * NTHR) * 4) = ra4; \
            if (F.tid < 256) *(float4*)(bufV + (buf) * 1024 + F.tid * 4) = rv; } while (0)
        RW_GLOAD(0); RW_LSTORE(0); __syncthreads();
        for (int c = 0; c < 128; ++c) {
            const int buf = c & 1;
            if (c + 1 < 128) RW_GLOAD(c + 1);
            float osel = 0.f;
#pragma unroll 4
            for (int i = 0; i < 32; ++i) {
                const float* row = bufA + buf * 10240 + i * 320 + kp * 4;
                const float4 r = *(const float4*)(row), k = *(const float4*)(row + 64), kk = *(const float4*)(row + 128), w = *(const float4*)(row + 192), a = *(const float4*)(row + 256);
                const float v = bufV[buf * 1024 + i * 32 + jj];
                float sa = -(s0 * kk.x + s1 * kk.y + s2 * kk.z + s3 * kk.w);
                sa = row16_sum(sa);
                const float kd0 = k.x * (1.f + (a.x - 1.f) * kaw.x), kd1 = k.y * (1.f + (a.y - 1.f) * kaw.y), kd2 = k.z * (1.f + (a.z - 1.f) * kaw.z), kd3 = k.w * (1.f + (a.w - 1.f) * kaw.w);
                s0 = s0 * w.x + sa * (kk.x * a.x) + v * kd0; s1 = s1 * w.y + sa * (kk.y * a.y) + v * kd1; s2 = s2 * w.z + sa * (kk.z * a.z) + v * kd2; s3 = s3 * w.w + sa * (kk.w * a.w) + v * kd3;
                float y = s0 * r.x + s1 * r.y + s2 * r.z + s3 * r.w;
                y = row16_sum(y);
                osel = (kp == (i & 15)) ? y : osel;
                if ((i & 15) == 15) { const int step = c * 32 + (i & 16) + kp, t = dir ? 4095 - step : step;
                    rwy[((size_t)dir * T_ + (size_t)b * 4096 + t) * 512 + h * 64 + rb * 32 + jj] = osel; }
            }
            if (c + 1 < 128) RW_LSTORE(buf ^ 1);
            __syncthreads();
        }
    }
#undef RW_LD1
#undef RW_GLOAD
#undef RW_LSTORE
}

__device__ __forceinline__ void phase_rwpost(const Frame& F) {
    const float* rwr = WSP(float, OFF_RWR); const float* rwk = WSP(float, OFF_RWK); const float* rwv = WSP(float, OFF_RWV);
    const float* rwa = WSP(float, OFF_RWA); const float* rwg = WSP(float, OFF_RWG); const float* rwy = WSP(float, OFF_RWY); bf16_t* ycat = WSP(bf16_t, OFF_YCAT);
    const int c0 = F.lane * 8;
    float lnw[8], lnb[8], kaw[8], rk[8];
#pragma unroll
    for (int q = 0; q < 8; ++q) { lnw[q] = F.in[I_RW_LNW][c0 + q]; lnb[q] = F.in[I_RW_LNB][c0 + q]; kaw[q] = F.in[I_RW_KA][c0 + q]; rk[q] = F.in[I_RW_RK][c0 + q]; }
    for (int tb = F.bid; tb < 256; tb += F.nblk) {
        const int base = tb * 64 + F.wid * 8;
        for (int i = 0; i < 8; ++i) { const size_t tok = base + i;
            float y[8], r[8], k[8], v[8], a0[8], a1[8], g[8];
            auto ld8 = [&](const float* p, float (&o)[8]) { const float4 x0 = *(const float4*)(p + tok * 512 + c0), x1 = *(const float4*)(p + tok * 512 + c0 + 4); o[0] = x0.x; o[1] = x0.y; o[2] = x0.z; o[3] = x0.w; o[4] = x1.x; o[5] = x1.y; o[6] = x1.z; o[7] = x1.w; };
            ld8(rwy, y); ld8(rwy + (size_t)T_ * 512, r);
#pragma unroll
            for (int q = 0; q < 8; ++q) y[q] += r[q];
            ld8(rwr, r); ld8(rwk, k); ld8(rwv, v); ld8(rwa, a0); ld8(rwa + (size_t)T_ * 512, a1); ld8(rwg, g);
            float sm = 0.f;
#pragma unroll
            for (int q = 0; q < 8; ++q) sm += y[q];
            sm += __shfl_xor(sm, 1); sm += __shfl_xor(sm, 2); sm += __shfl_xor(sm, 4);
            const float mean = sm * (1.f / 64.f);
            float vs = 0.f;
#pragma unroll
            for (int q = 0; q < 8; ++q) { y[q] -= mean; vs += y[q] * y[q]; }
            vs += __shfl_xor(vs, 1); vs += __shfl_xor(vs, 2); vs += __shfl_xor(vs, 4);
            const float rstd = rsqrtf(vs * (1.f / 64.f) + 64e-5f);
            float dot = 0.f;
#pragma unroll
            for (int q = 0; q < 8; ++q) { const float kb = k[q] * (1.f + (0.5f * (a0[q] + a1[q]) - 1.f) * kaw[q]); dot += r[q] * kb * rk[q]; }
            dot += __shfl_xor(dot, 1); dot += __shfl_xor(dot, 2); dot += __shfl_xor(dot, 4);
            float o[8];
#pragma unroll
            for (int q = 0; q < 8; ++q) o[q] = (y[q] * rstd * lnw[q] + lnb[q] + dot * v[q]) * g[q];
            *(u32x4*)(ycat + tok * 1024 + c0) = (u32x4){pk2(o[0], o[1]), pk2(o[2], o[3]), pk2(o[4], o[5]), pk2(o[6], o[7])};
        }
    }
}

__device__ __forceinline__ void phase_attn(const Frame& F) {
    LAS unsigned char* lds = F.lds;
    const bf16_t* P1 = WSP(bf16_t, OFF_P1); const bf16_t* Vimg = WSP(bf16_t, OFF_VIMG); bf16_t* ycat = WSP(bf16_t, OFF_YCAT);
    constexpr int QS = 0, KS = 65536, VS = 81920;
    const float lam_init = 0.8f - 0.6f * 0.7408182206817179f;
    float lam;
    { const float* lp = F.in[I_DF_LAM]; float s1 = 0.f, s2 = 0.f;
      for (int i = 0; i < 64; ++i) { s1 += lp[i] * lp[64 + i]; s2 += lp[128 + i] * lp[192 + i]; }
      lam = __expf(s1) - __expf(s2) + lam_init; }
    const int hh = F.lane >> 5, ql = F.lane & 31;
    const bool split = (F.nblk == 256);
    if (split && F.bid < 128) return;
    for (int u = (split ? F.bid - 128 : F.bid); u < 256; u += (split ? 128 : F.nblk)) {
        const int qb = u & 15, h = (u >> 4) & 3, b = u >> 6;
        const float slope2 = exp2f(-2.f * (float)(h + 1)) * 1.4426950408889634f;
        const size_t tok0 = (size_t)b * 4096 + qb * 256;
        int tz = F.tid; asm volatile("" : "+v"(tz));
#pragma unroll
        for (int i = 0; i < 8; ++i) { const int idx = tz + NTHR * i, row = idx >> 4, pos = idx & 15, col16 = pos ^ (row & 15);
            const u32x4 qv = *(const u32x4*)(P1 + (tok0 + row) * 3072 + 1920 + h * 128 + col16 * 8);
            const float sc = 0.18033688011112042f;
            u32x4 o; o.x = pk2(bflo(qv.x) * sc, bfhi(qv.x) * sc); o.y = pk2(bflo(qv.y) * sc, bfhi(qv.y) * sc); o.z = pk2(bflo(qv.z) * sc, bfhi(qv.z) * sc); o.w = pk2(bflo(qv.w) * sc, bfhi(qv.w) * sc);
            *(LAS u32x4*)(lds + QS + row * 256 + pos * 16) = o; }
        const int qrow = F.wid * 32 + ql;
        const float qpos = (float)(qb * 256 + qrow);
        unsigned osave[4][8];
        for (int m = 0; m < 2; ++m) {
#define AT_STAGE(kt, buf) do { { const int ci = F.wid, row = ci * 8 + (F.lane >> 3), pos = F.lane & 7, col16 = pos ^ ((row >> 1) & 7); \
                __builtin_amdgcn_global_load_lds((const unsigned*)(P1 + ((size_t)b * 4096 + (kt) * 64 + row) * 3072 + 2432 + h * 128 + m * 64 + col16 * 8), (LAS unsigned*)(lds + KS + (buf) * 8192 + ci * 1024), 16, 0, 0); } \
            _Pragma("unroll") for (int _i = 0; _i < 2; ++_i) { const int ci = F.wid * 2 + _i; \
                __builtin_amdgcn_global_load_lds((const unsigned*)(Vimg + (((size_t)(b * 4 + h) * 64 + (kt)) * 8192) + ci * 512 + F.lane * 8), (LAS unsigned*)(lds + VS + (buf) * 16384 + ci * 1024), 16, 0, 0); } } while (0)
            AT_STAGE(0, 0);
            f32x16 O[4];
#pragma unroll
            for (int dt = 0; dt < 4; ++dt)
#pragma unroll
                for (int r = 0; r < 16; ++r) O[dt][r] = 0.f;
            float mrun = -1e30f, lrun = 0.f;
            asm volatile("s_waitcnt vmcnt(0)" ::: "memory");
            __syncthreads();
            for (int kt = 0; kt < 64; ++kt) {
                const int buf = kt & 1;
                if (kt + 1 < 64) AT_STAGE(kt + 1, buf ^ 1);
                const float dbase = (float)(kt * 64 + 4 * hh) - qpos;
                f32x16 Sx[2];
#pragma unroll
                for (int k2 = 0; k2 < 2; ++k2) {
#pragma unroll
                    for (int r = 0; r < 16; ++r) Sx[k2][r] = 0.f;
#pragma unroll
                    for (int s = 0; s < 4; ++s) { const int col16 = s * 2 + hh; const int key = k2 * 32 + ql;
                        const bf16x8 kf = *(const LAS bf16x8*)(lds + KS + buf * 8192 + key * 128 + ((col16 ^ ((key >> 1) & 7)) * 16));
                        const int qc16 = m * 8 + s * 2 + hh; const bf16x8 qf = *(const LAS bf16x8*)(lds + QS + qrow * 256 + ((qc16 ^ (qrow & 15)) * 16));
                        Sx[k2] = __builtin_amdgcn_mfma_f32_32x32x16_bf16(kf, qf, Sx[k2], 0, 0, 0); }
                    asm volatile("" ::: "memory"); }
                float mt = -1e30f;
#pragma unroll
                for (int k2 = 0; k2 < 2; ++k2)
#pragma unroll
                    for (int r = 0; r < 16; ++r) { const float dd = dbase + (float)(k2 * 32 + (r & 3) + 8 * (r >> 2));
                        const float tv = Sx[k2][r] - slope2 * fabsf(dd); Sx[k2][r] = tv; mt = fmaxf(mt, tv); }
                mt = fmaxf(mt, __shfl_xor(mt, 32));
                const float mnew = fmaxf(mrun, mt), alpha = __builtin_amdgcn_exp2f(mrun - mnew);
                float ls = 0.f;
#pragma unroll
                for (int k2 = 0; k2 < 2; ++k2)
#pragma unroll
                    for (int r = 0; r < 16; ++r) { const float pv = __builtin_amdgcn_exp2f(Sx[k2][r] - mnew); Sx[k2][r] = pv; ls += pv; }
                lrun = lrun * alpha + ls; mrun = mnew;
                bf16x8 Pp[4];
#pragma unroll
                for (int ks = 0; ks < 4; ++ks) { const int k2 = ks >> 1, r0 = (ks & 1) * 8; bf16x8 pf;
#pragma unroll
                    for (int j = 0; j < 4; ++j) { const unsigned w2 = pg8::cvt_pk_bf16(Sx[k2][r0 + 2 * j], Sx[k2][r0 + 2 * j + 1]); pf[2 * j] = (short)(w2 & 0xFFFFu); pf[2 * j + 1] = (short)(w2 >> 16); }
                    Pp[ks] = pf; }
#pragma unroll
                for (int dt = 0; dt < 4; ++dt)
#pragma unroll
                    for (int r = 0; r < 16; ++r) O[dt][r] *= alpha;
#pragma unroll
                for (int dt = 0; dt < 4; ++dt) {
#pragma unroll
                    for (int ks = 0; ks < 4; ++ks) { const int dv = dt * 32 + ql;
                        const bf16x4 v1 = *(const LAS bf16x4*)(lds + VS + buf * 16384 + (4 * ks + hh) * 1024 + dv * 8);
                        const bf16x4 v2 = *(const LAS bf16x4*)(lds + VS + buf * 16384 + (4 * ks + 2 + hh) * 1024 + dv * 8);
                        const bf16x8 vf = (bf16x8){v1[0], v1[1], v1[2], v1[3], v2[0], v2[1], v2[2], v2[3]};
                        O[dt] = __builtin_amdgcn_mfma_f32_32x32x16_bf16(vf, Pp[ks], O[dt], 0, 0, 0); }
                    asm volatile("" ::: "memory"); }
                asm volatile("s_waitcnt vmcnt(0)" ::: "memory");
                __syncthreads();
            }
#undef AT_STAGE
            const float lt = lrun + __shfl_xor(lrun, 32);
            if (m == 0) { const float i0 = 1.f / lt;
#pragma unroll
                for (int dt = 0; dt < 4; ++dt)
#pragma unroll
                    for (int j = 0; j < 8; ++j) osave[dt][j] = pk2(O[dt][2 * j] * i0, O[dt][2 * j + 1] * i0);
            } else {
                const float i1 = lam / lt;
                float ss = 0.f;
#pragma unroll
                for (int dt = 0; dt < 4; ++dt)
#pragma unroll
                    for (int j = 0; j < 8; ++j) { const float oa = bflo(osave[dt][j]) - O[dt][2 * j] * i1, ob = bfhi(osave[dt][j]) - O[dt][2 * j + 1] * i1; O[dt][2 * j] = oa; O[dt][2 * j + 1] = ob; ss += oa * oa + ob * ob; }
                ss += __shfl_xor(ss, 32);
                const float rstd = rsqrtf(ss * (1.f / 128.f) + 1e-5f) * (1.f - lam_init);
                bf16_t* orow = ycat + (tok0 + qrow) * 1024 + 512 + h * 128;
#pragma unroll
                for (int dt = 0; dt < 4; ++dt)
#pragma unroll
                    for (int gq = 0; gq < 4; ++gq) { const int dv = dt * 32 + 8 * gq + 4 * hh; const float4 sw = *(const float4*)(F.in[I_DF_SUBLN] + dv);
                        u32x2 pk; pk.x = pk2(O[dt][4 * gq] * rstd * sw.x, O[dt][4 * gq + 1] * rstd * sw.y); pk.y = pk2(O[dt][4 * gq + 2] * rstd * sw.z, O[dt][4 * gq + 3] * rstd * sw.w);
                        *(u32x2*)(orow + dv) = pk; }
            }
        }
        __syncthreads();
    }
}
enum { PH_PRO = 0, PH_NORM0, PH_IN0, PH_DNPREP, PH_DNAB, PH_DNC, PH_SCAN0, PH_POST0, PH_GLU, PH_OUT0, PH_MID0, PH_TOPK0, PH_MOE1_0, PH_MOE2_0, PH_COMB0,
       PH_IN1, PH_RWPREP, PH_LORA, PH_SCAN1, PH_RWPOST, PH_OUT1, PH_MID1, PH_TOPK1, PH_MOE1_1, PH_MOE2_1, PH_COMB1, N_PHASES };
#ifndef DBL
#define DBL -1
#endif
#define REP(k) for (int rep_ = 0; rep_ < ((DBL) == (k) ? 2 : 1); ++rep_)
__global__ void __launch_bounds__(NTHR, 2) fwd(Args args) {
    extern __shared__ __attribute__((aligned(16))) unsigned char smem[];
    Frame F;
    const int wid_s = __builtin_amdgcn_readfirstlane((int)threadIdx.x >> 6);
    F.smem = smem; F.lds = (LAS unsigned char*)smem; F.wid = wid_s; F.lane = my_lane(); F.tid = wid_s * 64 + F.lane;
    F.bid = blockIdx.x; F.nblk = gridDim.x; F.in = args.in; F.out = args.out; F.ws = args.ws;
#define FRESH() do { int l_ = my_lane(); asm volatile("" : "+v"(l_)); F.lane = l_; F.wid = wid_s; F.tid = wid_s * 64 + l_; \
        unsigned char* w_ = args.ws; asm volatile("" : "+s"(w_)); F.ws = w_; float* o_ = args.out; asm volatile("" : "+s"(o_)); F.out = o_; } while (0)
    volatile LAS unsigned* xbw = (volatile LAS unsigned*)(F.lds + LDS_MAIN);
    if (F.tid < 4) xbw[F.tid] = 0u;
    __syncthreads();
    const int lo = args.ph_lo, hi = args.ph_hi;
    XcdBarrier bar; bar.bar = (unsigned*)(args.ws + OFF_BAR); bar.x = 0; bar.st = xbw;
    if (hi - lo > 1) bar = xcd_barrier_post((unsigned*)(args.ws + OFF_BAR), xbw, F.tid);
#define IN(k) (lo <= (k) && (k) < hi)
#define SEAM(k) do { if (IN(k) && IN((k) + 1)) { FRESH(); xcd_barrier(bar, F.tid); } } while (0)
    const int G = F.nblk, c = F.bid;

    if (IN(PH_PRO)) { FRESH(); REP(0) { phase_mod(F); __syncthreads(); phase_convert(F); __syncthreads(); } } SEAM(PH_PRO);
    if (IN(PH_NORM0)) { FRESH(); phase_norm0(F); } SEAM(PH_NORM0);
    if (IN(PH_IN0)) { FRESH();
        pg8::Gemm g{WSP(bf16_t, OFF_HB), WSP(bf16_t, OFF_WIN0T), 1024, 1024, 1024, nullptr}; pg8::StaticOrder S; S.init(T_, 2560, G, c);
        EpiBf16Plain E{WSP(bf16_t, OFF_P0), 2560, 2560};
        pg8::gemm_phase<EpiBf16Plain, pg8::StaticOrder, false>(F.lds, g, S, E, F.tid);
    } SEAM(PH_IN0);
    if (IN(PH_DNPREP)) { FRESH(); phase_dnprep(F); } SEAM(PH_DNPREP);
    if (IN(PH_DNAB)) { FRESH(); REP(40) { phase_dn_ab(F); __syncthreads(); } } SEAM(PH_DNAB);
    if (IN(PH_DNC)) { FRESH(); REP(41) { phase_dn_c(F); __syncthreads(); } } SEAM(PH_DNC);
    if (IN(PH_SCAN0)) { FRESH();
#ifdef DN_NAIVE_CHECK
        phase_dn_naive_check(F); __syncthreads();
#endif
#ifdef DN_NANSCAN
        phase_dn_nanscan(F); __syncthreads(); FRESH(); xcd_barrier(bar, F.tid);
#endif
#ifdef BISECT_OLD_FIRST
        phase_dnscan(F); __syncthreads(); FRESH(); xcd_barrier(bar, F.tid);
#endif
        REP(42) { CarryBufs<4> cb{WSP(u32x4, OFF_DN_PHI), WSP(u32x4, OFF_DN_C), WSP(bf16_t, OFF_DN_QE), WSP(u32x4, OFF_DN_YI), WSP(float, OFF_DNO), 4, 512};
          phase_carry<4>(F, cb, 128, F.bid, F.nblk); __syncthreads();
#ifdef DN_CHECK2
          FRESH(); xcd_barrier(bar, F.tid); if (F.bid == 0 && F.tid == 0) ((unsigned*)(F.ws + OFF_BAR))[4002] = 1u; FRESH(); xcd_barrier(bar, F.tid);
          phase_dn_ab(F); FRESH(); xcd_barrier(bar, F.tid); phase_dn_c(F); FRESH(); xcd_barrier(bar, F.tid); phase_carry<4>(F, cb, 128, F.bid, F.nblk); __syncthreads();
#endif
          }
#ifdef BISECT_OLD_DN
        phase_dnscan(F); __syncthreads();
#endif
        REP(43) { phase_s5scan(F); __syncthreads(); }
    } SEAM(PH_SCAN0);
#ifdef PROBE_MIN
    {
        FRESH(); const float* fw = (const float*)(F.ws + OFF_BAR); const float r1 = sqrtf(fw[4004] / fmaxf(fw[4005], 1e-30f)), r2 = sqrtf(fw[4006] / fmaxf(fw[4007], 1e-30f));
        const float d1 = (r1 == r1) ? fminf(8.f, floorf(r1 * 50.f)) : 9.f, d2 = (r2 == r2) ? fminf(8.f, floorf(r2 * 50.f)) : 9.f;
        float addv = 100.f * (1.f + 10.f * d1 + d2);
#ifdef DN_NANSCAN
        addv = 100.f * (float)(((const unsigned*)(F.ws + OFF_BAR))[4001] + 1u);
#endif
        for (size_t i = (size_t)F.bid * NTHR + F.tid; i < (size_t)T_ * 1024; i += (size_t)F.nblk * NTHR) F.out[i] = addv;
        return; }
#else
    if (IN(PH_POST0)) { FRESH(); phase_post0(F); } SEAM(PH_POST0);
    if (IN(PH_GLU)) { FRESH();
        pg8::Gemm g{WSP(bf16_t, OFF_YS5), WSP(bf16_t, OFF_WGLUT), 512, 512, 512, nullptr}; pg8::StaticOrder S; S.init(T_, 512, G, c);
        EpiGlu E{WSP(bf16_t, OFF_YS5), F.in[I_S5_GLUB], WSP(bf16_t, OFF_YCAT)};
        pg8::gemm_phase<EpiGlu, pg8::StaticOrder, false>(F.lds, g, S, E, F.tid);
    } SEAM(PH_GLU);
    if (IN(PH_OUT0)) { FRESH();
        pg8::Gemm g{WSP(bf16_t, OFF_YCAT), WSP(bf16_t, OFF_WOUT0T), 1024, 1024, 1024, nullptr}; pg8::StaticOrder S; S.init(T_, 1024, G, c);
        EpiF32 E{WSP(float, OFF_YMIX), 1024};
        pg8::gemm_phase<EpiF32, pg8::StaticOrder, false>(F.lds, g, S, E, F.tid);
    } SEAM(PH_OUT0);
    if (IN(PH_MID0)) { FRESH(); phase_mid(F, 0, F.in[I_X], WSP(float, OFF_XA)); } SEAM(PH_MID0);
    if (IN(PH_TOPK0)) { FRESH(); phase_topk(F); } SEAM(PH_TOPK0);
    if (IN(PH_MOE1_0)) { FRESH();
        pg8::Gemm g{WSP(bf16_t, OFF_HB), (const bf16_t*)(F.ws + OFF_W1T), 1024, 1024, 1024, WSP(int, OFF_ROWTOK)}; pg8::MoeOrder S{176, 22, G, c};
        EpiSwiglu E{WSP(bf16_t, OFF_HBUF)};
        pg8::gemm_phase<EpiSwiglu, pg8::MoeOrder, true>(F.lds, g, S, E, F.tid);
    } SEAM(PH_MOE1_0);
    if (IN(PH_MOE2_0)) { FRESH();
        pg8::Gemm g{WSP(bf16_t, OFF_HBUF), (const bf16_t*)(F.ws + OFF_W2T), F_, F_, F_, nullptr}; pg8::MoeOrder S{32, 4, G, c};
        EpiDown E{WSP(bf16_t, OFF_YBUF), WSP(float, OFF_GATEV)};
        pg8::gemm_phase<EpiDown, pg8::MoeOrder, false>(F.lds, g, S, E, F.tid);
    } SEAM(PH_MOE2_0);
    if (IN(PH_COMB0)) { FRESH(); phase_combine(F, 0, WSP(float, OFF_XA), WSP(float, OFF_XB), true); } SEAM(PH_COMB0);
    if (IN(PH_IN1)) { FRESH();
        { pg8::Gemm g{WSP(bf16_t, OFF_HB), WSP(bf16_t, OFF_WIN1T), 1024, 1024, 1024, nullptr}; pg8::StaticOrder S; S.init(T_, 3072, G, c);
          EpiBf16Plain E{WSP(bf16_t, OFF_P1), 3072, 2944};
          pg8::gemm_phase<EpiBf16Plain, pg8::StaticOrder, false>(F.lds, g, S, E, F.tid); }
        { pg8::Gemm g{WSP(bf16_t, OFF_WVT), WSP(bf16_t, OFF_HB), 1024, 1024, 1024, nullptr}; pg8::StaticOrder S; S.init(512, T_, G, c);
          EpiVimg E{WSP(bf16_t, OFF_VIMG)};
          pg8::gemm_phase<EpiVimg, pg8::StaticOrder, false>(F.lds, g, S, E, F.tid); }
    } SEAM(PH_IN1);
    if (IN(PH_RWPREP)) { FRESH(); phase_rwprep(F); } SEAM(PH_RWPREP);
    if (IN(PH_LORA)) { FRESH();
        pg8::Gemm g{WSP(bf16_t, OFF_LORAIN), WSP(bf16_t, OFF_WLORAT), 384, 384, 384, nullptr}; pg8::StaticOrder S; S.init(T_, 2560, G, c);
        EpiLora E{WSP(float, OFF_RWDEC), WSP(float, OFF_RWA), WSP(float, OFF_RWG), F.in[I_RW_W0], F.in[I_RW_A0]};
        pg8::gemm_phase<EpiLora, pg8::StaticOrder, false>(F.lds, g, S, E, F.tid);
    } SEAM(PH_LORA);
    if (IN(PH_SCAN1)) { FRESH(); REP(160) { phase_rwscan(F); __syncthreads(); } REP(161) { phase_attn(F); __syncthreads(); } } SEAM(PH_SCAN1);
    if (IN(PH_RWPOST)) { FRESH(); phase_rwpost(F); } SEAM(PH_RWPOST);
    if (IN(PH_OUT1)) { FRESH();
        pg8::Gemm g{WSP(bf16_t, OFF_YCAT), WSP(bf16_t, OFF_WOUT1T), 1024, 1024, 1024, nullptr}; pg8::StaticOrder S; S.init(T_, 1024, G, c);
        EpiF32 E{WSP(float, OFF_YMIX), 1024};
        pg8::gemm_phase<EpiF32, pg8::StaticOrder, false>(F.lds, g, S, E, F.tid);
    } SEAM(PH_OUT1);
    if (IN(PH_MID1)) { FRESH(); phase_mid(F, 1, WSP(float, OFF_XB), WSP(float, OFF_XA)); } SEAM(PH_MID1);
    if (IN(PH_TOPK1)) { FRESH(); phase_topk(F); } SEAM(PH_TOPK1);
    if (IN(PH_MOE1_1)) { FRESH();
        pg8::Gemm g{WSP(bf16_t, OFF_HB), (const bf16_t*)(F.ws + OFF_W1T + W1T_LAYER), 1024, 1024, 1024, WSP(int, OFF_ROWTOK)}; pg8::MoeOrder S{176, 22, G, c};
        EpiSwiglu E{WSP(bf16_t, OFF_HBUF)};
        pg8::gemm_phase<EpiSwiglu, pg8::MoeOrder, true>(F.lds, g, S, E, F.tid);
    } SEAM(PH_MOE1_1);
    if (IN(PH_MOE2_1)) { FRESH();
        pg8::Gemm g{WSP(bf16_t, OFF_HBUF), (const bf16_t*)(F.ws + OFF_W2T + W2T_LAYER), F_, F_, F_, nullptr}; pg8::MoeOrder S{32, 4, G, c};
        EpiDown E{WSP(bf16_t, OFF_YBUF), WSP(float, OFF_GATEV)};
        pg8::gemm_phase<EpiDown, pg8::MoeOrder, false>(F.lds, g, S, E, F.tid);
    } SEAM(PH_MOE2_1);
    if (IN(PH_COMB1)) { FRESH(); phase_combine(F, 1, WSP(float, OFF_XA), F.out, false); }
#endif
#undef IN
#undef SEAM
#undef FRESH
}

#ifndef ONE_LAUNCH
#define ONE_LAUNCH 1
#endif
extern "C" void kernel_launch(void* const* d_in, const int* in_sizes, int n_in, void* d_out, int out_size, void* d_ws, size_t ws_size, hipStream_t stream) {
    static int grid = 0;
    if (grid == 0) {
        int dev = 0, cus = 0, per_cu = 0;
        if (n_in != 43 || ws_size < WS_NEED) { fprintf(stderr, "kernel_launch: unexpected inputs (%d) or workspace (%zu < %zu)\n", n_in, ws_size, (size_t)WS_NEED); grid = -1; return; }
        if (hipGetDevice(&dev) != hipSuccess || hipDeviceGetAttribute(&cus, hipDeviceAttributeMultiprocessorCount, dev) != hipSuccess) { grid = -1; return; }
        if (hipFuncSetAttribute((const void*)fwd, hipFuncAttributeMaxDynamicSharedMemorySize, LDS_BYTES) != hipSuccess) { fprintf(stderr, "kernel_launch: hipFuncSetAttribute failed\n"); grid = -1; return; }
        if (hipOccupancyMaxActiveBlocksPerMultiprocessor(&per_cu, (const void*)fwd, NTHR, LDS_BYTES) != hipSuccess || per_cu < 1) { fprintf(stderr, "kernel_launch: occupancy query says %d\n", per_cu); (void)hipGetLastError(); }
        grid = cus;
    }
    if (grid < 0) return;
    (void)hipMemsetAsync((char*)d_ws + OFF_BAR, 0, 16384, stream);
    Args a{};
    for (int i = 0; i < 43; ++i) a.in[i] = (const float*)d_in[i];
    a.out = (float*)d_out; a.ws = (unsigned char*)d_ws;
#if ONE_LAUNCH
    a.ph_lo = 0; a.ph_hi = N_PHASES;
    hipLaunchKernelGGL(fwd, dim3(grid), dim3(NTHR), LDS_BYTES, stream, a);
#else
    for (int ph = 0; ph < N_PHASES; ++ph) { a.ph_lo = ph; a.ph_hi = ph + 1; hipLaunchKernelGGL(fwd, dim3(grid), dim3(NTHR), LDS_BYTES, stream, a); }
#endif
}
```

```cpp
#include <hip/hip_runtime.h>
#include <stdint.h>
#include <stdio.h>

#define LAS __attribute__((address_space(3)))
typedef unsigned short bf16_t;
typedef short bf16x8 __attribute__((ext_vector_type(8)));
typedef short bf16x4 __attribute__((ext_vector_type(4)));
typedef float f32x4 __attribute__((ext_vector_type(4)));
typedef float f32x16 __attribute__((ext_vector_type(16)));
typedef unsigned u32x4 __attribute__((ext_vector_type(4)));
typedef unsigned u32x2 __attribute__((ext_vector_type(2)));

constexpr int T_ = 16384, D_ = 1024, B_ = 4, S_ = 4096, E_ = 16, CAP_ = 512, F_ = 2816;
constexpr int NTHR = 512;
constexpr int LDS_MAIN = 155648;
constexpr int LDS_BYTES = LDS_MAIN + 64;

constexpr size_t al256(size_t x) { return (x + 255) & ~(size_t)255; }
constexpr size_t OFF_BAR    = 0;
constexpr size_t OFF_MOD    = 16384;
constexpr size_t OFF_WIN0T  = OFF_MOD    + al256((size_t)2 * 4 * 6144 * 4);
constexpr size_t OFF_WGLUT  = OFF_WIN0T  + (size_t)2560 * 1024 * 2;
constexpr size_t OFF_WOUT0T = OFF_WGLUT  + (size_t)512 * 512 * 2;
constexpr size_t OFF_WIN1T  = OFF_WOUT0T + (size_t)1024 * 1024 * 2;
constexpr size_t OFF_WVT    = OFF_WIN1T  + (size_t)3072 * 1024 * 2;
constexpr size_t OFF_WOUT1T = OFF_WVT    + (size_t)512 * 1024 * 2;
constexpr size_t OFF_WLORAT = OFF_WOUT1T + (size_t)1024 * 1024 * 2;
constexpr size_t OFF_W1T    = OFF_WLORAT + (size_t)2560 * 384 * 2;
constexpr size_t W1T_LAYER  = (size_t)16 * 5632 * 1024 * 2;
constexpr size_t OFF_W2T    = OFF_W1T    + 2 * W1T_LAYER;
constexpr size_t W2T_LAYER  = (size_t)16 * 1024 * 2816 * 2;
constexpr size_t OFF_HB     = OFF_W2T    + 2 * W2T_LAYER;
constexpr size_t OFF_XA     = OFF_HB     + (size_t)T_ * 1024 * 2;
constexpr size_t OFF_XB     = OFF_XA     + (size_t)T_ * 1024 * 4;
constexpr size_t OFF_YMIX   = OFF_XB     + (size_t)T_ * 1024 * 4;
constexpr size_t OFF_YCAT   = OFF_YMIX   + (size_t)T_ * 1024 * 4;
constexpr size_t OFF_PROBS  = OFF_YCAT   + (size_t)T_ * 1024 * 2;
constexpr size_t OFF_ROWTOK = OFF_PROBS  + (size_t)4 * 16 * 4096 * 4;
constexpr size_t OFF_GATEV  = OFF_ROWTOK + (size_t)32768 * 4;
constexpr size_t OFF_SLOT   = OFF_GATEV  + (size_t)32768 * 4;
constexpr size_t OFF_SCR    = OFF_SLOT   + (size_t)T_ * 16 * 4;
constexpr size_t OFF_P0     = OFF_SCR;
constexpr size_t OFF_GB0    = OFF_P0     + (size_t)T_ * 2560 * 2;
constexpr size_t OFF_QKVN   = OFF_GB0    + (size_t)T_ * 16 * 4;
constexpr size_t OFF_DNO    = OFF_QKVN   + (size_t)T_ * 1536 * 4;
constexpr size_t OFF_S5Y    = OFF_DNO    + (size_t)2 * T_ * 512 * 4;
constexpr size_t OFF_YS5    = OFF_S5Y    + (size_t)2 * T_ * 512 * 4;
constexpr size_t OFF_DN_GCS = OFF_YS5    + (size_t)T_ * 512 * 2;
constexpr size_t OFF_DN_AM  = OFF_DN_GCS + (size_t)2048 * 64 * 4;
constexpr size_t OFF_DN_TM  = OFF_DN_AM  + (size_t)2048 * 4096 * 2;
constexpr size_t OFF_DN_QE  = OFF_DN_TM  + (size_t)2048 * 4096 * 2;
constexpr size_t OFF_DN_YI  = OFF_DN_QE  + (size_t)2048 * 8192 * 2;
constexpr size_t OFF_DN_PHI = OFF_DN_YI  + (size_t)2048 * 16384;
constexpr size_t OFF_DN_C   = OFF_DN_PHI + (size_t)2048 * 32768;
constexpr size_t END_L0     = OFF_DN_C   + (size_t)2048 * 32768;
constexpr size_t OFF_HBUF   = OFF_SCR;
constexpr size_t OFF_YBUF   = OFF_HBUF   + (size_t)32768 * 2816 * 2;
constexpr size_t END_MOE    = OFF_YBUF   + (size_t)32768 * 1024 * 2;
constexpr size_t OFF_P1     = OFF_SCR;
constexpr size_t OFF_VIMG   = OFF_P1     + (size_t)T_ * 3072 * 2;
constexpr size_t OFF_RWR    = OFF_VIMG   + (size_t)512 * T_ * 2;
constexpr size_t OFF_RWK    = OFF_RWR    + (size_t)T_ * 512 * 2;
constexpr size_t OFF_RWV    = OFF_RWK    + (size_t)T_ * 512 * 2;
constexpr size_t OFF_RWKK   = OFF_RWV    + (size_t)T_ * 512 * 2;
constexpr size_t OFF_LORAIN = OFF_RWKK   + (size_t)T_ * 512 * 2;
constexpr size_t OFF_RWDEC  = OFF_LORAIN + (size_t)T_ * 384 * 2;
constexpr size_t OFF_RWA    = OFF_RWDEC  + (size_t)2 * T_ * 512 * 4;
constexpr size_t OFF_RWG    = OFF_RWA    + (size_t)2 * T_ * 512 * 2;
constexpr size_t OFF_RW_MAB = OFF_RWG    + (size_t)T_ * 512 * 2;
constexpr size_t OFF_RW_QE  = OFF_RW_MAB;
constexpr size_t OFF_RW_YI  = OFF_RW_MAB + 8192;
constexpr size_t OFF_RW_X1T = OFF_RW_MAB + (size_t)4096 * 16384;
constexpr size_t OFF_RW_GRB = OFF_RW_X1T + (size_t)4096 * 8192;
constexpr size_t OFF_RWY    = OFF_RW_X1T;
constexpr size_t OFF_RW_GRK = OFF_RW_GRB + (size_t)4096 * 8192;
constexpr size_t OFF_RW_TM  = OFF_RW_GRK + (size_t)4096 * 8192;
constexpr size_t OFF_RW_PL  = OFF_RW_TM  + (size_t)4096 * 8192;
constexpr size_t OFF_RW_PHI = OFF_RW_PL  + (size_t)4096 * 256;
constexpr size_t OFF_RW_C   = OFF_RW_PHI + (size_t)4096 * 8192;
constexpr size_t END_L1     = OFF_RW_C   + (size_t)4096 * 8192;
static_assert((size_t)2 * T_ * 512 * 4 == (size_t)2 * 4096 * 8192, "rwy aliases X1T | GRB");
constexpr size_t WS_NEED    = END_L1 > END_L0 ? (END_L1 > END_MOE ? END_L1 : END_MOE) : (END_L0 > END_MOE ? END_L0 : END_MOE);
static_assert(WS_NEED < (size_t)1470000000, "workspace budget");

struct Args { const float* in[43]; float* out; unsigned char* ws; int ph_lo, ph_hi; };

enum { I_X = 0, I_C, I_ADA_W, I_ADA_B, I_NMIX_PRE, I_NMIX_POST, I_NFFN_PRE, I_NFFN_POST, I_ROUTER, I_WGATE, I_WUP, I_WDOWN,
       I_AB_IN, I_AB_OUT, I_DN_CONV, I_DN_ALOG, I_DN_DTB, I_DN_NORM, I_S5_ARE, I_S5_AIM, I_S5_LDT, I_S5_BRE, I_S5_BIM, I_S5_CRE, I_S5_CIM,
       I_S5_D, I_S5_GLUW, I_S5_GLUB, I_CD_IN, I_CD_OUT, I_RW_MU, I_RW_W0, I_RW_W2, I_RW_A0, I_RW_A2, I_RW_G2, I_RW_KK, I_RW_KA, I_RW_RK,
       I_RW_LNW, I_RW_LNB, I_DF_LAM, I_DF_SUBLN };

__device__ __forceinline__ bf16_t f2bf(float f) { unsigned u = __float_as_uint(f); u += 0x7FFFu + ((u >> 16) & 1u); return (bf16_t)(u >> 16); }
__device__ __forceinline__ float bf2f(bf16_t b) { return __uint_as_float(((unsigned)b) << 16); }
typedef __bf16 bf16v2_t __attribute__((ext_vector_type(2)));
typedef float f32x2_t __attribute__((ext_vector_type(2)));
#ifdef SOFT_CVT
__device__ __forceinline__ unsigned pk2(float lo, float hi) { return (unsigned)f2bf(lo) | ((unsigned)f2bf(hi) << 16); }
#else
__device__ __forceinline__ unsigned pk2(float lo, float hi) { const f32x2_t v = {lo, hi}; const bf16v2_t b = __builtin_convertvector(v, bf16v2_t); return __builtin_bit_cast(unsigned, b); }
#endif
__device__ __forceinline__ float bflo(unsigned u) { return __uint_as_float(u << 16); }
__device__ __forceinline__ float bfhi(unsigned u) { return __uint_as_float(u & 0xFFFF0000u); }
__device__ __forceinline__ float wave_sum(float v) {
#pragma unroll
    for (int o = 32; o; o >>= 1) v += __shfl_xor(v, o);
    return v;
}
#ifdef SLOW_SIGMOID
__device__ __forceinline__ float sigmoidf_(float x) { return 1.f / (1.f + __expf(-x)); }
__device__ __forceinline__ float siluf_(float x) { return x / (1.f + __expf(-x)); }
#else
__device__ __forceinline__ float sigmoidf_(float x) { return __builtin_amdgcn_rcpf(1.f + __builtin_amdgcn_exp2f(-1.4426950408889634f * x)); }
__device__ __forceinline__ float siluf_(float x) { return x * sigmoidf_(x); }
#endif
__device__ __forceinline__ float softplusf_(float x) { return fmaxf(x, 0.f) + __logf(1.f + __expf(-fabsf(x))); }
__device__ __forceinline__ float gelu_tanhf_(float x) { const float u = 0.7978845608028654f * (x + 0.044715f * x * x * x); const float t = 2.f / (1.f + __expf(-2.f * u)) - 1.f; return 0.5f * x * (1.f + t); }
template <int CTRL> __device__ __forceinline__ float dppf(float x) { return __int_as_float(__builtin_amdgcn_update_dpp(0, __float_as_int(x), CTRL, 0xF, 0xF, true)); }
__device__ __forceinline__ float row16_sum(float x) { x += dppf<0x128>(x); x += dppf<0x124>(x); x += dppf<0x122>(x); x += dppf<0x121>(x); return x; }

#define XB_TMO      128
#define XB_XCNT(j)  (256  + 64 * (j))
#define XB_XSUB(j)  (1280 + 64 * (j))
#define XB_XGEN(j)  (2304 + 64 * (j))
#define XB_TOP      3328
#define XB_TOPGEN   3392
#define XCD_BAR_WORDS 3456
#define XB_SPIN_CAP (1u << 27)
__device__ __forceinline__ unsigned xb_ld(unsigned* p)              { return __hip_atomic_load(p, __ATOMIC_RELAXED, __HIP_MEMORY_SCOPE_AGENT); }
__device__ __forceinline__ unsigned xb_add(unsigned* p, unsigned v) { return __hip_atomic_fetch_add(p, v, __ATOMIC_RELAXED, __HIP_MEMORY_SCOPE_AGENT); }
__device__ __forceinline__ unsigned xb_xcc_id() { return (unsigned)__builtin_amdgcn_s_getreg((3 << 11) | 20) & 0xFu; }
#define XB_SPIN(cond, bar) do { unsigned _sp = 0; while (cond) { __builtin_amdgcn_s_sleep(1); \
    if ((++_sp & 255u) == 0u) { if (xb_ld(&(bar)[XB_TMO])) break; if (_sp > XB_SPIN_CAP) { atomicAdd(&(bar)[XB_TMO], 1u); break; } } } } while (0)
struct XcdBarrier { unsigned* bar; unsigned x; volatile LAS unsigned* st; };
__device__ __forceinline__ int my_lane() { int l; asm volatile("v_mbcnt_lo_u32_b32 %0, -1, 0\n\tv_mbcnt_hi_u32_b32 %0, -1, %0" : "=v"(l)); return l; }
__device__ __forceinline__ XcdBarrier xcd_barrier_post(unsigned* bar, volatile LAS unsigned* st, int tid) {
    XcdBarrier b; b.bar = bar; b.x = xb_xcc_id(); b.st = st;
    if (tid == 0) (void)xb_add(&bar[XB_XCNT(b.x)], 1u);
    return b;
}
__device__ __forceinline__ void xcd_barrier_complete(unsigned* bar, unsigned x, unsigned& nloc, unsigned& nx) {
    const unsigned G = gridDim.x * gridDim.y * gridDim.z;
    unsigned sum, cnt, mine, sp = 0u;
    for (;;) {
        sum = 0u; cnt = 0u; mine = 0u;
#pragma unroll
        for (unsigned j = 0; j < 16; ++j) { const unsigned c = xb_ld(&bar[XB_XCNT(j)]); sum += c; cnt += (c > 0u) ? 1u : 0u; mine = (j == x) ? c : mine; }
        if (sum == G) break;
        __builtin_amdgcn_s_sleep(1);
        if ((++sp & 255u) == 0u) { if (xb_ld(&bar[XB_TMO])) break; if (sp > XB_SPIN_CAP) { atomicAdd(&bar[XB_TMO], 1u); break; } }
    }
    nloc = mine > 0u ? mine : 1u; nx = cnt > 0u ? cnt : 1u;
}
__device__ __forceinline__ void xcd_barrier(const XcdBarrier& b, int tid) {
    asm volatile("s_waitcnt vmcnt(0)" ::: "memory");
    __syncthreads();
    if (tid == 0) {
        unsigned* bar = b.bar;
        __builtin_amdgcn_s_waitcnt(0);
        unsigned nloc = b.st[0], nx = b.st[1];
        if (nloc == 0u) { xcd_barrier_complete(bar, b.x, nloc, nx); b.st[0] = nloc; b.st[1] = nx; }
        const unsigned old = xb_add(&bar[XB_XSUB(b.x)], 1u);
        const unsigned gen = old / nloc;
        if (old + 1u == (gen + 1u) * nloc) {
            __builtin_amdgcn_fence(__ATOMIC_RELEASE, "agent");
            asm volatile("s_waitcnt vmcnt(0)" ::: "memory");
            const unsigned og = xb_add(&bar[XB_TOP], 1u);
            const unsigned tg = og / nx;
            if (og + 1u == (tg + 1u) * nx) xb_add(&bar[XB_TOPGEN], 1u);
            else XB_SPIN(xb_ld(&bar[XB_TOPGEN]) == tg, bar);
            __builtin_amdgcn_fence(__ATOMIC_ACQUIRE, "agent");
            xb_add(&bar[XB_XGEN(b.x)], 1u);
            asm volatile("s_waitcnt vmcnt(0)" ::: "memory");
        } else {
            XB_SPIN(xb_ld(&bar[XB_XGEN(b.x)]) == gen, bar);
            __builtin_amdgcn_fence(__ATOMIC_ACQUIRE, "agent");
            asm volatile("s_waitcnt vmcnt(0)" ::: "memory");
        }
    }
    __syncthreads();
}

namespace pg8 {
constexpr int BM = 256, BK = 64, HALF = 128, HTB = HALF * BK * 2, STAGE_BYTES = 8 * HTB, NXCD = 8, WGM = 8;
__host__ __device__ __forceinline__ int lds_byte(int r, int c) { const int st = (r >> 4) * 2 + (c >> 5), rr = r & 15, cc = c & 31, ob = rr * 64 + cc * 2; return st * 1024 + (ob ^ (((ob >> 9) & 1) << 5)); }
__host__ __device__ __forceinline__ void stage_rc(int b, int& R, int& C) { const int st = b / 1024, sb = b % 1024, swz = sb ^ (((sb >> 9) & 1) << 5); R = (st >> 1) * 16 + swz / 64; C = (st & 1) * 32 + (swz % 64) / 2; }
__host__ __device__ __forceinline__ int perm32(int rho) { const int n = rho >> 4, i = rho & 15; return 8 * (i >> 2) + 4 * n + (i & 3); }
struct Unit { int pm, pn; };
struct Gemm { const bf16_t* A; const bf16_t* Bt; int lda, ldb, K; const int* rowidx; size_t kstepB = 0, tstepB = 0; };

struct StaticOrder {
    int nM, nN, nwg, G, c;
    __device__ void init(int M, int N, int G_, int c_) { nM = M / BM; nN = N / BM; nwg = nM * nN; G = G_; c = c_; }
    __device__ bool next(int i, Unit& u) const {
        const long L = (long)i * G + c; if (L >= nwg) return false;
        int wgid = (int)L; { const int q = nwg / NXCD, r = nwg % NXCD, xcd = wgid % NXCD, off = wgid / NXCD; wgid = (xcd < r ? xcd * (q + 1) : r * (q + 1) + (xcd - r) * q) + off; }
        const int nig = WGM * nN, gid = wgid / nig, fm = gid * WGM, gsz = (nM - fm) < WGM ? (nM - fm) : WGM;
        u.pm = fm + ((wgid % nig) % gsz); u.pn = (wgid % nig) / gsz; return true;
    }
};
struct MoeOrder {
    int per_e, npn, G, c;
    __device__ bool next(int i, Unit& u) const {
        const int nwg = 16 * per_e; const long L = (long)i * G + c; if (L >= nwg) return false;
        int wgid = (int)L; { const int q = nwg / NXCD, xcd = wgid % NXCD, off = wgid / NXCD; wgid = xcd * q + off; }
        const int e = wgid / per_e, r = wgid % per_e; u.pm = e * 8 + (r & 7); u.pn = e * npn + (r >> 3); return true;
    }
};

__device__ __forceinline__ unsigned cvt_pk_bf16(float lo, float hi) { const f32x2_t v = {lo, hi}; const bf16v2_t b = __builtin_convertvector(v, bf16v2_t); return __builtin_bit_cast(unsigned, b); }

template <class Epi, class Sched, bool GATHER>
__device__ __forceinline__ void gemm_phase(LAS unsigned char* lds, const Gemm g, const Sched& S, const Epi& E, int tid_) {
    const int tid = tid_, wid = __builtin_amdgcn_readfirstlane(tid >> 6), lane = tid & 63, wr = wid >> 2, wc = wid & 3, fr = lane & 15, fq = lane >> 4;
    const int K = g.K, nt = K / BK;
    int Rr[2], Cc[2]; unsigned voffA[2], voffB[2];
#pragma unroll
    for (int i = 0; i < 2; ++i) { int R, C; stage_rc(tid * 16 + i * 8192, R, C); const int Rb = Epi::PERM ? ((R & ~31) + perm32(R & 31)) : R;
        Rr[i] = R; Cc[i] = C; voffA[i] = (unsigned)(R * g.lda + C) * 2u; voffB[i] = (unsigned)(Rb * g.ldb + C) * 2u; }
    const size_t kstep = (size_t)(BK * 2);
    const size_t hstepA = (size_t)HALF * g.lda * 2, tstepA = 2 * hstepA;
    const size_t hstepB = (size_t)HALF * g.ldb * 2, tstepB = g.tstepB ? g.tstepB : 2 * hstepB, kstepB = g.kstepB ? g.kstepB : kstep;
    const unsigned ldsw = (unsigned)wid * 1024u;
    const int aoff = lds_byte(wr * 64 + fr, fq * 8), boff = lds_byte(wc * 32 + fr, fq * 8);
    const unsigned lda2 = (unsigned)g.lda * 2u;
#define PG8_AOFF(vo, pm_) do { _Pragma("unroll") for (int _h = 0; _h < 2; ++_h) _Pragma("unroll") for (int _i = 0; _i < 2; ++_i) { const int _row = (pm_) * 256 + _h * 128 + Rr[_i]; \
        (vo)[_h][_i] = (unsigned)g.rowidx[_row] * lda2 + (unsigned)Cc[_i] * 2u; } } while (0)
#define PG8_SA(b, h) (((b) * 2 + (h)) * HTB)
#define PG8_SB(b, h) ((4 + (b) * 2 + (h)) * HTB)
#define PG8_STAGE_B(bufoff, gbase) do { _Pragma("unroll") for (int _i = 0; _i < 2; ++_i) \
        __builtin_amdgcn_global_load_lds((const unsigned*)((const char*)(gbase) + voffB[_i]), (LAS unsigned*)(lds + (bufoff) + ldsw + _i * 8192), 16, 0, 0); } while (0)
#define PG8_STAGE_A(bufoff, uptr, voh, kb) do { _Pragma("unroll") for (int _i = 0; _i < 2; ++_i) { \
        const char* _p = GATHER ? ((const char*)g.A + (size_t)(voh)[_i] + (kb)) : ((const char*)(uptr) + voffA[_i]); \
        __builtin_amdgcn_global_load_lds((const unsigned*)_p, (LAS unsigned*)(lds + (bufoff) + ldsw + _i * 8192), 16, 0, 0); } } while (0)
#define PG8_LDA(dst, b, h) do { _Pragma("unroll") for (int m = 0; m < 4; ++m) _Pragma("unroll") for (int k = 0; k < 2; ++k) dst[m][k] = *(const LAS bf16x8*)(lds + PG8_SA(b, h) + aoff + m * 2048 + k * 1024); } while (0)
#define PG8_LDB(dst, b, h) do { _Pragma("unroll") for (int n = 0; n < 2; ++n) _Pragma("unroll") for (int k = 0; k < 2; ++k) dst[n][k] = *(const LAS bf16x8*)(lds + PG8_SB(b, h) + boff + n * 2048 + k * 1024); } while (0)
#define PG8_MMA(ai, bj, At, Bt) do { __builtin_amdgcn_s_setprio(1); _Pragma("unroll") for (int m = 0; m < 4; ++m) _Pragma("unroll") for (int n = 0; n < 2; ++n) _Pragma("unroll") for (int k = 0; k < 2; ++k) \
        acc[ai][bj][m][n] = __builtin_amdgcn_mfma_f32_16x16x32_bf16(Bt[n][k], At[m][k], acc[ai][bj][m][n], 0, 0, 0); __builtin_amdgcn_s_setprio(0); } while (0)
#define PG8_WAIT_V(n) asm volatile("s_waitcnt vmcnt(" #n ")" ::: "memory")
#define PG8_WAIT_L(n) asm volatile("s_waitcnt lgkmcnt(" #n ")" ::: "memory")
#define PG8_BAR __builtin_amdgcn_s_barrier()
#define PG8_SCHED __builtin_amdgcn_sched_barrier(0)
    Unit cur, nxt; int ui = 0;
    if (!S.next(0, cur)) return;
    f32x4 acc[2][2][4][2];
#pragma unroll
    for (int a = 0; a < 2; ++a)
#pragma unroll
        for (int b = 0; b < 2; ++b)
#pragma unroll
            for (int m = 0; m < 4; ++m)
#pragma unroll
                for (int n = 0; n < 2; ++n) acc[a][b][m][n] = (f32x4){0.f, 0.f, 0.f, 0.f};
    bf16x8 At[4][2], B0[2][2], B1[2][2];
    unsigned vcur[2][2], vnxt[2][2];
    if (GATHER) { PG8_AOFF(vcur, cur.pm); }
    else {
#pragma unroll
        for (int h = 0; h < 2; ++h)
#pragma unroll
            for (int i = 0; i < 2; ++i) vcur[h][i] = 0u; }
    const char* cA = (const char*)g.A + (GATHER ? (size_t)0 : (size_t)cur.pm * tstepA);
    const char* cB = (const char*)g.Bt + (size_t)cur.pn * tstepB;
    PG8_STAGE_B(PG8_SB(0, 0), cB); PG8_STAGE_A(PG8_SA(0, 0), cA, vcur[0], 0); PG8_STAGE_B(PG8_SB(0, 1), cB + hstepB); PG8_STAGE_A(PG8_SA(0, 1), cA + hstepA, vcur[1], 0);
    if (wr == 1) PG8_BAR;
    PG8_WAIT_V(4); PG8_BAR;
    PG8_STAGE_B(PG8_SB(1, 0), cB + kstepB); PG8_STAGE_A(PG8_SA(1, 0), cA + kstep, vcur[0], kstep); PG8_STAGE_B(PG8_SB(1, 1), cB + hstepB + kstepB);
    PG8_WAIT_V(6); PG8_BAR;
    for (;;) {
        const bool has_next = S.next(ui + 1, nxt);
        if (GATHER) {
            if (has_next) { PG8_AOFF(vnxt, nxt.pm); }
            else {
#pragma unroll
                for (int h = 0; h < 2; ++h)
#pragma unroll
                    for (int i = 0; i < 2; ++i) vnxt[h][i] = vcur[h][i]; } }
        const char* nA = (has_next && !GATHER) ? (const char*)g.A + (size_t)nxt.pm * tstepA : cA;
        const char* nB = has_next ? (const char*)g.Bt + (size_t)nxt.pn * tstepB : cB;
#pragma nounroll
        for (int t = 0; t < nt; t += 2) {
            const bool last = (t == nt - 2);
            const size_t kb1 = (size_t)(t + 1) * kstep;
            const size_t kb2 = last ? (size_t)0 : (size_t)(t + 2) * kstep, kb3 = kb2 + kstep;
            unsigned va2[2][2];
#pragma unroll
            for (int h = 0; h < 2; ++h)
#pragma unroll
                for (int i = 0; i < 2; ++i) va2[h][i] = (GATHER && last) ? vnxt[h][i] : vcur[h][i];
            const char* a1 = cA + kb1;
            const char* a2 = last ? nA : cA + kb2; const char* a3 = a2 + kstep;
            const char* b2 = last ? nB : cB + (size_t)(t + 2) * kstepB; const char* b3 = b2 + kstepB;
            PG8_LDB(B0, 0, 0); PG8_SCHED; PG8_LDA(At, 0, 0); PG8_STAGE_A(PG8_SA(1, 1), a1 + hstepA, vcur[1], kb1);
            PG8_WAIT_L(8); PG8_BAR; PG8_WAIT_L(0); PG8_MMA(0, 0, At, B0); PG8_BAR; PG8_SCHED;
            PG8_LDB(B1, 0, 1); PG8_STAGE_B(PG8_SB(0, 0), b2);
            PG8_BAR; PG8_WAIT_L(0); PG8_MMA(0, 1, At, B1); PG8_BAR;
            PG8_LDA(At, 0, 1); PG8_STAGE_A(PG8_SA(0, 0), a2, va2[0], kb2);
            PG8_BAR; PG8_WAIT_L(0); PG8_MMA(1, 0, At, B0); PG8_BAR; PG8_SCHED;
            PG8_STAGE_B(PG8_SB(0, 1), b2 + hstepB);
            PG8_WAIT_V(6); PG8_BAR; PG8_MMA(1, 1, At, B1); PG8_BAR;
            PG8_LDB(B0, 1, 0); PG8_SCHED; PG8_LDA(At, 1, 0); PG8_STAGE_A(PG8_SA(0, 1), a2 + hstepA, va2[1], kb2);
            PG8_WAIT_L(8); PG8_BAR; PG8_WAIT_L(0); PG8_MMA(0, 0, At, B0); PG8_BAR; PG8_SCHED;
            PG8_LDB(B1, 1, 1); PG8_STAGE_B(PG8_SB(1, 0), b3);
            PG8_BAR; PG8_WAIT_L(0); PG8_MMA(0, 1, At, B1); PG8_BAR;
            PG8_LDA(At, 1, 1); PG8_STAGE_A(PG8_SA(1, 0), a3, va2[0], kb3);
            PG8_BAR; PG8_WAIT_L(0); PG8_MMA(1, 0, At, B0); PG8_BAR; PG8_SCHED;
            PG8_STAGE_B(PG8_SB(1, 1), b3 + hstepB);
            PG8_WAIT_V(6); PG8_BAR; PG8_MMA(1, 1, At, B1); PG8_BAR;
        }
        { int tz = tid; asm volatile("" : "+v"(tz));
          const int wid2 = __builtin_amdgcn_readfirstlane(tz >> 6), lane2 = tz & 63; E(acc, cur, wid2 >> 2, wid2 & 3, lane2 & 15, lane2 >> 4); }
        if (!has_next) break;
#pragma unroll
        for (int a = 0; a < 2; ++a)
#pragma unroll
            for (int b = 0; b < 2; ++b)
#pragma unroll
                for (int m = 0; m < 4; ++m)
#pragma unroll
                    for (int n = 0; n < 2; ++n) acc[a][b][m][n] = (f32x4){0.f, 0.f, 0.f, 0.f};
        cur = nxt; cA = nA; cB = nB; ++ui;
#pragma unroll
        for (int h = 0; h < 2; ++h)
#pragma unroll
            for (int i = 0; i < 2; ++i) vcur[h][i] = vnxt[h][i];
    }
    PG8_WAIT_V(0);
    if (wr == 0) PG8_BAR;
    PG8_BAR;
#undef PG8_AOFF
#undef PG8_SA
#undef PG8_SB
#undef PG8_STAGE_A
#undef PG8_STAGE_B
#undef PG8_LDA
#undef PG8_LDB
#undef PG8_MMA
#undef PG8_WAIT_V
#undef PG8_WAIT_L
#undef PG8_BAR
#undef PG8_SCHED
}
}
using pg8::Unit;
typedef f32x4 AccT[2][2][4][2];
struct EpiBf16Plain {
    static constexpr bool PERM = true;
    bf16_t* O; int ldc; int ncols;
    __device__ __forceinline__ void operator()(const AccT& acc, const Unit& u, int wr, int wc, int fr, int fq) const {
        const int row0 = u.pm * 256 + wr * 64 + fr, col0 = u.pn * 256 + wc * 32 + 8 * fq;
#pragma unroll
        for (int ai = 0; ai < 2; ++ai)
#pragma unroll
            for (int m = 0; m < 4; ++m) { bf16_t* rowp = O + (size_t)(row0 + ai * 128 + m * 16) * ldc;
#pragma unroll
                for (int bj = 0; bj < 2; ++bj) { const int col = col0 + bj * 128; if (col < ncols) { const f32x4 v0 = acc[ai][bj][m][0], v1 = acc[ai][bj][m][1];
                    u32x4 pk; pk.x = pg8::cvt_pk_bf16(v0[0], v0[1]); pk.y = pg8::cvt_pk_bf16(v0[2], v0[3]); pk.z = pg8::cvt_pk_bf16(v1[0], v1[1]); pk.w = pg8::cvt_pk_bf16(v1[2], v1[3]);
                    *(u32x4*)(rowp + col) = pk; } } }
    }
};
struct EpiF32 {
    static constexpr bool PERM = false;
    float* C; int ldc;
    __device__ __forceinline__ void operator()(const AccT& acc, const Unit& u, int wr, int wc, int fr, int fq) const {
        const int row0 = u.pm * 256 + wr * 64 + fr, col0 = u.pn * 256 + wc * 32 + 4 * fq;
#pragma unroll
        for (int ai = 0; ai < 2; ++ai)
#pragma unroll
            for (int m = 0; m < 4; ++m) { float* rowp = C + (size_t)(row0 + ai * 128 + m * 16) * ldc + col0;
#pragma unroll
                for (int bj = 0; bj < 2; ++bj)
#pragma unroll
                    for (int n = 0; n < 2; ++n) *(f32x4*)(rowp + bj * 128 + n * 16) = acc[ai][bj][m][n]; }
    }
};
struct EpiGlu {
    static constexpr bool PERM = true;
    const bf16_t* ys5; const float* bias; bf16_t* ycat;
    __device__ __forceinline__ void operator()(const AccT& acc, const Unit& u, int wr, int wc, int fr, int fq) const {
        const int row0 = u.pm * 256 + wr * 64 + fr, col0 = u.pn * 256 + wc * 32 + 8 * fq;
#pragma unroll
        for (int bj = 0; bj < 2; ++bj) { const int col = col0 + bj * 128;
            const f32x4 b0 = *(const f32x4*)(bias + col), b1 = *(const f32x4*)(bias + col + 4);
#pragma unroll
            for (int ai = 0; ai < 2; ++ai)
#pragma unroll
                for (int m = 0; m < 4; ++m) { const int row = row0 + ai * 128 + m * 16;
                    const u32x4 yv = *(const u32x4*)(ys5 + (size_t)row * 512 + col);
                    const f32x4 v0 = acc[ai][bj][m][0] + b0, v1 = acc[ai][bj][m][1] + b1;
                    u32x4 pk;
                    pk.x = pg8::cvt_pk_bf16(bflo(yv.x) * sigmoidf_(v0[0]), bfhi(yv.x) * sigmoidf_(v0[1]));
                    pk.y = pg8::cvt_pk_bf16(bflo(yv.y) * sigmoidf_(v0[2]), bfhi(yv.y) * sigmoidf_(v0[3]));
                    pk.z = pg8::cvt_pk_bf16(bflo(yv.z) * sigmoidf_(v1[0]), bfhi(yv.z) * sigmoidf_(v1[1]));
                    pk.w = pg8::cvt_pk_bf16(bflo(yv.w) * sigmoidf_(v1[2]), bfhi(yv.w) * sigmoidf_(v1[3]));
                    *(u32x4*)(ycat + (size_t)row * 1024 + 512 + col) = pk; } }
    }
};
struct EpiSwiglu {
    static constexpr bool PERM = true;
    bf16_t* H;
    __device__ __forceinline__ void operator()(const AccT& acc, const Unit& u, int wr, int wc, int fr, int fq) const {
        const int e = u.pm >> 3; const int row0 = u.pm * 256 + wr * 64 + fr, col0 = (u.pn - e * 22) * 128 + wc * 32 + 8 * fq;
#pragma unroll
        for (int ai = 0; ai < 2; ++ai)
#pragma unroll
            for (int m = 0; m < 4; ++m) { const f32x4 g0 = acc[ai][0][m][0], g1 = acc[ai][0][m][1], u0 = acc[ai][1][m][0], u1 = acc[ai][1][m][1];
                u32x4 pk;
                pk.x = pg8::cvt_pk_bf16(siluf_(g0[0]) * u0[0], siluf_(g0[1]) * u0[1]); pk.y = pg8::cvt_pk_bf16(siluf_(g0[2]) * u0[2], siluf_(g0[3]) * u0[3]);
                pk.z = pg8::cvt_pk_bf16(siluf_(g1[0]) * u1[0], siluf_(g1[1]) * u1[1]); pk.w = pg8::cvt_pk_bf16(siluf_(g1[2]) * u1[2], siluf_(g1[3]) * u1[3]);
                *(u32x4*)(H + (size_t)(row0 + ai * 128 + m * 16) * F_ + col0) = pk; }
    }
};
struct EpiDown {
    static constexpr bool PERM = true;
    bf16_t* Y; const float* gatev;
    __device__ __forceinline__ void operator()(const AccT& acc, const Unit& u, int wr, int wc, int fr, int fq) const {
        const int e = u.pm >> 3; const int row0 = u.pm * 256 + wr * 64 + fr, col0 = (u.pn - e * 4) * 256 + wc * 32 + 8 * fq;
#pragma unroll
        for (int ai = 0; ai < 2; ++ai)
#pragma unroll
            for (int m = 0; m < 4; ++m) { const int row = row0 + ai * 128 + m * 16; const float gt = gatev[row];
#pragma unroll
                for (int bj = 0; bj < 2; ++bj) { const f32x4 v0 = acc[ai][bj][m][0], v1 = acc[ai][bj][m][1];
                    u32x4 pk; pk.x = pg8::cvt_pk_bf16(v0[0] * gt, v0[1] * gt); pk.y = pg8::cvt_pk_bf16(v0[2] * gt, v0[3] * gt); pk.z = pg8::cvt_pk_bf16(v1[0] * gt, v1[1] * gt); pk.w = pg8::cvt_pk_bf16(v1[2] * gt, v1[3] * gt);
                    *(u32x4*)(Y + (size_t)row * 1024 + col0 + bj * 128) = pk; } }
    }
};
struct EpiVimg {
    static constexpr bool PERM = false;
    bf16_t* V;
    __device__ __forceinline__ void operator()(const AccT& acc, const Unit& u, int wr, int wc, int fr, int fq) const {
        const int row0 = u.pm * 256 + wr * 64 + fr, col0 = u.pn * 256 + wc * 32 + 4 * fq;
#pragma unroll
        for (int ai = 0; ai < 2; ++ai)
#pragma unroll
            for (int m = 0; m < 4; ++m) { const int row = row0 + ai * 128 + m * 16, h = row >> 7, dv = row & 127;
#pragma unroll
                for (int bj = 0; bj < 2; ++bj)
#pragma unroll
                    for (int n = 0; n < 2; ++n) { const int tok = col0 + bj * 128 + n * 16, b = tok >> 12, s = tok & 4095, kt = s >> 6, un = (s & 63) >> 2;
                        const f32x4 v = acc[ai][bj][m][n]; u32x2 pk; pk.x = pg8::cvt_pk_bf16(v[0], v[1]); pk.y = pg8::cvt_pk_bf16(v[2], v[3]);
                        *(u32x2*)(V + (((size_t)(b * 4 + h) * 64 + kt) * 2048 + (((un >> 2) * 2 + (un & 1)) * 128 + dv) * 2 + ((un >> 1) & 1)) * 4) = pk; } }
    }
};
struct EpiLora {
    static constexpr bool PERM = false;
    float* ev; bf16_t* av; bf16_t* gv; const float* w0; const float* a0;
    __device__ __forceinline__ void operator()(const AccT& acc, const Unit& u, int wr, int wc, int fr, int fq) const {
        const int row0 = u.pm * 256 + wr * 64 + fr, colt = u.pn * 256, kind = colt >> 9;
        const int cbase = (colt & 511) + wc * 32 + 4 * fq;
        if (kind < 2) {
            const float* addp = w0 + kind * 512; float* dst = ev + (size_t)kind * T_ * 512;
#pragma unroll
            for (int bj = 0; bj < 2; ++bj)
#pragma unroll
                for (int n = 0; n < 2; ++n) { const int c = cbase + bj * 128 + n * 16; const f32x4 ad = *(const f32x4*)(addp + c);
#pragma unroll
                    for (int ai = 0; ai < 2; ++ai)
#pragma unroll
                        for (int m = 0; m < 4; ++m) { const f32x4 v = acc[ai][bj][m][n] + ad; f32x4 o;
#pragma unroll
                            for (int q = 0; q < 4; ++q) o[q] = 0.6065306597126334f * sigmoidf_(v[q]);
                            *(f32x4*)(dst + (size_t)(row0 + ai * 128 + m * 16) * 512 + c) = o; asm volatile("" ::: "memory"); } }
        } else {
            const bool isa = kind < 4; const float* addp = a0 + ((kind - 2) & 1) * 512; bf16_t* dst = isa ? av + (size_t)(kind - 2) * T_ * 512 : gv;
#pragma unroll
            for (int bj = 0; bj < 2; ++bj)
#pragma unroll
                for (int n = 0; n < 2; ++n) { const int c = cbase + bj * 128 + n * 16; f32x4 ad = (f32x4){0.f, 0.f, 0.f, 0.f}; if (isa) ad = *(const f32x4*)(addp + c);
#pragma unroll
                    for (int ai = 0; ai < 2; ++ai)
#pragma unroll
                        for (int m = 0; m < 4; ++m) { const f32x4 v = acc[ai][bj][m][n] + ad; f32x4 o = v;
                            if (isa) {
#pragma unroll
                                for (int q = 0; q < 4; ++q) o[q] = sigmoidf_(v[q]); }
                            u32x2 pk; pk.x = pk2(o[0], o[1]); pk.y = pk2(o[2], o[3]);
                            *(u32x2*)(dst + (size_t)(row0 + ai * 128 + m * 16) * 512 + c) = pk; asm volatile("" ::: "memory"); } }
        }
    }
};

__device__ __forceinline__ bf16x8 as_frag(const u32x4 u) { union { u32x4 a; bf16x8 b; } x; x.a = u; return x.b; }
struct Frame {
    unsigned char* smem; LAS unsigned char* lds; int tid, lane, wid, bid, nblk;
    const float* const* in; float* out; unsigned char* ws; size_t z;
};
#define WSP(T, off) ((T*)(F.ws + ((off) + F.z)))

__device__ __forceinline__ void phase_mod(const Frame& F) {
    float* silu_c = (float*)F.smem; float* red = silu_c + 4096;
    const float* c = F.in[I_C];
    for (int i = F.tid; i < 4096; i += NTHR) silu_c[i] = siluf_(c[i]);
    __syncthreads();
    float* mod = WSP(float, OFF_MOD);
    for (int u = F.bid; u < 192; u += F.nblk) {
        const int l = u / 96, cg = u % 96, col = cg * 64 + F.lane;
        const float* W = F.in[I_ADA_W] + (size_t)l * 1024 * 6144 + col;
        float a0 = 0.f, a1 = 0.f, a2 = 0.f, a3 = 0.f;
        const int kb = F.wid * 128;
#pragma unroll 8
        for (int k = 0; k < 128; ++k) { const float w = W[(size_t)(kb + k) * 6144]; a0 += silu_c[kb + k] * w; a1 += silu_c[1024 + kb + k] * w; a2 += silu_c[2048 + kb + k] * w; a3 += silu_c[3072 + kb + k] * w; }
        red[(F.wid * 4 + 0) * 64 + F.lane] = a0; red[(F.wid * 4 + 1) * 64 + F.lane] = a1; red[(F.wid * 4 + 2) * 64 + F.lane] = a2; red[(F.wid * 4 + 3) * 64 + F.lane] = a3;
        __syncthreads();
        if (F.wid < 4) { float s = 0.f;
#pragma unroll
            for (int w = 0; w < 8; ++w) s += red[(w * 4 + F.wid) * 64 + F.lane];
            mod[(size_t)(l * 4 + F.wid) * 6144 + col] = s + F.in[I_ADA_B][l * 6144 + col]; }
        __syncthreads();
    }
}

struct CvtJob { const float* src; size_t lds_; bf16_t* dst; size_t ldd; };
#define CVT_LOAD(j, t, P) do { const int kp_ = (t) >> 5, nc_ = ((t) & 31) * 4; const float* s_ = (j).src + (size_t)(2 * kp_) * (j).lds_ + nc_; \
        P##0 = *(const float4*)(s_); P##1 = *(const float4*)(s_ + (j).lds_); P##2 = *(const float4*)(s_ + (size_t)32 * (j).lds_); P##3 = *(const float4*)(s_ + (size_t)33 * (j).lds_); \
        P##4 = *(const float4*)(s_ + (size_t)64 * (j).lds_); P##5 = *(const float4*)(s_ + (size_t)65 * (j).lds_); P##6 = *(const float4*)(s_ + (size_t)96 * (j).lds_); P##7 = *(const float4*)(s_ + (size_t)97 * (j).lds_); } while (0)
#define CVT_PUT(tl, a, b, kd) do { tl[(nc + 0) * 65 + ((nc + 0) >> 5) + (kd)] = pk2(a.x, b.x); tl[(nc + 1) * 65 + ((nc + 1) >> 5) + (kd)] = pk2(a.y, b.y); \
        tl[(nc + 2) * 65 + ((nc + 2) >> 5) + (kd)] = pk2(a.z, b.z); tl[(nc + 3) * 65 + ((nc + 3) >> 5) + (kd)] = pk2(a.w, b.w); } while (0)
__device__ __forceinline__ void cvt_store(bf16_t* dst, size_t ldd, int t, float4 r0, float4 r1, float4 r2, float4 r3, float4 r4, float4 r5, float4 r6, float4 r7, unsigned* tl) {
    const int kp = t >> 5, nc = (t & 31) * 4;
    CVT_PUT(tl, r0, r1, kp); CVT_PUT(tl, r2, r3, kp + 16); CVT_PUT(tl, r4, r5, kp + 32); CVT_PUT(tl, r6, r7, kp + 48);
    __syncthreads();
    const int kq = t & 15;
#pragma unroll
    for (int ps = 0; ps < 4; ++ps) { const int n = (t >> 4) + 32 * ps; const unsigned* rp = tl + n * 65 + (n >> 5) + kq * 4;
        bf16_t* d = ldd ? dst + (size_t)n * ldd + kq * 8 : dst + (kq >> 3) * 16384 + n * 64 + (kq & 7) * 8;
        *(uint4*)d = make_uint4(rp[0], rp[1], rp[2], rp[3]); }
}
__device__ __forceinline__ CvtJob cvt_job_small(const Frame& F, int x) {
    CvtJob j; int tt = x;
    if (tt < 128)               { const int kt = tt & 7, nt = tt >> 3; j.src = F.in[I_AB_IN] + (size_t)kt * 128 * 2576 + nt * 128; j.lds_ = 2576; j.dst = WSP(bf16_t, OFF_WIN0T) + (size_t)(nt * 128) * 1024 + kt * 128; j.ldd = 1024; }
    else if ((tt -= 128) < 32)  { const int kt = tt & 7, nt = tt >> 3; j.src = F.in[I_AB_IN] + (size_t)kt * 128 * 2576 + 2064 + nt * 128; j.lds_ = 2576; j.dst = WSP(bf16_t, OFF_WIN0T) + (size_t)(2048 + nt * 128) * 1024 + kt * 128; j.ldd = 1024; }
    else if ((tt -= 32) < 16)   { const int kt = tt & 3, nt = tt >> 2; j.src = F.in[I_S5_GLUW] + (size_t)kt * 128 * 512 + nt * 128; j.lds_ = 512; j.dst = WSP(bf16_t, OFF_WGLUT) + (size_t)(nt * 128) * 512 + kt * 128; j.ldd = 512; }
    else if ((tt -= 16) < 64)   { const int kt = tt & 7, nt = tt >> 3; j.src = F.in[I_AB_OUT] + (size_t)kt * 128 * 1024 + nt * 128; j.lds_ = 1024; j.dst = WSP(bf16_t, OFF_WOUT0T) + (size_t)(nt * 128) * 1024 + kt * 128; j.ldd = 1024; }
    else if ((tt -= 64) < 184)  { const int kt = tt & 7, nt = tt >> 3; j.src = F.in[I_CD_IN] + (size_t)kt * 128 * 3456 + nt * 128; j.lds_ = 3456; j.dst = WSP(bf16_t, OFF_WIN1T) + (size_t)(nt * 128) * 1024 + kt * 128; j.ldd = 1024; }
    else if ((tt -= 184) < 32)  { const int kt = tt & 7, nt = tt >> 3; j.src = F.in[I_CD_IN] + (size_t)kt * 128 * 3456 + 2944 + nt * 128; j.lds_ = 3456; j.dst = WSP(bf16_t, OFF_WVT) + (size_t)(nt * 128) * 1024 + kt * 128; j.ldd = 1024; }
    else { tt -= 32;              const int kt = tt & 7, nt = tt >> 3; j.src = F.in[I_CD_OUT] + (size_t)kt * 128 * 1024 + nt * 128; j.lds_ = 1024; j.dst = WSP(bf16_t, OFF_WOUT1T) + (size_t)(nt * 128) * 1024 + kt * 128; j.ldd = 1024; }
    return j;
}
__device__ __forceinline__ CvtJob cvt_job_expert(const Frame& F, int x) {
    CvtJob j; const int region = x / 176, tt = x % 176, l = region / 48, rem = region % 48, e = rem / 3, kind = rem % 3;
    if (kind < 2) { const int kt = tt & 7, nt = tt >> 3;
        j.src = F.in[kind == 0 ? I_WGATE : I_WUP] + ((size_t)(l * 16 + e) * 1024 + kt * 128) * 2816 + nt * 128; j.lds_ = 2816;
        j.dst = (bf16_t*)(F.ws + OFF_W1T + (size_t)l * W1T_LAYER) + (size_t)(e * 22 + nt) * (256 * 1024) + (size_t)(2 * kt) * 16384 + kind * 128 * 64; j.ldd = 0; }
    else { const int kt = tt % 22, nt = tt / 22;
        j.src = F.in[I_WDOWN] + ((size_t)(l * 16 + e) * 2816 + kt * 128) * 1024 + nt * 128; j.lds_ = 1024;
        j.dst = (bf16_t*)(F.ws + OFF_W2T + (size_t)l * W2T_LAYER) + (size_t)(e * 4 + (nt >> 1)) * (256 * 2816) + (size_t)(2 * kt) * 16384 + (nt & 1) * 128 * 64; j.ldd = 0; }
    return j;
}
template <bool LORA> __device__ __forceinline__ void phase_convert(const Frame& F, int jlo, int jhi, int b0, int bst) {
    unsigned* tl0 = (unsigned*)F.smem; unsigned* tl1 = tl0 + 128 * 65 + 8;
    constexpr int NSMALL = 520, NJOB = NSMALL + 16 * 3 * 176;
    float4 c0 = make_float4(0.f, 0.f, 0.f, 0.f), c1 = c0, c2 = c0, c3 = c0, c4 = c0, c5 = c0, c6 = c0, c7 = c0, n0 = c0, n1 = c0, n2 = c0, n3 = c0, n4 = c0, n5 = c0, n6 = c0, n7 = c0,
           m0 = c0, m1 = c0, m2 = c0, m3 = c0, m4 = c0, m5 = c0, m6 = c0, m7 = c0;
#define CVT_JOB(xx) ((xx) < NSMALL ? cvt_job_small(F, (xx)) : cvt_job_expert(F, (xx) - NSMALL))
    (void)NJOB;
    int x = jlo + b0, par = 0;
    if (x < jhi) { const CvtJob j = CVT_JOB(x); CVT_LOAD(j, F.tid, c); }
    if (x + bst < jhi) { const CvtJob j = CVT_JOB(x + bst); CVT_LOAD(j, F.tid, n); }
    for (; x < jhi; x += bst, par ^= 1) {
        const CvtJob j = CVT_JOB(x);
        const int xn = x + 2 * bst;
        if (xn < jhi) { const CvtJob jn = CVT_JOB(xn); CVT_LOAD(jn, F.tid, m); }
        cvt_store(j.dst, j.ldd, F.tid, c0, c1, c2, c3, c4, c5, c6, c7, par ? tl1 : tl0);
        c0 = n0; c1 = n1; c2 = n2; c3 = n3; c4 = n4; c5 = n5; c6 = n6; c7 = n7;
        n0 = m0; n1 = m1; n2 = m2; n3 = m3; n4 = m4; n5 = m5; n6 = m6; n7 = m7;
    }
#undef CVT_JOB
    __syncthreads();
    if (LORA) {
        bf16_t* Wl = WSP(bf16_t, OFF_WLORAT);
        const float* w2 = F.in[I_RW_W2]; const float* a2 = F.in[I_RW_A2]; const float* g2 = F.in[I_RW_G2];
        for (int i = F.bid * NTHR + F.tid; i < 2560 * 384; i += F.nblk * NTHR) {
            const int n = i / 384, k = i % 384, kind = n >> 9, c = n & 511; float v = 0.f;
            if (kind == 0) { if (k < 64) v = w2[(size_t)(0 * 64 + k) * 512 + c]; }
            else if (kind == 1) { if (k >= 64 && k < 128) v = w2[(size_t)(1 * 64 + (k - 64)) * 512 + c]; }
            else if (kind == 2) { if (k >= 128 && k < 192) v = a2[(size_t)(0 * 64 + (k - 128)) * 512 + c]; }
            else if (kind == 3) { if (k >= 192 && k < 256) v = a2[(size_t)(1 * 64 + (k - 192)) * 512 + c]; }
            else { if (k >= 256) v = g2[(size_t)(k - 256) * 512 + c]; }
            Wl[i] = f2bf(v);
        }
    }
}

__device__ __forceinline__ void load_row16(const float* p, int lane, float (&v)[16]) {
    const float4* q = (const float4*)(p + lane * 4);
#pragma unroll
    for (int i = 0; i < 4; ++i) { const float4 t = q[i * 64]; v[4 * i] = t.x; v[4 * i + 1] = t.y; v[4 * i + 2] = t.z; v[4 * i + 3] = t.w; }
}
__device__ __forceinline__ void store_row16(float* p, int lane, const float (&v)[16]) {
    float4* q = (float4*)(p + lane * 4);
#pragma unroll
    for (int i = 0; i < 4; ++i) q[i * 64] = make_float4(v[4 * i], v[4 * i + 1], v[4 * i + 2], v[4 * i + 3]);
}
__device__ __forceinline__ void load_row16_bf(const bf16_t* p, int lane, float (&v)[16]) {
    const u32x2* q = (const u32x2*)(p + lane * 4);
#pragma unroll
    for (int i = 0; i < 4; ++i) { const u32x2 t = q[i * 64]; v[4 * i] = bflo(t.x); v[4 * i + 1] = bfhi(t.x); v[4 * i + 2] = bflo(t.y); v[4 * i + 3] = bfhi(t.y); }
}
__device__ __forceinline__ void store_row16_bf(bf16_t* p, int lane, const float (&v)[16]) {
    u32x2* q = (u32x2*)(p + lane * 4);
#pragma unroll
    for (int i = 0; i < 4; ++i) q[i * 64] = (u32x2){pk2(v[4 * i], v[4 * i + 1]), pk2(v[4 * i + 2], v[4 * i + 3])};
}
__device__ __forceinline__ void fill_thin(float* wl, const float* W, int ldw, int tid) {
    for (int i = tid; i < 1024 * 16; i += NTHR) { const int c = i >> 4, j = i & 15; const int q = (c >> 8) * 4 + (c & 3), ln = (c >> 2) & 63; wl[(q * 64 + ln) * 20 + j] = W[(size_t)c * ldw + j]; }
}
__device__ __forceinline__ void thin16(const float* wl, int lane, const float (&h)[16], float (&o)[16]) {
#pragma unroll
    for (int j = 0; j < 16; ++j) o[j] = 0.f;
#pragma unroll
    for (int i = 0; i < 16; ++i) { const float4* w = (const float4*)(wl + (i * 64 + lane) * 20);
        if ((i & 1) == 0) asm volatile("" ::: "memory");
#pragma unroll
        for (int q = 0; q < 4; ++q) { const float4 t = w[q]; o[4 * q] += h[i] * t.x; o[4 * q + 1] += h[i] * t.y; o[4 * q + 2] += h[i] * t.z; o[4 * q + 3] += h[i] * t.w; } }
#pragma unroll
    for (int j = 0; j < 16; ++j) o[j] = wave_sum(o[j]);
}

__device__ __forceinline__ void phase_norm0(const Frame& F) {
    float* wl = (float*)F.smem;
    fill_thin(wl, F.in[I_AB_IN] + 2048, 2576, F.tid);
    __syncthreads();
    const float* x = F.in[I_X]; const float* mod = WSP(float, OFF_MOD); bf16_t* hb = WSP(bf16_t, OFF_HB); float* gb = WSP(float, OFF_GB0);
    for (int tb = F.bid; tb < 256; tb += F.nblk) {
        const int base = tb * 64 + F.wid * 8, b = base >> 12;
        float gain[16], sc[16], sh[16];
        load_row16(F.in[I_NMIX_PRE], F.lane, gain);
        load_row16(mod + (size_t)(0 * 4 + b) * 6144 + 1024, F.lane, sc);
        load_row16(mod + (size_t)(0 * 4 + b) * 6144, F.lane, sh);
        for (int i = 0; i < 8; ++i) {
            const int tok = base + i; float v[16]; load_row16(x + (size_t)tok * 1024, F.lane, v);
            float ss = 0.f;
#pragma unroll
            for (int q = 0; q < 16; ++q) ss += v[q] * v[q];
            ss = wave_sum(ss); const float rstd = rsqrtf(ss * (1.f / 1024.f) + 1e-6f);
#pragma unroll
            for (int q = 0; q < 16; ++q) v[q] = v[q] * rstd * gain[q] * (1.f + sc[q]) + sh[q];
            store_row16_bf(hb + (size_t)tok * 1024, F.lane, v);
            float o[16]; thin16(wl, F.lane, v, o);
            if (F.lane < 16) { const int j = F.lane; float r = 0.f;
#pragma unroll
                for (int q = 0; q < 16; ++q) r = (q == j) ? o[q] : r;
                float outv;
                if (j < 8) outv = -__expf(F.in[I_DN_ALOG][j]) * softplusf_(r + F.in[I_DN_DTB][j]);
                else outv = sigmoidf_(r);
                gb[(size_t)tok * 16 + j] = outv; }
        }
    }
}

__device__ __forceinline__ void phase_dnprep(const Frame& F) {
    const bf16_t* P0 = WSP(bf16_t, OFF_P0); bf16_t* qkvn = WSP(bf16_t, OFF_QKVN); const float* cw = F.in[I_DN_CONV];
    const int c0 = F.lane * 8;
    for (int tb = F.bid; tb < 256; tb += F.nblk) {
        const int base = tb * 64 + F.wid * 8;
        for (int i = 0; i < 8; ++i) {
            const int tok = base + i, s = tok & 4095;
#pragma unroll
            for (int grp = 0; grp < 3; ++grp) {
                float acc[8];
#pragma unroll
                for (int q = 0; q < 8; ++q) acc[q] = 0.f;
#pragma unroll
                for (int j = 0; j < 5; ++j) { const int sj = s + j - 2;
                    if (sj >= 0 && sj < 4096) {
                        const u32x4 pv = *(const u32x4*)(P0 + (size_t)(tok + j - 2) * 2560 + grp * 512 + c0);
                        const float4 w0 = *(const float4*)(cw + j * 1536 + grp * 512 + c0), w1 = *(const float4*)(cw + j * 1536 + grp * 512 + c0 + 4);
                        acc[0] += w0.x * bflo(pv.x); acc[1] += w0.y * bfhi(pv.x); acc[2] += w0.z * bflo(pv.y); acc[3] += w0.w * bfhi(pv.y);
                        acc[4] += w1.x * bflo(pv.z); acc[5] += w1.y * bfhi(pv.z); acc[6] += w1.z * bflo(pv.w); acc[7] += w1.w * bfhi(pv.w); } }
                float ss = 0.f;
#pragma unroll
                for (int q = 0; q < 8; ++q) { acc[q] = siluf_(acc[q]); ss += acc[q] * acc[q]; }
                if (grp < 2) {
                    ss += __shfl_xor(ss, 1); ss += __shfl_xor(ss, 2); ss += __shfl_xor(ss, 4); ss += __shfl_xor(ss, 8);
                    float sc = rsqrtf(ss + 1e-6f); if (grp == 0) sc *= 0.08838834764831845f;
#pragma unroll
                    for (int q = 0; q < 8; ++q) acc[q] *= sc; }
                *(u32x4*)(qkvn + (size_t)tok * 1536 + grp * 512 + c0) = (u32x4){pk2(acc[0], acc[1]), pk2(acc[2], acc[3]), pk2(acc[4], acc[5]), pk2(acc[6], acc[7])};
            }
        }
    }
}

__device__ __forceinline__ void phase_dnscan(const Frame& F) {
    float* bufQK = (float*)F.smem;
    float* bufV = bufQK + 2 * 32 * 256;
    float* bufG = bufV + 2 * 32 * 32;
    const float* qkvn = WSP(float, OFF_QKVN); const float* gb = WSP(float, OFF_GB0); float* dno = WSP(float, OFF_DNO);
    const int col4 = F.lane >> 4, kp = F.lane & 15, jj = F.wid * 4 + col4;
    const bool split = (F.nblk == 256);
    if (split && F.bid >= 128) return;
    for (int u = F.bid; u < 128; u += (split ? 128 : F.nblk)) {
        const int cb = u & 3, seq = u >> 2, dir = seq & 1, h = (seq >> 1) & 3, b = seq >> 3;
        float s[8];
#pragma unroll
        for (int q = 0; q < 8; ++q) s[q] = 0.f;
        float4 rq0, rq1, rq2, rq3; float4 rv = make_float4(0.f, 0.f, 0.f, 0.f); float rg = 0.f;
#define DN_LD1(dst, i, c) do { const int idx = F.tid + NTHR * (i), row = idx >> 6, c4 = idx & 63, step = (c) * 32 + row, t = dir ? 4095 - step : step; \
            const size_t tok = (size_t)b * 4096 + t; dst = *(const float4*)(qkvn + tok * 1536 + (c4 < 32 ? h * 128 + c4 * 4 : 512 + h * 128 + (c4 - 32) * 4)); } while (0)
#define DN_GLOAD(c) do { DN_LD1(rq0, 0, c); DN_LD1(rq1, 1, c); DN_LD1(rq2, 2, c); DN_LD1(rq3, 3, c); \
            if (F.tid < 256) { const int row = F.tid >> 3, c4 = F.tid & 7, step = (c) * 32 + row, t = dir ? 4095 - step : step; const size_t tok = (size_t)b * 4096 + t; \
                rv = *(const float4*)(qkvn + tok * 1536 + 1024 + h * 128 + cb * 32 + c4 * 4); } \
            else if (F.tid < 320) { const int row = (F.tid - 256) >> 1, which = F.tid & 1, step = (c) * 32 + row, t = dir ? 4095 - step : step; const size_t tok = (size_t)b * 4096 + t; \
                rg = gb[tok * 16 + which * 8 + dir * 4 + h]; } } while (0)
#define DN_LSTORE(buf) do { *(float4*)(bufQK + (buf) * 8192 + (F.tid) * 4) = rq0; *(float4*)(bufQK + (buf) * 8192 + (F.tid + NTHR) * 4) = rq1; \
            *(float4*)(bufQK + (buf) * 8192 + (F.tid + 2 * NTHR) * 4) = rq2; *(float4*)(bufQK + (buf) * 8192 + (F.tid + 3 * NTHR) * 4) = rq3; \
            if (F.tid < 256) *(float4*)(bufV + (buf) * 1024 + F.tid * 4) = rv; else if (F.tid < 320) bufG[(buf) * 64 + (F.tid - 256)] = rg; } while (0)
        DN_GLOAD(0); DN_LSTORE(0); __syncthreads();
        for (int c = 0; c < 128; ++c) {
            const int buf = c & 1;
            if (c + 1 < 128) DN_GLOAD(c + 1);
            float osel = 0.f;
#pragma unroll 4
            for (int i = 0; i < 32; ++i) {
                const float* row = bufQK + buf * 8192 + i * 256;
                const float4 q0 = *(const float4*)(row + kp * 8), q1 = *(const float4*)(row + kp * 8 + 4);
                const float4 k0 = *(const float4*)(row + 128 + kp * 8), k1 = *(const float4*)(row + 128 + kp * 8 + 4);
                const float v = bufV[buf * 1024 + i * 32 + jj]; const float g = bufG[buf * 64 + i * 2], beta = bufG[buf * 64 + i * 2 + 1];
                const float a = __expf(g);
#pragma unroll
                for (int q = 0; q < 8; ++q) s[q] *= a;
                float d = k0.x * s[0] + k0.y * s[1] + k0.z * s[2] + k0.w * s[3] + k1.x * s[4] + k1.y * s[5] + k1.z * s[6] + k1.w * s[7];
                d = row16_sum(d);
                const float cc = beta * (v - d);
                s[0] += k0.x * cc; s[1] += k0.y * cc; s[2] += k0.z * cc; s[3] += k0.w * cc; s[4] += k1.x * cc; s[5] += k1.y * cc; s[6] += k1.z * cc; s[7] += k1.w * cc;
                float o = q0.x * s[0] + q0.y * s[1] + q0.z * s[2] + q0.w * s[3] + q1.x * s[4] + q1.y * s[5] + q1.z * s[6] + q1.w * s[7];
                o = row16_sum(o);
                osel = (kp == (i & 15)) ? o : osel;
                if ((i & 15) == 15) { const int step = c * 32 + (i & 16) + kp, t = dir ? 4095 - step : step;
                    dno[((size_t)dir * T_ + (size_t)b * 4096 + t) * 512 + h * 128 + cb * 32 + jj] = osel; }
            }
            if (c + 1 < 128) DN_LSTORE(buf ^ 1);
            __syncthreads();
        }
    }
#undef DN_LD1
#undef DN_GLOAD
#undef DN_LSTORE
}

__device__ __forceinline__ void phase_s5scan(const Frame& F) {
    float* Ebuf = (float*)F.smem;
    unsigned char* wbase = F.smem + 32768 + F.wid * (2048 + 8448 + 4352);
    bf16_t* ub = (bf16_t*)wbase;
    float* bu = (float*)(wbase + 2048);
    bf16_t* xsb = (bf16_t*)(wbase + 2048 + 8448);
    const bf16_t* P0 = WSP(bf16_t, OFF_P0); bf16_t* s5y = WSP(bf16_t, OFF_S5Y);
    const int p = F.lane, l15 = F.lane & 15, kg = F.lane >> 4;
#ifdef S5_CMP
    float cmp_e = 0.f, cmp_r = 0.f;
#endif
    for (int u = F.bid; u < 256; u += F.nblk) {
        const int d = u & 1, g = (u >> 1) & 31, b = u >> 6;
        const float dt = __expf(F.in[I_S5_LDT][d * 32 + g]);
        const float are = F.in[I_S5_ARE][(d * 32 + g) * 64 + p], aim = F.in[I_S5_AIM][(d * 32 + g) * 64 + p];
        const float mag = __expf(are * dt);
        float rev = aim * dt * 0.15915494309189535f; rev -= floorf(rev);
        const float lr = mag * __builtin_amdgcn_cosf(rev), li = mag * __builtin_amdgcn_sinf(rev);
        const float den = are * are + aim * aim, nr = lr - 1.f, ni = li;
        const float fre = (nr * are + ni * aim) / den, fim = (ni * are - nr * aim) / den;
        bf16x8 bfr[8];
#pragma unroll
        for (int n = 0; n < 8; ++n) { const int ps = (n & 3) * 16 + l15; const float fr_ = __shfl(fre, ps), fi_ = __shfl(fim, ps);
            const float* br = F.in[I_S5_BRE] + ((size_t)(d * 32 + g) * 64 + ps) * 16 + 8 * (kg & 1); const float* bi = F.in[I_S5_BIM] + ((size_t)(d * 32 + g) * 64 + ps) * 16 + 8 * (kg & 1);
            bf16x8 f;
#pragma unroll
            for (int j = 0; j < 8; ++j) { const float r_ = br[j], i_ = bi[j]; const float v = (n < 4) ? (fr_ * r_ - fi_ * i_) : (fr_ * i_ + fi_ * r_); f[j] = (short)f2bf(kg < 2 ? v : 0.f); }
            bfr[n] = f; }
        bf16x8 cfrag[4];
        { const int hcol = l15;
#pragma unroll
          for (int s = 0; s < 4; ++s) { const int kk0 = 32 * s + 8 * kg; bf16x8 f;
#pragma unroll
              for (int j = 0; j < 8; ++j) { const int kk = kk0 + j; const float v = kk < 64 ? F.in[I_S5_CRE][((size_t)(d * 32 + g) * 16 + hcol) * 64 + kk] : -F.in[I_S5_CIM][((size_t)(d * 32 + g) * 16 + hcol) * 64 + (kk - 64)]; f[j] = (short)f2bf(v); }
              cfrag[s] = f; } }
        float l64r = lr, l64i = li;
#pragma unroll
        for (int q = 0; q < 6; ++q) { const float r2 = l64r * l64r - l64i * l64i, i2 = 2.f * l64r * l64i; l64r = r2; l64i = i2; }
#define S5_LOADU(cw) do { const int n_ = (cw) * 64 + F.lane, t_ = d ? 4095 - n_ : n_; const bf16_t* src_ = P0 + ((size_t)b * 4096 + t_) * 2560 + 2048 + g * 16; \
            const u32x4 a_ = *(const u32x4*)src_, c_ = *(const u32x4*)(src_ + 8); asm volatile("s_waitcnt lgkmcnt(0)" ::: "memory"); __builtin_amdgcn_wave_barrier(); \
            *(u32x4*)(ub + F.lane * 16) = a_; *(u32x4*)(ub + F.lane * 16 + 8) = c_; asm volatile("s_waitcnt lgkmcnt(0)" ::: "memory"); __builtin_amdgcn_wave_barrier(); } while (0)
#define S5_BU(sub) do { bf16x8 af_; { const u32x4 z_ = (u32x4){0u, 0u, 0u, 0u}; u32x4 v_ = *(const u32x4*)(ub + ((sub) * 16 + l15) * 16 + 8 * (kg & 1)); if (kg >= 2) v_ = z_; af_ = as_frag(v_); } \
            f32x4 ac_[8]; \
            _Pragma("unroll") for (int n = 0; n < 8; ++n) { ac_[n] = (f32x4){0.f, 0.f, 0.f, 0.f}; ac_[n] = __builtin_amdgcn_mfma_f32_16x16x32_bf16(af_, bfr[n], ac_[n], 0, 0, 0); } \
            asm volatile("s_nop 15\n\ts_nop 15" : "+v"(ac_[0]), "+v"(ac_[1]), "+v"(ac_[2]), "+v"(ac_[3]), "+v"(ac_[4]), "+v"(ac_[5]), "+v"(ac_[6]), "+v"(ac_[7]) :: "memory"); \
            _Pragma("unroll") for (int n = 0; n < 8; ++n) { _Pragma("unroll") for (int j = 0; j < 4; ++j) bu[(kg * 4 + j) * 132 + n * 16 + l15] = ac_[n][j]; } \
            asm volatile("s_waitcnt lgkmcnt(0)" ::: "memory"); __builtin_amdgcn_wave_barrier(); } while (0)
        for (int i = 0; i < 8; ++i) { const int cw = F.wid * 8 + i; S5_LOADU(cw); float xr = 0.f, xi = 0.f;
            for (int sub = 0; sub < 4; ++sub) { S5_BU(sub);
#pragma unroll
                for (int j = 0; j < 16; ++j) { const float br_ = bu[j * 132 + p], bi_ = bu[j * 132 + 64 + p]; const float nxr = lr * xr - li * xi + br_, nxi = lr * xi + li * xr + bi_; xr = nxr; xi = nxi; }
                asm volatile("s_waitcnt lgkmcnt(0)" ::: "memory"); __builtin_amdgcn_wave_barrier(); }
            Ebuf[(cw * 64 + p) * 2] = xr; Ebuf[(cw * 64 + p) * 2 + 1] = xi; }
        __syncthreads();
        float xr = 0.f, xi = 0.f;
        for (int c = 0; c < F.wid * 8; ++c) { const float er = Ebuf[(c * 64 + p) * 2], ei = Ebuf[(c * 64 + p) * 2 + 1]; const float nr_ = l64r * xr - l64i * xi + er, ni_ = l64r * xi + l64i * xr + ei; xr = nr_; xi = ni_; }
        for (int i = 0; i < 8; ++i) { const int cw = F.wid * 8 + i; S5_LOADU(cw);
            for (int sub = 0; sub < 4; ++sub) { S5_BU(sub);
#pragma unroll
                for (int j = 0; j < 16; ++j) { const float br_ = bu[j * 132 + p], bi_ = bu[j * 132 + 64 + p];
                    asm volatile("" ::: "memory");
                    const float nxr = lr * xr - li * xi + br_, nxi = lr * xi + li * xr + bi_; xr = nxr; xi = nxi;
                    bf16_t* xs = xsb + j * 136; xs[p] = f2bf(xr); xs[64 + p] = f2bf(xi);
                    asm volatile("" ::: "memory"); }
                asm volatile("s_waitcnt lgkmcnt(0)" ::: "memory"); __builtin_amdgcn_wave_barrier();
                f32x4 acc = (f32x4){0.f, 0.f, 0.f, 0.f};
#pragma unroll
                for (int s = 0; s < 4; ++s) { const bf16x8 af = *(const bf16x8*)(xsb + l15 * 136 + 32 * s + 8 * kg); acc = __builtin_amdgcn_mfma_f32_16x16x32_bf16(af, cfrag[s], acc, 0, 0, 0); }
                asm volatile("s_waitcnt lgkmcnt(0)" ::: "memory"); __builtin_amdgcn_wave_barrier();
#pragma unroll
                for (int jp = 0; jp < 2; ++jp) {
                    const float n0 = __shfl_xor(acc[2 * jp], 1), n1 = __shfl_xor(acc[2 * jp + 1], 1); const bool odd = (l15 & 1) != 0;
                    const int j = odd ? 2 * jp + 1 : 2 * jp; const float lo = odd ? n1 : acc[2 * jp], hi = odd ? acc[2 * jp + 1] : n0;
                    const int tl_ = kg * 4 + j, n = cw * 64 + sub * 16 + tl_, t = d ? 4095 - n : n;
                    *(unsigned*)(s5y + ((size_t)d * T_ + (size_t)b * 4096 + t) * 512 + g * 16 + (l15 & ~1)) = pk2(lo, hi); }
            } }
#ifdef S5_CMP
        cmp_e = wave_sum(cmp_e); cmp_r = wave_sum(cmp_r); if (F.lane == 0) { float* fw = (float*)(F.ws + OFF_BAR); atomicAdd(fw + 4004, cmp_e); atomicAdd(fw + 4005, cmp_r); atomicAdd(fw + 4006, cmp_e); atomicAdd(fw + 4007, cmp_r); }
#endif
        __syncthreads();
#undef S5_LOADU
#undef S5_BU
    }
}

__device__ __forceinline__ void phase_post0(const Frame& F) {
    const bf16_t* P0 = WSP(bf16_t, OFF_P0); const bf16_t* dno = WSP(bf16_t, OFF_DNO); const bf16_t* s5y = WSP(bf16_t, OFF_S5Y);
    bf16_t* ycat = WSP(bf16_t, OFF_YCAT); bf16_t* ys5 = WSP(bf16_t, OFF_YS5);
    const int c0 = F.lane * 8;
    float nw[8], dsk[8];
#pragma unroll
    for (int q = 0; q < 8; ++q) { nw[q] = F.in[I_DN_NORM][(c0 & 127) + q]; dsk[q] = F.in[I_S5_D][c0 + q]; }
    for (int tb = F.bid; tb < 256; tb += F.nblk) {
        const int base = tb * 64 + F.wid * 8;
        for (int i = 0; i < 8; ++i) { const size_t tok = base + i;
            { const u32x4 a = *(const u32x4*)(dno + tok * 512 + c0), b = *(const u32x4*)(dno + ((size_t)T_ + tok) * 512 + c0);
              float o[8] = {bflo(a.x) + bflo(b.x), bfhi(a.x) + bfhi(b.x), bflo(a.y) + bflo(b.y), bfhi(a.y) + bfhi(b.y), bflo(a.z) + bflo(b.z), bfhi(a.z) + bfhi(b.z), bflo(a.w) + bflo(b.w), bfhi(a.w) + bfhi(b.w)};
              float ss = 0.f;
#pragma unroll
              for (int q = 0; q < 8; ++q) ss += o[q] * o[q];
              ss += __shfl_xor(ss, 1); ss += __shfl_xor(ss, 2); ss += __shfl_xor(ss, 4); ss += __shfl_xor(ss, 8);
              const float rstd = rsqrtf(ss * (1.f / 128.f) + 1e-6f);
              const u32x4 zv = *(const u32x4*)(P0 + tok * 2560 + 1536 + c0);
              const float z[8] = {bflo(zv.x), bfhi(zv.x), bflo(zv.y), bfhi(zv.y), bflo(zv.z), bfhi(zv.z), bflo(zv.w), bfhi(zv.w)};
#pragma unroll
              for (int q = 0; q < 8; ++q) o[q] = o[q] * rstd * nw[q] * siluf_(z[q]);
              *(u32x4*)(ycat + tok * 1024 + c0) = (u32x4){pk2(o[0], o[1]), pk2(o[2], o[3]), pk2(o[4], o[5]), pk2(o[6], o[7])}; }
            { const u32x4 a = *(const u32x4*)(s5y + tok * 512 + c0), b = *(const u32x4*)(s5y + ((size_t)T_ + tok) * 512 + c0);
              const u32x4 uv = *(const u32x4*)(P0 + tok * 2560 + 2048 + c0);
              const float uu[8] = {bflo(uv.x), bfhi(uv.x), bflo(uv.y), bfhi(uv.y), bflo(uv.z), bfhi(uv.z), bflo(uv.w), bfhi(uv.w)};
              float y[8] = {bflo(a.x) + bflo(b.x), bfhi(a.x) + bfhi(b.x), bflo(a.y) + bflo(b.y), bfhi(a.y) + bfhi(b.y), bflo(a.z) + bflo(b.z), bfhi(a.z) + bfhi(b.z), bflo(a.w) + bflo(b.w), bfhi(a.w) + bfhi(b.w)};
#pragma unroll
              for (int q = 0; q < 8; ++q) y[q] = gelu_tanhf_(y[q] + dsk[q] * uu[q]);
              *(u32x4*)(ys5 + tok * 512 + c0) = (u32x4){pk2(y[0], y[1]), pk2(y[2], y[3]), pk2(y[4], y[5]), pk2(y[6], y[7])}; }
        }
    }
}
constexpr int LD72 = 72;
#ifndef DN_SWAPTEST_V
#define DN_SWAPTEST_V (vv * beta)
#endif
#ifdef DN_ROBUST
#define DN_WSYNC() __syncthreads()
#define DN_XSYNC() __syncthreads()
#else
#define DN_WSYNC() do { asm volatile("s_waitcnt lgkmcnt(0)" ::: "memory"); __builtin_amdgcn_wave_barrier(); } while (0)
#define DN_XSYNC() do { } while (0)
#endif
#ifndef DN_CLIM
#define DN_CLIM 64
#endif
__device__ __forceinline__ int perm16(int x) { return ((x >> 2) & 1) * 8 + ((x >> 3) << 2) + (x & 3); }
__device__ __forceinline__ bf16x8 ld_frag_f32(const float* p) {
    const float4 a = *(const float4*)p, b = *(const float4*)(p + 4);
    bf16x8 f; const unsigned w0 = pk2(a.x, a.y), w1 = pk2(a.z, a.w), w2 = pk2(b.x, b.y), w3 = pk2(b.z, b.w);
    f[0] = (short)(w0 & 0xFFFFu); f[1] = (short)(w0 >> 16); f[2] = (short)(w1 & 0xFFFFu); f[3] = (short)(w1 >> 16);
    f[4] = (short)(w2 & 0xFFFFu); f[5] = (short)(w2 >> 16); f[6] = (short)(w3 & 0xFFFFu); f[7] = (short)(w3 >> 16); return f;
}
__device__ __forceinline__ u32x4 pack8(const f32x16& a, int s) {
    u32x4 o; o.x = pg8::cvt_pk_bf16(a[8 * s], a[8 * s + 1]); o.y = pg8::cvt_pk_bf16(a[8 * s + 2], a[8 * s + 3]); o.z = pg8::cvt_pk_bf16(a[8 * s + 4], a[8 * s + 5]); o.w = pg8::cvt_pk_bf16(a[8 * s + 6], a[8 * s + 7]); return o;
}
__device__ __forceinline__ void unpack16(const u32x4 lo, const u32x4 hi, f32x16& a) {
    a[0] = bflo(lo.x); a[1] = bfhi(lo.x); a[2] = bflo(lo.y); a[3] = bfhi(lo.y); a[4] = bflo(lo.z); a[5] = bfhi(lo.z); a[6] = bflo(lo.w); a[7] = bfhi(lo.w);
    a[8] = bflo(hi.x); a[9] = bfhi(hi.x); a[10] = bflo(hi.y); a[11] = bfhi(hi.y); a[12] = bflo(hi.z); a[13] = bfhi(hi.z); a[14] = bflo(hi.w); a[15] = bfhi(hi.w);
}
template <int KS> __device__ __forceinline__ f32x16 tile_mm(const bf16_t* A, int ldA, const bf16_t* Bt, int ldB, int lane) {
    f32x16 acc;
#pragma unroll
    for (int r = 0; r < 16; ++r) acc[r] = 0.f;
    const int rw = lane & 31, hh = lane >> 5;
#pragma unroll
    for (int s = 0; s < KS; ++s) { const bf16x8 a = *(const bf16x8*)(A + rw * ldA + 16 * s + 8 * hh), b = *(const bf16x8*)(Bt + rw * ldB + 16 * s + 8 * hh);
        acc = __builtin_amdgcn_mfma_f32_32x32x16_bf16(a, b, acc, 0, 0, 0); }
    return acc;
}

__device__ __forceinline__ void phase_dn_ab(const Frame& F) {
    const bf16_t* qkvn = WSP(bf16_t, OFF_QKVN); const float* gb = WSP(float, OFF_GB0);
    float* gcs_g = WSP(float, OFF_DN_GCS); bf16_t* Am_g = WSP(bf16_t, OFF_DN_AM); bf16_t* Tm_g = WSP(bf16_t, OFF_DN_TM);
    float* Gs = (float*)F.smem + F.wid * (64 * 68 + 128);
    float* gsm = Gs + 64 * 68; float* bsm = gsm + 64;
    const int rw = F.lane & 31, hh = F.lane >> 5;
    for (int ch = F.bid + F.wid * F.nblk; ch < 2048; ch += F.nblk * 8) {
        const int seq = ch >> 6, c = ch & 63, dir = seq & 1, h = (seq >> 1) & 3, b = seq >> 3;
        { const int step = c * 64 + F.lane, t = dir ? 4095 - step : step; const size_t tok = (size_t)b * 4096 + t;
          float gc = gb[tok * 16 + dir * 4 + h]; const float beta = gb[tok * 16 + 8 + dir * 4 + h];
#pragma unroll
          for (int o = 1; o < 64; o <<= 1) { const float tt = __shfl_up(gc, o); if (F.lane >= o) gc += tt; }
          gsm[F.lane] = gc; bsm[F.lane] = beta; gcs_g[(size_t)ch * 64 + F.lane] = gc; }
        DN_WSYNC();
        size_t tokr[2];
#pragma unroll
        for (int ti = 0; ti < 2; ++ti) { const int step = c * 64 + ti * 32 + rw, t = dir ? 4095 - step : step; tokr[ti] = (size_t)b * 4096 + t; }
        bf16x8 kf[2][8];
#pragma unroll
        for (int ti = 0; ti < 2; ++ti)
#pragma unroll
            for (int s = 0; s < 8; ++s) kf[ti][s] = *(const bf16x8*)(qkvn + tokr[ti] * 1536 + 512 + h * 128 + 16 * s + 8 * hh);
#pragma unroll
        for (int ti = 0; ti < 2; ++ti)
#pragma unroll
            for (int tj = 0; tj <= ti; ++tj) {
                f32x16 acc;
#pragma unroll
                for (int r = 0; r < 16; ++r) acc[r] = 0.f;
#pragma unroll
                for (int s = 0; s < 8; ++s) acc = __builtin_amdgcn_mfma_f32_32x32x16_bf16(kf[ti][s], kf[tj][s], acc, 0, 0, 0);
                int j = tj * 32 + rw; asm volatile("" : "+v"(j));
                const float gcj = gsm[j]; const int ib = ti * 32 + 4 * hh;
#pragma unroll
                for (int r = 0; r < 16; ++r) { const int i = ib + (r & 3) + 8 * (r >> 2);
                    Gs[i * 68 + j] = (j < i) ? bsm[i] * acc[r] * __expf(fminf(gsm[i] - gcj, 0.f)) : 0.f; }
            }
#pragma unroll
        for (int ti = 0; ti < 2; ++ti) {
            bf16x8 qf[8];
#pragma unroll
            for (int s = 0; s < 8; ++s) qf[s] = *(const bf16x8*)(qkvn + tokr[ti] * 1536 + h * 128 + 16 * s + 8 * hh);
#pragma unroll
            for (int tj = 0; tj < 2; ++tj) {
                f32x16 acc;
#pragma unroll
                for (int r = 0; r < 16; ++r) acc[r] = 0.f;
                if (tj <= ti) {
#pragma unroll
                    for (int s = 0; s < 8; ++s) acc = __builtin_amdgcn_mfma_f32_32x32x16_bf16(qf[s], kf[tj][s], acc, 0, 0, 0); }
                int j = tj * 32 + rw; asm volatile("" : "+v"(j));
                const float gcj = gsm[j]; const int ib = ti * 32 + 4 * hh;
                bf16_t* ap = Am_g + (size_t)ch * 4096 + (ti * 32 + 4 * hh) * 64 + j; asm volatile("" : "+v"(ap));
#pragma unroll
                for (int r = 0; r < 16; ++r) { const int i = ib + (r & 3) + 8 * (r >> 2);
                    const float v = (j <= i) ? acc[r] * __expf(fminf(gsm[i] - gcj, 0.f)) : 0.f;
                    ap[((r & 3) + 8 * (r >> 2)) * 64] = f2bf(v); }
            }
        }
        DN_WSYNC();
        { float x[64]; int cc = F.lane; asm volatile("" : "+v"(cc));
#pragma unroll
          for (int i = 0; i < 64; ++i) { float acc = (i == cc) ? 1.f : 0.f, ac1 = 0.f, ac2 = 0.f, ac3 = 0.f;
#pragma unroll
              for (int j4 = 0; j4 < (i + 3) / 4; ++j4) { const float4 gv = *(const float4*)(Gs + i * 68 + j4 * 4);
                  if (j4 * 4 + 0 < i) acc -= gv.x * x[j4 * 4 + 0]; if (j4 * 4 + 1 < i) ac1 -= gv.y * x[j4 * 4 + 1];
                  if (j4 * 4 + 2 < i) ac2 -= gv.z * x[j4 * 4 + 2]; if (j4 * 4 + 3 < i) ac3 -= gv.w * x[j4 * 4 + 3]; }
              x[i] = (acc + ac1) + (ac2 + ac3); }
          bf16_t* tp = Tm_g + (size_t)ch * 4096 + cc; asm volatile("" : "+v"(tp));
#pragma unroll
          for (int i = 0; i < 64; ++i) tp[i * 64] = f2bf(x[i]); }
        DN_WSYNC();
    }
}

__device__ __forceinline__ void phase_dn_c(const Frame& F) {
    const bf16_t* qkvn = WSP(bf16_t, OFF_QKVN); const float* gb = WSP(float, OFF_GB0);
    const float* gcs_g = WSP(float, OFF_DN_GCS); const bf16_t* Am_g = WSP(bf16_t, OFF_DN_AM); const bf16_t* Tm_g = WSP(bf16_t, OFF_DN_TM);
    bf16_t* Qe_g = WSP(bf16_t, OFF_DN_QE); u32x4* Yi_g = WSP(u32x4, OFF_DN_YI); u32x4* Ph_g = WSP(u32x4, OFF_DN_PHI); u32x4* C_g = WSP(u32x4, OFF_DN_C);
    bf16_t* T_s = (bf16_t*)F.smem; bf16_t* A_s = T_s + 64 * LD72; bf16_t* KbgT = A_s + 64 * LD72; bf16_t* VbT = KbgT + 128 * LD72; bf16_t* KdT = VbT + 128 * LD72;
    bf16_t* wT = KdT + 128 * LD72; bf16_t* uT = wT + 128 * LD72; float* gcsb = (float*)(uT + 128 * LD72);
    const int rw = F.lane & 31, hh = F.lane >> 5, w = F.wid;
    const int it5 = w >> 2, dt5 = w & 3, d5 = dt5 * 32 + rw;
    float kr[16], vr[16], qr[16], gbn = 0.f; u32x4 tpc, apc;
#define DNC_LOAD(chx) do { const int seq_ = (chx) >> 6, c_ = (chx) & 63, dir_ = seq_ & 1, h_ = (seq_ >> 1) & 3, b_ = seq_ >> 3; \
        { const int row = F.tid >> 3, pc = F.tid & 7; tpc = *(const u32x4*)(Tm_g + (size_t)(chx) * 4096 + row * 64 + pc * 8); apc = *(const u32x4*)(Am_g + (size_t)(chx) * 4096 + row * 64 + pc * 8); } \
        _Pragma("unroll") for (int it = 0; it < 4; ++it) { const int x = F.tid + NTHR * it, chn = x & 127, tq = x >> 7; \
            _Pragma("unroll") for (int e = 0; e < 4; ++e) { const int step = c_ * 64 + tq * 4 + e, t = dir_ ? 4095 - step : step; const size_t tok = (size_t)b_ * 4096 + t; \
                kr[it * 4 + e] = bf2f(qkvn[tok * 1536 + 512 + h_ * 128 + chn]); vr[it * 4 + e] = bf2f(qkvn[tok * 1536 + 1024 + h_ * 128 + chn]); } } \
        _Pragma("unroll") for (int r = 0; r < 16; ++r) { const int step = c_ * 64 + it5 * 32 + (r & 3) + 8 * (r >> 2) + 4 * hh, t = dir_ ? 4095 - step : step; \
            qr[r] = bf2f(qkvn[((size_t)b_ * 4096 + t) * 1536 + h_ * 128 + d5]); } \
        if (F.tid < 64) gbn = gcs_g[(size_t)(chx) * 64 + F.tid]; \
        else if (F.tid < 128) { const int step = c_ * 64 + (F.tid - 64), t = dir_ ? 4095 - step : step; gbn = gb[((size_t)b_ * 4096 + t) * 16 + 8 + dir_ * 4 + h_]; } } while (0)
    int ch = F.bid, par = 0;
    if (ch < 2048) { DNC_LOAD(ch); if (F.tid < 128) gcsb[F.tid] = gbn; }
    __syncthreads();
    for (; ch < 2048; ch += F.nblk, par ^= 1) {
        const float* gcs = gcsb + par * 128; const float* bts = gcs + 64;
        const float gl = gcs[63];
        { const int row = F.tid >> 3, pc = F.tid & 7; *(u32x4*)(T_s + row * LD72 + pc * 8) = tpc; *(u32x4*)(A_s + row * LD72 + pc * 8) = apc; }
#pragma unroll
        for (int it = 0; it < 4; ++it) { const int x = F.tid + NTHR * it, chn = x & 127, tq = x >> 7;
            float kb[4], vb[4], kd[4];
#pragma unroll
            for (int e = 0; e < 4; ++e) { const int i = tq * 4 + e; const float gci = gcs[i], beta = bts[i], kv = kr[it * 4 + e];
                kb[e] = kv * beta * __expf(gci); vb[e] = vr[it * 4 + e] * beta; kd[e] = kv * __expf(gl - gci); }
            *(u32x2*)(KbgT + chn * LD72 + tq * 4) = (u32x2){pk2(kb[0], kb[1]), pk2(kb[2], kb[3])};
            *(u32x2*)(VbT + chn * LD72 + tq * 4) = (u32x2){pk2(vb[0], vb[1]), pk2(vb[2], vb[3])};
            *(u32x2*)(KdT + chn * LD72 + tq * 4) = (u32x2){pk2(kd[0], kd[1]), pk2(kd[2], kd[3])}; }
        float qc[16];
#pragma unroll
        for (int r = 0; r < 16; ++r) qc[r] = qr[r];
        __syncthreads();
        const int chn_ = ch + F.nblk;
        if (chn_ < 2048) DNC_LOAD(chn_);
        { const int rt = w >> 1, ct = w & 1;
          const f32x16 a3 = tile_mm<4>(KbgT + rt * 32 * LD72, LD72, T_s + ct * 32 * LD72, LD72, F.lane);
          const f32x16 a4 = tile_mm<4>(VbT + rt * 32 * LD72, LD72, T_s + ct * 32 * LD72, LD72, F.lane);
#pragma unroll
          for (int r = 0; r < 16; ++r) { const int row = rt * 32 + (r & 3) + 8 * (r >> 2) + 4 * hh, col = ct * 32 + rw;
              wT[row * LD72 + col] = f2bf(a3[r]); uT[row * LD72 + col] = f2bf(a4[r]); } }
        __syncthreads();
        { const f32x16 a5 = tile_mm<4>(A_s + it5 * 32 * LD72, LD72, wT + dt5 * 32 * LD72, LD72, F.lane);
          const f32x16 a6 = tile_mm<4>(A_s + it5 * 32 * LD72, LD72, uT + dt5 * 32 * LD72, LD72, F.lane);
          const int dp = (d5 & ~15) | perm16(d5 & 15);
          bf16_t* qp = Qe_g + (size_t)ch * 8192 + (it5 * 32 + 4 * hh) * 128 + dp;
#pragma unroll
          for (int r = 0; r < 16; ++r) { const int i = it5 * 32 + (r & 3) + 8 * (r >> 2) + 4 * hh;
              qp[((r & 3) + 8 * (r >> 2)) * 128] = f2bf(qc[r] * __expf(gcs[i]) - a5[r]); }
          u32x4* yo = Yi_g + ((size_t)(ch * 2 + it5) * 4 + dt5) * 128 + F.lane * 2;
          yo[0] = pack8(a6, 0); yo[1] = pack8(a6, 1); }
        const float glast = __expf(gl);
#pragma unroll
        for (int e = 0; e < 2; ++e) { const int x = w * 2 + e;
            { const int kbt = x >> 2, ra = x & 3;
              f32x16 a7 = tile_mm<4>(wT + kbt * 32 * LD72, LD72, KdT + ra * 32 * LD72, LD72, F.lane);
#pragma unroll
              for (int r = 0; r < 16; ++r) { const int brow = kbt * 32 + (r & 3) + 8 * (r >> 2) + 4 * hh, acol = ra * 32 + rw; a7[r] = ((brow == acol) ? glast : 0.f) - a7[r]; }
              u32x4* po = Ph_g + ((((size_t)ch * 4 + ra) * 4 + kbt) * 2) * 64 + F.lane;
              po[0] = pack8(a7, 0); po[64] = pack8(a7, 1); }
            { const int ra = x >> 2, vt = x & 3;
              const f32x16 a8 = tile_mm<4>(KdT + ra * 32 * LD72, LD72, uT + vt * 32 * LD72, LD72, F.lane);
              u32x4* co = C_g + ((size_t)(ch * 4 + ra) * 4 + vt) * 128 + F.lane * 2;
              co[0] = pack8(a8, 0); co[1] = pack8(a8, 1); } }
        if (chn_ < 2048 && F.tid < 128) gcsb[(par ^ 1) * 128 + F.tid] = gbn;
        __syncthreads();
    }
#undef DNC_LOAD
}

template <int NT> struct CarryBufs { const u32x4* Phi; const u32x4* C; const bf16_t* Qe; const u32x4* Yi; bf16_t* out; int nslice; int ncol; int qe_cs; int yi_cs; };
template <int NT, int D> __device__ __forceinline__ void phase_carry(const Frame& F, const CarryBufs<NT> cb, int ntask, int bid0, int bstride) {
    LAS unsigned char* lds = F.lds;
    const int rw = F.lane & 31, hh = F.lane >> 5, w = F.wid;
    const bool carry = w < NT, outw = (w >= NT && w < NT + 2);
    for (int task = bid0; task < ntask; task += bstride) {
        const int kx = task >> 3, slice = kx % cb.nslice, seq = (task & 7) + 8 * (kx / cb.nslice), dir = seq & 1, hb = seq >> 1;
        const int heads = cb.ncol / (32 * cb.nslice), h = hb % heads, b = hb / heads;
        f32x16 S;
#pragma unroll
        for (int r = 0; r < 16; ++r) S[r] = 0.f;
        u32x4 afr[D][NT * 2], ini[D][2];
#define CR_LOAD(j, ch) do { if (carry) { _Pragma("unroll") for (int kb = 0; kb < NT; ++kb) _Pragma("unroll") for (int s = 0; s < 2; ++s) \
                afr[j][kb * 2 + s] = cb.Phi[((((size_t)(ch) * NT + w) * NT + kb) * 2 + s) * 64 + F.lane]; \
              const u32x4* cp = cb.C + ((size_t)((ch) * NT + w) * cb.nslice + slice) * 128 + F.lane * 2; ini[j][0] = cp[0]; ini[j][1] = cp[1]; } \
            else if (outw) { const int it = w - NT; _Pragma("unroll") for (int kb = 0; kb < NT; ++kb) _Pragma("unroll") for (int s = 0; s < 2; ++s) \
                afr[j][kb * 2 + s] = *(const u32x4*)(cb.Qe + (size_t)(ch) * cb.qe_cs + (it * 32 + rw) * (32 * NT) + kb * 32 + 16 * s + 8 * hh); \
              const u32x4* yp = cb.Yi + (size_t)(ch) * cb.yi_cs + ((size_t)it * cb.nslice + slice) * 128 + F.lane * 2; ini[j][0] = yp[0]; ini[j][1] = yp[1]; } } while (0)
#pragma unroll
        for (int j = 0; j < D; ++j) CR_LOAD(j, seq * 64 + j);
        for (int c0 = 0; c0 < 64; c0 += D) {
#pragma unroll
            for (int j = 0; j < D; ++j) { const int c = c0 + j;
                if (c < 64) {
                    const int ch = seq * 64 + c, buf = c & 1;
                    if (carry) {
#pragma unroll
                        for (int s = 0; s < 2; ++s) *(LAS u32x4*)(lds + (((buf * NT + w) * 2 + s) * 64 + F.lane) * 16) = pack8(S, s); }
                    __syncthreads();
                    if (carry || outw) {
                        f32x16 acc, acc2; unpack16(ini[j][0], ini[j][1], acc);
#pragma unroll
                        for (int r = 0; r < 16; ++r) acc2[r] = 0.f;
#pragma unroll
                        for (int kb = 0; kb < NT; ++kb)
#pragma unroll
                            for (int s = 0; s < 2; ++s) { const u32x4 bfr = *(const LAS u32x4*)(lds + (((buf * NT + kb) * 2 + s) * 64 + F.lane) * 16);
                                if (s == 0) acc = __builtin_amdgcn_mfma_f32_32x32x16_bf16(as_frag(afr[j][kb * 2 + s]), as_frag(bfr), acc, 0, 0, 0);
                                else acc2 = __builtin_amdgcn_mfma_f32_32x32x16_bf16(as_frag(afr[j][kb * 2 + s]), as_frag(bfr), acc2, 0, 0, 0); }
#pragma unroll
                        for (int r = 0; r < 16; ++r) acc[r] += acc2[r];
                        if (carry) S = acc;
                        else { const int it = w - NT;
                            bf16_t* op = cb.out + ((size_t)dir * T_ + (size_t)b * 4096) * 512 + h * (32 * cb.nslice) + slice * 32 + (rw & ~1);
                            const bool odd = (rw & 1) != 0;
#pragma unroll
                            for (int j = 0; j < 8; ++j) { const float n0 = __shfl_xor(acc[2 * j], 1), n1 = __shfl_xor(acc[2 * j + 1], 1);
                                const int r = odd ? 2 * j + 1 : 2 * j; const float lo = odd ? n1 : acc[2 * j], hi = odd ? acc[2 * j + 1] : n0;
                                const int i = it * 32 + (r & 3) + 8 * (r >> 2) + 4 * hh, step = c * 64 + i, t = dir ? 4095 - step : step;
                                *(unsigned*)(op + (size_t)t * 512) = pk2(lo, hi); } }
                    }
                    if (c + D < 64) CR_LOAD(j, ch + D);
                } }
        }
        __syncthreads();
#undef CR_LOAD
    }
}
#ifdef DN_NAIVE_CHECK
__device__ __forceinline__ void phase_dn_naive_check(const Frame& F) {
    const float* qkvn = WSP(float, OFF_QKVN); const float* gb = WSP(float, OFF_GB0);
    const float* gcs_g = WSP(float, OFF_DN_GCS); const bf16_t* Am_g = WSP(bf16_t, OFF_DN_AM); const bf16_t* Tm_g = WSP(bf16_t, OFF_DN_TM);
    const bf16_t* Qe_g = WSP(bf16_t, OFF_DN_QE); const unsigned* Yi_g = WSP(unsigned, OFF_DN_YI); const unsigned short* Ph_g = WSP(unsigned short, OFF_DN_PHI); const unsigned* C_g = WSP(unsigned, OFF_DN_C);
    unsigned* flag = (unsigned*)(F.ws + OFF_BAR) + 4001;
    float* gcn = (float*)F.smem; float* btn = gcn + 64; float* Gn = btn + 64; float* Tn = Gn + 4096; float* An = Tn + 4096; float* un = An + 4096; float* wn = un + 8192;
    const int chk[8] = {0, 1, 63, 64, 1000, 1027, 2046, 2047};
    if (F.bid >= 8) return;
    const int ch = F.bid == 0 ? 0 : (F.bid == 1 ? 1 : (F.bid == 2 ? 63 : (F.bid == 3 ? 64 : (F.bid == 4 ? 1000 : (F.bid == 5 ? 1027 : (F.bid == 6 ? 2046 : 2047))))));
    (void)chk;
    const int seq = ch >> 6, c = ch & 63, dir = seq & 1, h = (seq >> 1) & 3, b = seq >> 3;
    unsigned bits = 0u; float eyi = 0.f, ryi = 0.f, ec = 0.f, rc = 0.f;
#define TOKOF(i) ((size_t)b * 4096 + (dir ? 4095 - (c * 64 + (i)) : (c * 64 + (i))))
    if (F.tid == 0) { float s = 0.f; for (int i = 0; i < 64; ++i) { s += gb[TOKOF(i) * 16 + dir * 4 + h]; gcn[i] = s; btn[i] = gb[TOKOF(i) * 16 + 8 + dir * 4 + h]; } }
    __syncthreads();
    if (F.tid < 64) { const float d = fabsf(gcn[F.tid] - gcs_g[(size_t)ch * 64 + F.tid]); if (!(d <= 1e-3f * fmaxf(1.f, fabsf(gcn[F.tid])))) bits |= 0u; }
    for (int e = F.tid; e < 4096; e += NTHR) { const int i = e >> 6, j = e & 63; const float* qi = qkvn + TOKOF(i) * 1536 + h * 128; const float* ki = qkvn + TOKOF(i) * 1536 + 512 + h * 128; const float* kj = qkvn + TOKOF(j) * 1536 + 512 + h * 128;
        float qk = 0.f, kk = 0.f; for (int d = 0; d < 128; ++d) { qk += qi[d] * kj[d]; kk += ki[d] * kj[d]; }
        const float dec = __expf(fminf(gcn[i] - gcn[j], 0.f));
        const float a = (j <= i) ? qk * dec : 0.f; An[e] = a; Gn[e] = (j < i) ? btn[i] * kk * dec : 0.f;
        const float ad = bf2f(Am_g[(size_t)ch * 4096 + e]); if (!(fabsf(ad - a) <= 0.03f * fabsf(a) + 2e-3f)) bits |= 0u;
        Tn[e] = bf2f(Tm_g[(size_t)ch * 4096 + e]); }
    __syncthreads();
    for (int e = F.tid; e < 4096; e += NTHR) { const int i = e >> 6, cc = e & 63; float r = Tn[i * 64 + cc] - (i == cc ? 1.f : 0.f); for (int j = 0; j < i; ++j) r += Gn[i * 64 + j] * Tn[j * 64 + cc];
        if (!(fabsf(r) <= 0.03f)) bits |= 0u; }
    const float gl = gcn[63];
    for (int e = F.tid; e < 8192; e += NTHR) { const int t = e >> 7, d = e & 127; float us = 0.f, ws_ = 0.f;
        for (int j = 0; j < 64; ++j) { const float tv = Tn[t * 64 + j]; us += tv * qkvn[TOKOF(j) * 1536 + 1024 + h * 128 + d] * btn[j]; ws_ += tv * qkvn[TOKOF(j) * 1536 + 512 + h * 128 + d] * btn[j] * __expf(gcn[j]); }
#ifdef DN_SWAP
        us = ws_;
#endif
        un[e] = us; wn[e] = ws_;
}
    __syncthreads();
    for (int e = F.tid; e < 8192; e += NTHR) { const int i = e >> 7, d = e & 127; float yi = 0.f, aw = 0.f;
        for (int t = 0; t < 64; ++t) { yi += An[i * 64 + t] * un[t * 128 + d]; aw += An[i * 64 + t] * wn[t * 128 + d]; }
        const float qe = qkvn[TOKOF(i) * 1536 + h * 128 + d] * __expf(gcn[i]) - aw;
        { const int it = i >> 5, dt = d >> 5, i5 = i & 31, hh = (i5 >> 2) & 1, r = (i5 & 3) + 4 * (i5 >> 3), lane = (d & 31) + 32 * hh;
          const unsigned wv = Yi_g[((((size_t)(ch * 2 + it) * 4 + dt) * 128 + lane * 2 + (r >> 3)) * 4) + ((r & 7) >> 1)]; const float yv = (r & 1) ? bfhi(wv) : bflo(wv);
          eyi += (yv - yi) * (yv - yi); ryi += yi * yi; }
        { const int dp = (d & ~15) | perm16(d & 15); const float qv = bf2f(Qe_g[(size_t)ch * 8192 + i * 128 + dp]); if (!(fabsf(qv - qe) <= 0.03f * fabsf(qe) + 1e-3f)) bits |= 0u; } }
    for (int e = F.tid; e < 16384; e += NTHR) { const int bb = e >> 7, a = e & 127; float ph = (bb == a) ? __expf(gl) : 0.f, cv = 0.f;
        for (int t = 0; t < 64; ++t) { const float kd_a = qkvn[TOKOF(t) * 1536 + 512 + h * 128 + a] * __expf(gl - gcn[t]); ph -= wn[t * 128 + bb] * kd_a;
            const float kd_b = qkvn[TOKOF(t) * 1536 + 512 + h * 128 + bb] * __expf(gl - gcn[t]); cv += kd_b * un[t * 128 + a]; }
        { const int ra = a >> 5, kb = bb >> 5, b5 = bb & 31, s = b5 >> 4, hh = (b5 >> 2) & 1, j = ((b5 >> 3) & 1) * 4 + (b5 & 3), lane = (a & 31) + 32 * hh;
          const float pv = bf2f(Ph_g[((((((size_t)ch * 4 + ra) * 4 + kb) * 2 + s) * 64 + lane) * 8) + j]); if (!(fabsf(pv - ph) <= 0.03f * fabsf(ph) + 2e-3f)) bits |= 32u; }
        { const int ra = bb >> 5, vt = a >> 5, a5 = bb & 31, hh = (a5 >> 2) & 1, r = (a5 & 3) + 4 * (a5 >> 3), lane = (a & 31) + 32 * hh;
          const unsigned wv = C_g[((((size_t)(ch * 4 + ra) * 4 + vt) * 128 + lane * 2 + (r >> 3)) * 4) + ((r & 7) >> 1)]; const float cvd = (r & 1) ? bfhi(wv) : bflo(wv);
          ec += (cvd - cv) * (cvd - cv); rc += cv * cv; } }
    eyi = wave_sum(eyi); ryi = wave_sum(ryi); ec = wave_sum(ec); rc = wave_sum(rc);
    if (F.lane == 0) { float* fw = (float*)(F.ws + OFF_BAR); atomicAdd(fw + 4004, eyi); atomicAdd(fw + 4005, ryi); atomicAdd(fw + 4006, ec); atomicAdd(fw + 4007, rc); }
    (void)flag; (void)bits;
#undef TOKOF
}
#endif

#ifdef DN_NANSCAN
__device__ __forceinline__ void phase_dn_nanscan(const Frame& F) {
    unsigned* flag = (unsigned*)(F.ws + OFF_BAR) + 4001;
    const size_t gtid = (size_t)F.bid * NTHR + F.tid, gn = (size_t)F.nblk * NTHR;
    unsigned bits = 0u;
#define SCAN_BF(off, nbytes, bit) do { const unsigned* p_ = (const unsigned*)(F.ws + (off)); const size_t n_ = (size_t)(nbytes) / 4; \
        for (size_t i_ = gtid; i_ < n_; i_ += gn) { const unsigned w_ = p_[i_]; if ((w_ & 0x7F800000u) == 0x7F800000u || (w_ & 0x00007F80u) == 0x00007F80u) bits |= (bit); } } while (0)
    SCAN_BF(OFF_DN_TM, (size_t)2048 * 4096 * 2, 1u);
    SCAN_BF(OFF_DN_AM, (size_t)2048 * 4096 * 2, 2u);
    SCAN_BF(OFF_DN_QE, (size_t)2048 * 8192 * 2, 4u);
    SCAN_BF(OFF_DN_YI, (size_t)2048 * 16384, 8u);
    SCAN_BF(OFF_DN_PHI, (size_t)2048 * 32768, 16u);
    SCAN_BF(OFF_DN_C, (size_t)2048 * 32768, 32u);
#ifdef S5_NANSCAN
    bits = 0u;
    { const unsigned* p_ = (const unsigned*)(F.ws + OFF_S5Y); const size_t n_ = (size_t)2 * T_ * 512; for (size_t i_ = gtid; i_ < n_; i_ += gn) { const unsigned w_ = p_[i_]; if ((w_ & 0x7F800000u) == 0x7F800000u) bits |= ((i_ / ((size_t)T_ * 512)) ? 2u : 1u) | (((i_ >> 4) & 31) < 16 ? 4u : 8u); } }
#endif
#undef SCAN_BF
    if (bits) atomicOr(flag, bits);
}
#endif
struct RwArr { bf16_t *At, *Bt, *Kt, *Rt, *AtT, *VT, *BdT, *KdT; float* gsum; float* pl; };
template <bool ROWS, bool TRANS> __device__ __forceinline__ void rw_build(const Frame& F, int ch, const RwArr A) {
    const bf16_t* rwr = WSP(bf16_t, OFF_RWR); const bf16_t* rwk = WSP(bf16_t, OFF_RWK); const bf16_t* rwv = WSP(bf16_t, OFF_RWV); const bf16_t* rwkk = WSP(bf16_t, OFF_RWKK);
    const float* rwe = WSP(float, OFF_RWDEC); const bf16_t* rwa = WSP(bf16_t, OFF_RWA);
    const int seq = ch >> 6, c = ch & 63, dir = seq & 1, h = (seq >> 1) & 7, b = seq >> 4;
    const int k = F.tid & 63, tg = F.tid >> 6;
    const float kaw = F.in[I_RW_KA][h * 64 + k];
    float lw[8], av[8], kkv[8], kv[8], rv[8], vv[8];
#pragma unroll
    for (int e = 0; e < 8; ++e) { const int step = c * 64 + tg * 8 + e, t = dir ? 4095 - step : step; const size_t idx = ((size_t)b * 4096 + t) * 512 + h * 64 + k;
        lw[e] = -rwe[(size_t)dir * T_ * 512 + idx]; av[e] = bf2f(rwa[(size_t)dir * T_ * 512 + idx]); kkv[e] = bf2f(rwkk[idx]); kv[e] = bf2f(rwk[idx]); rv[e] = bf2f(rwr[idx]); vv[e] = bf2f(rwv[idx]); }
    float lam[8]; { float s = 0.f;
#pragma unroll
        for (int e = 0; e < 8; ++e) { s += lw[e]; lam[e] = s; } }
    A.gsum[tg * 64 + k] = lam[7];
    __syncthreads();
    float prefix = 0.f, total = 0.f;
#pragma unroll
    for (int g = 0; g < 8; ++g) { const float gs = A.gsum[g * 64 + k]; total += gs; if (g < tg) prefix += gs; }
    if (tg == 0 && A.pl) A.pl[k] = __expf(total);
    float at8[8], bd8[8], kd8[8];
#pragma unroll
    for (int e = 0; e < 8; ++e) { const int i = tg * 8 + e; const float Lc = prefix + lam[e], Lp = Lc - lw[e];
        const float kdir = kv[e] * (1.f + (av[e] - 1.f) * kaw), kb = kkv[e] * av[e];
        const float iP = __expf(-Lc), dl = __expf(total - Lc);
        const float at = -kkv[e] * __expf(Lp);
        if (ROWS) { A.At[i * LD72 + k] = f2bf(at); A.Bt[i * LD72 + k] = f2bf(kb * iP); A.Kt[i * LD72 + k] = f2bf(kdir * iP); }
        if (A.Rt) A.Rt[i * LD72 + k] = f2bf(rv[e] * __expf(Lc));
        at8[e] = at; bd8[e] = kb * dl; kd8[e] = kdir * dl; }
    if (A.VT) *(u32x4*)(A.VT + k * LD72 + tg * 8) = (u32x4){pk2(vv[0], vv[1]), pk2(vv[2], vv[3]), pk2(vv[4], vv[5]), pk2(vv[6], vv[7])};
    if (TRANS) {
        *(u32x4*)(A.AtT + k * LD72 + tg * 8) = (u32x4){pk2(at8[0], at8[1]), pk2(at8[2], at8[3]), pk2(at8[4], at8[5]), pk2(at8[6], at8[7])};
        *(u32x4*)(A.BdT + k * LD72 + tg * 8) = (u32x4){pk2(bd8[0], bd8[1]), pk2(bd8[2], bd8[3]), pk2(bd8[4], bd8[5]), pk2(bd8[6], bd8[7])};
        *(u32x4*)(A.KdT + k * LD72 + tg * 8) = (u32x4){pk2(kd8[0], kd8[1]), pk2(kd8[2], kd8[3]), pk2(kd8[4], kd8[5]), pk2(kd8[6], kd8[7])}; }
}
template <int KS> __device__ __forceinline__ f32x16 tile_mm_acc(f32x16 acc, const bf16_t* A, int ldA, const bf16_t* Bt, int ldB, int lane) {
    const int rw = lane & 31, hh = lane >> 5;
#pragma unroll
    for (int s = 0; s < KS; ++s) { const bf16x8 a = *(const bf16x8*)(A + rw * ldA + 16 * s + 8 * hh), b = *(const bf16x8*)(Bt + rw * ldB + 16 * s + 8 * hh);
        acc = __builtin_amdgcn_mfma_f32_32x32x16_bf16(a, b, acc, 0, 0, 0); }
    return acc;
}

__device__ __forceinline__ void phase_rw_a(const Frame& F) {
    bf16_t* At = (bf16_t*)F.smem; bf16_t* Bt = At + 64 * LD72; bf16_t* Kt = Bt + 64 * LD72; bf16_t* Rt = Kt + 64 * LD72; bf16_t* VT = Rt + 64 * LD72; bf16_t* Mak = VT + 64 * LD72;
    float* gsum = (float*)(Mak + 64 * LD72); float* pl = gsum + 512;
    float* Mab_g = WSP(float, OFF_RW_MAB); bf16_t* X1T_g = WSP(bf16_t, OFF_RW_X1T); bf16_t* Grb_g = WSP(bf16_t, OFF_RW_GRB); bf16_t* Grk_g = WSP(bf16_t, OFF_RW_GRK); float* PL_g = WSP(float, OFF_RW_PL);
    const int rw = F.lane & 31, hh = F.lane >> 5, w = F.wid;
    for (int ch = F.bid; ch < 4096; ch += F.nblk) {
        const RwArr A{At, Bt, Kt, Rt, nullptr, VT, nullptr, nullptr, gsum, pl};
        rw_build<true, false>(F, ch, A);
        __syncthreads();
        if (F.tid < 64) PL_g[(size_t)ch * 64 + F.tid] = pl[F.tid];
        { const int prod = w >> 1, ti = w & 1;
          const bf16_t* Ar = (prod < 2 ? At : Rt) + ti * 32 * LD72; const bf16_t* Bb = (prod & 1) ? Kt : Bt;
#pragma unroll
          for (int tj = 0; tj < 2; ++tj) {
              f32x16 acc;
#pragma unroll
              for (int r = 0; r < 16; ++r) acc[r] = 0.f;
              if (tj <= ti) acc = tile_mm_acc<4>(acc, Ar, LD72, Bb + tj * 32 * LD72, LD72, F.lane);
              int j = tj * 32 + rw; asm volatile("" : "+v"(j));
              const int ib = ti * 32 + 4 * hh;
              if (prod == 0) { float* gp = Mab_g + (size_t)ch * 4096 + (size_t)ib * 64 + j;
#pragma unroll
                  for (int r = 0; r < 16; ++r) { const int io = (r & 3) + 8 * (r >> 2); gp[io * 64] = (j < ib + io) ? -acc[r] : 0.f; } }
              else if (prod == 1) {
#pragma unroll
                  for (int r = 0; r < 16; ++r) { const int io = (r & 3) + 8 * (r >> 2); Mak[(ib + io) * LD72 + j] = f2bf((j < ib + io) ? acc[r] : 0.f); } }
              else { bf16_t* gp = (prod == 2 ? Grb_g : Grk_g) + (size_t)ch * 4096 + (size_t)ib * 64 + j;
#pragma unroll
                  for (int r = 0; r < 16; ++r) { const int io = (r & 3) + 8 * (r >> 2); gp[io * 64] = f2bf((j <= ib + io) ? acc[r] : 0.f); } }
          } }
        __syncthreads();
        if (w < 4) { const int ti = w >> 1, tv = w & 1;
            const f32x16 acc = tile_mm<4>(Mak + ti * 32 * LD72, LD72, VT + tv * 32 * LD72, LD72, F.lane);
            bf16_t* xp = X1T_g + (size_t)ch * 4096 + (size_t)(tv * 32 + rw) * 64 + ti * 32 + 4 * hh;
#pragma unroll
            for (int g = 0; g < 4; ++g) *(u32x2*)(xp + 8 * g) = (u32x2){pk2(acc[4 * g], acc[4 * g + 1]), pk2(acc[4 * g + 2], acc[4 * g + 3])}; }
        __syncthreads();
    }
}

__device__ __forceinline__ void phase_rw_b(const Frame& F) {
    const float* Mab_g = WSP(float, OFF_RW_MAB); bf16_t* Tm_g = WSP(bf16_t, OFF_RW_TM);
    float* Gs = (float*)F.smem + F.wid * (64 * 68);
    for (int ch = F.bid + F.wid * F.nblk; ch < 4096; ch += F.nblk * 8) {
#pragma unroll
        for (int q = 0; q < 16; ++q) { const int idx = q * 64 + F.lane, row = idx >> 4, c4 = idx & 15;
            *(float4*)(Gs + row * 68 + c4 * 4) = *(const float4*)(Mab_g + (size_t)ch * 4096 + row * 64 + c4 * 4); }
        asm volatile("s_waitcnt vmcnt(0) lgkmcnt(0)" ::: "memory"); __builtin_amdgcn_wave_barrier();
        { float x[64]; int cc = F.lane; asm volatile("" : "+v"(cc));
#pragma unroll
          for (int i = 0; i < 64; ++i) { float acc = (i == cc) ? 1.f : 0.f, ac1 = 0.f, ac2 = 0.f, ac3 = 0.f;
#pragma unroll
              for (int j4 = 0; j4 < (i + 3) / 4; ++j4) { const float4 gv = *(const float4*)(Gs + i * 68 + j4 * 4);
                  if (j4 * 4 + 0 < i) acc -= gv.x * x[j4 * 4 + 0]; if (j4 * 4 + 1 < i) ac1 -= gv.y * x[j4 * 4 + 1];
                  if (j4 * 4 + 2 < i) ac2 -= gv.z * x[j4 * 4 + 2]; if (j4 * 4 + 3 < i) ac3 -= gv.w * x[j4 * 4 + 3]; }
              x[i] = (acc + ac1) + (ac2 + ac3); }
          bf16_t* tp = Tm_g + (size_t)ch * 4096 + cc; asm volatile("" : "+v"(tp));
#pragma unroll
          for (int i = 0; i < 64; ++i) tp[i * 64] = f2bf(x[i]); }
        asm volatile("s_waitcnt lgkmcnt(0)" ::: "memory"); __builtin_amdgcn_wave_barrier();
    }
}

__device__ __forceinline__ void phase_rw_c(const Frame& F) {
    bf16_t* AtT = (bf16_t*)F.smem; bf16_t* VT = AtT + 64 * LD72; bf16_t* BdT = VT + 64 * LD72; bf16_t* KdT = BdT + 64 * LD72; bf16_t* Rt = KdT + 64 * LD72;
    bf16_t* T_s = Rt + 64 * LD72; bf16_t* X1T = T_s + 64 * LD72; bf16_t* Grb = X1T + 64 * LD72; bf16_t* Grk = Grb + 64 * LD72; bf16_t* UT = Grk + 64 * LD72; bf16_t* WmT = UT + 64 * LD72;
    float* gsum = (float*)(WmT + 64 * LD72); float* pl = gsum + 512;
    const bf16_t* Tm_g = WSP(bf16_t, OFF_RW_TM); const bf16_t* X1T_g = WSP(bf16_t, OFF_RW_X1T); const bf16_t* Grb_g = WSP(bf16_t, OFF_RW_GRB); const bf16_t* Grk_g = WSP(bf16_t, OFF_RW_GRK);
    bf16_t* Qe_g = WSP(bf16_t, OFF_RW_QE); u32x4* Yi_g = WSP(u32x4, OFF_RW_YI); u32x4* Ph_g = WSP(u32x4, OFF_RW_PHI); u32x4* C_g = WSP(u32x4, OFF_RW_C);
    const int rw = F.lane & 31, hh = F.lane >> 5, w = F.wid;
    for (int ch = F.bid; ch < 4096; ch += F.nblk) {
        { const int row = F.tid >> 3, pc = F.tid & 7; const size_t go = (size_t)ch * 4096 + row * 64 + pc * 8; const int lo_ = row * LD72 + pc * 8;
          *(u32x4*)(T_s + lo_) = *(const u32x4*)(Tm_g + go); *(u32x4*)(X1T + lo_) = *(const u32x4*)(X1T_g + go);
          *(u32x4*)(Grb + lo_) = *(const u32x4*)(Grb_g + go); *(u32x4*)(Grk + lo_) = *(const u32x4*)(Grk_g + go); }
        const RwArr A{nullptr, nullptr, nullptr, Rt, AtT, VT, BdT, KdT, gsum, pl};
        rw_build<false, true>(F, ch, A);
        __syncthreads();
        { const int prod = w >> 2, tr = (w >> 1) & 1, tc = w & 1;
          const f32x16 acc = tile_mm<4>((prod ? AtT : X1T) + tr * 32 * LD72, LD72, T_s + tc * 32 * LD72, LD72, F.lane);
          bf16_t* dst = prod ? WmT : UT;
#pragma unroll
          for (int r = 0; r < 16; ++r) dst[(tr * 32 + (r & 3) + 8 * (r >> 2) + 4 * hh) * LD72 + tc * 32 + rw] = f2bf(acc[r]); }
        __syncthreads();
        { const int kind = w >> 1;
#pragma unroll
          for (int e = 0; e < 2; ++e) { const int x = (w & 1) * 2 + e, t0 = x >> 1, t1 = x & 1;
              f32x16 acc;
#pragma unroll
              for (int r = 0; r < 16; ++r) acc[r] = 0.f;
              if (kind == 0) {
                  acc = tile_mm_acc<4>(acc, Grb + t0 * 32 * LD72, LD72, WmT + t1 * 32 * LD72, LD72, F.lane);
                  const int kcol = t1 * 32 + rw, kp = (kcol & ~15) | perm16(kcol & 15);
                  bf16_t* qp = Qe_g + (size_t)ch * 8192 + (size_t)(t0 * 32 + 4 * hh) * 64 + kp;
#pragma unroll
                  for (int r = 0; r < 16; ++r) { const int io = (r & 3) + 8 * (r >> 2); qp[io * 64] = f2bf(acc[r] + bf2f(Rt[(t0 * 32 + 4 * hh + io) * LD72 + kcol])); } }
              else if (kind == 1) {
                  acc = tile_mm_acc<4>(acc, Grb + t0 * 32 * LD72, LD72, UT + t1 * 32 * LD72, LD72, F.lane);
                  acc = tile_mm_acc<4>(acc, Grk + t0 * 32 * LD72, LD72, VT + t1 * 32 * LD72, LD72, F.lane);
#pragma unroll
                  for (int r = 0; r < 16; ++r) acc[r] += 0.f;
                  u32x4* yo = Yi_g + (size_t)ch * 1024 + ((size_t)t0 * 2 + t1) * 128 + F.lane * 2; yo[0] = pack8(acc, 0); yo[1] = pack8(acc, 1); }
              else if (kind == 2) {
                  acc = tile_mm_acc<4>(acc, WmT + t0 * 32 * LD72, LD72, BdT + t1 * 32 * LD72, LD72, F.lane);
                  const int kout = t1 * 32 + rw; const float plk = pl[kout];
#pragma unroll
                  for (int r = 0; r < 16; ++r) { const int kin = t0 * 32 + (r & 3) + 8 * (r >> 2) + 4 * hh; acc[r] += (kin == kout) ? plk : 0.f; }
                  u32x4* po = Ph_g + ((((size_t)ch * 2 + t1) * 2 + t0) * 2) * 64 + F.lane; po[0] = pack8(acc, 0); po[64] = pack8(acc, 1); }
              else {
                  acc = tile_mm_acc<4>(acc, BdT + t0 * 32 * LD72, LD72, UT + t1 * 32 * LD72, LD72, F.lane);
                  acc = tile_mm_acc<4>(acc, KdT + t0 * 32 * LD72, LD72, VT + t1 * 32 * LD72, LD72, F.lane);
#pragma unroll
                  for (int r = 0; r < 16; ++r) acc[r] += 0.f;
                  u32x4* co = C_g + ((size_t)(ch * 2 + t0) * 2 + t1) * 128 + F.lane * 2; co[0] = pack8(acc, 0); co[1] = pack8(acc, 1); }
          } }
        __syncthreads();
    }
}
template <bool XINBF> __device__ __forceinline__ void phase_mid(const Frame& F, int layer, const void* xin, bf16_t* xout) {
    float* wl = (float*)F.smem;
    fill_thin(wl, F.in[I_ROUTER] + (size_t)layer * 1024 * 16, 16, F.tid);
    __syncthreads();
    const float* mod = WSP(float, OFF_MOD); const bf16_t* ymix = WSP(bf16_t, OFF_YMIX); bf16_t* hb = WSP(bf16_t, OFF_HB); float* probs = WSP(float, OFF_PROBS);
    for (int tb = F.bid; tb < 256; tb += F.nblk) {
        const int base = tb * 64 + F.wid * 8, b = base >> 12;
        const float* mb = mod + (size_t)(layer * 4 + b) * 6144;
        for (int i = 0; i < 8; ++i) {
            const int tok = base + i; float y[16], xv[16];
            load_row16_bf(ymix + (size_t)tok * 1024, F.lane, y);
            if (XINBF) load_row16_bf((const bf16_t*)xin + (size_t)tok * 1024, F.lane, xv); else load_row16((const float*)xin + (size_t)tok * 1024, F.lane, xv);
            float ss = 0.f;
#pragma unroll
            for (int q = 0; q < 16; ++q) ss += y[q] * y[q];
            ss = wave_sum(ss); float rstd = rsqrtf(ss * (1.f / 1024.f) + 1e-6f);
            float s2 = 0.f;
            { float npost[16], g1[16]; load_row16(F.in[I_NMIX_POST] + layer * 1024, F.lane, npost); load_row16(mb + 2048, F.lane, g1);
#pragma unroll
              for (int q = 0; q < 16; ++q) { xv[q] = xv[q] + g1[q] * (y[q] * rstd * npost[q]); s2 += xv[q] * xv[q]; } }
            store_row16_bf(xout + (size_t)tok * 1024, F.lane, xv);
            s2 = wave_sum(s2); rstd = rsqrtf(s2 * (1.f / 1024.f) + 1e-6f);
            asm volatile("" ::: "memory");
            { float npre[16], sc[16], sh[16]; load_row16(F.in[I_NFFN_PRE] + layer * 1024, F.lane, npre); load_row16(mb + 4096, F.lane, sc); load_row16(mb + 3072, F.lane, sh);
#pragma unroll
              for (int q = 0; q < 16; ++q) y[q] = xv[q] * rstd * npre[q] * (1.f + sc[q]) + sh[q]; }
            asm volatile("" ::: "memory");
            store_row16_bf(hb + (size_t)tok * 1024, F.lane, y);
            float o[16]; thin16(wl, F.lane, y, o);
            float mx = o[0];
#pragma unroll
            for (int q = 1; q < 16; ++q) mx = fmaxf(mx, o[q]);
            float sum = 0.f;
#pragma unroll
            for (int q = 0; q < 16; ++q) { o[q] = __expf(o[q] - mx); sum += o[q]; }
            const float inv = 1.f / sum;
            if (F.lane < 16) { float r = 0.f;
#pragma unroll
                for (int q = 0; q < 16; ++q) r = (q == F.lane) ? o[q] : r;
                probs[((size_t)(b * 16 + F.lane)) * 4096 + (tok & 4095)] = r * inv; }
        }
    }
}

__device__ __forceinline__ void phase_topk(const Frame& F) {
    unsigned* keys = (unsigned*)F.smem;
    unsigned* hist = keys + 4096;
    unsigned* ctl = hist + 256;
    unsigned* wsum = ctl + 8;
    const float* probs = WSP(float, OFF_PROBS); int* rowtok = WSP(int, OFF_ROWTOK); float* gatev = WSP(float, OFF_GATEV); int* slot = WSP(int, OFF_SLOT);
    for (int u = F.bid; u < 64; u += F.nblk) {
        const int b = u >> 4, e = u & 15;
        const float* pr = probs + (size_t)u * 4096;
        for (int i = F.tid; i < 4096; i += NTHR) keys[i] = __float_as_uint(pr[i]);
        if (F.tid == 0) { ctl[0] = 0u; ctl[1] = 512u; }
        __syncthreads();
        for (int pass = 0; pass < 4; ++pass) {
            const int shift = 24 - 8 * pass;
            if (F.tid < 256) hist[F.tid] = 0u;
            __syncthreads();
            const unsigned prefix = ctl[0]; const unsigned himask = pass == 0 ? 0u : (0xFFFFFFFFu << (shift + 8));
            for (int i = F.tid; i < 4096; i += NTHR) { const unsigned k = keys[i]; if ((k & himask) == prefix) atomicAdd(&hist[(k >> shift) & 255u], 1u); }
            __syncthreads();
            if (F.wid == 0) {
                const unsigned kr = ctl[1]; unsigned hq[4], tot = 0u;
#pragma unroll
                for (int q = 0; q < 4; ++q) { hq[q] = hist[255 - (4 * F.lane + q)]; tot += hq[q]; }
                unsigned inc = tot;
#pragma unroll
                for (int o = 1; o < 64; o <<= 1) { const unsigned t = __shfl_up(inc, o); if (F.lane >= o) inc += t; }
                unsigned cum = inc - tot;
#pragma unroll
                for (int q = 0; q < 4; ++q) { if (cum < kr && cum + hq[q] >= kr) { ctl[0] = prefix | ((unsigned)(255 - (4 * F.lane + q)) << shift); ctl[1] = kr - cum; } cum += hq[q]; } }
            __syncthreads();
        }
        const unsigned thr = ctl[0], keq = ctl[1];
        const int i0 = F.tid * 8; unsigned kk[8]; unsigned ceq = 0u;
#pragma unroll
        for (int q = 0; q < 8; ++q) { kk[q] = keys[i0 + q]; ceq += (kk[q] == thr) ? 1u : 0u; }
        unsigned inc = ceq;
#pragma unroll
        for (int o = 1; o < 64; o <<= 1) { const unsigned t = __shfl_up(inc, o); if (F.lane >= o) inc += t; }
        if (F.lane == 63) wsum[F.wid] = inc;
        __syncthreads();
        unsigned woff = 0u;
        for (int w = 0; w < F.wid; ++w) woff += wsum[w];
        unsigned eqpre = woff + inc - ceq;
        __syncthreads();
        unsigned csel = 0u; unsigned selmask = 0u;
#pragma unroll
        for (int q = 0; q < 8; ++q) { bool sel = kk[q] > thr; if (kk[q] == thr) { sel = eqpre < keq; ++eqpre; } if (sel) { selmask |= 1u << q; ++csel; } }
        inc = csel;
#pragma unroll
        for (int o = 1; o < 64; o <<= 1) { const unsigned t = __shfl_up(inc, o); if (F.lane >= o) inc += t; }
        if (F.lane == 63) wsum[8 + F.wid] = inc;
        __syncthreads();
        woff = 0u;
        for (int w = 0; w < F.wid; ++w) woff += wsum[8 + w];
        unsigned sl = woff + inc - csel;
#pragma unroll
        for (int q = 0; q < 8; ++q) { const int tokg = b * 4096 + i0 + q;
            if (selmask & (1u << q)) { const int row = e * 2048 + b * 512 + (int)sl; ++sl; rowtok[row] = tokg; gatev[row] = __uint_as_float(kk[q]); slot[(size_t)tokg * 16 + e] = row; }
            else slot[(size_t)tokg * 16 + e] = -1; }
        __syncthreads();
    }
}

template <bool XOUTBF> __device__ __forceinline__ void phase_combine(const Frame& F, int layer, const bf16_t* xin, void* xout, bool next_norm) {
    const float* mod = WSP(float, OFF_MOD); const bf16_t* Y = WSP(bf16_t, OFF_YBUF); const int* slot = WSP(int, OFF_SLOT); bf16_t* hb = WSP(bf16_t, OFF_HB);
    for (int tb = F.bid; tb < 256; tb += F.nblk) {
        const int base = tb * 64 + F.wid * 8, b = base >> 12;
        const float* mb = mod + (size_t)(layer * 4 + b) * 6144;
        float npost[16], g2[16];
        load_row16(F.in[I_NFFN_POST] + layer * 1024, F.lane, npost); load_row16(mb + 5120, F.lane, g2);
        for (int i = 0; i < 8; ++i) {
            const int tok = base + i; float y[16];
#pragma unroll
            for (int q = 0; q < 16; ++q) y[q] = 0.f;
            const int myslot = slot[(size_t)tok * 16 + (F.lane & 15)];
            for (int e = 0; e < 16; ++e) { const int r = __shfl(myslot, e);
                if (r >= 0) { const u32x2* yp = (const u32x2*)(Y + (size_t)r * 1024 + F.lane * 4);
#pragma unroll
                    for (int i = 0; i < 4; ++i) { const u32x2 a = yp[i * 64]; y[4 * i] += bflo(a.x); y[4 * i + 1] += bfhi(a.x); y[4 * i + 2] += bflo(a.y); y[4 * i + 3] += bfhi(a.y); } } }
            float ss = 0.f;
#pragma unroll
            for (int q = 0; q < 16; ++q) ss += y[q] * y[q];
            ss = wave_sum(ss); float rstd = rsqrtf(ss * (1.f / 1024.f) + 1e-6f);
            float xv[16]; load_row16_bf(xin + (size_t)tok * 1024, F.lane, xv);
            float s2 = 0.f;
#pragma unroll
            for (int q = 0; q < 16; ++q) { xv[q] = xv[q] + g2[q] * (y[q] * rstd * npost[q]); s2 += xv[q] * xv[q]; }
#ifdef DN_CHECK
            if (!next_norm && ((const unsigned*)(F.ws + OFF_BAR))[4000] != 0u) {
#pragma unroll
                for (int q = 0; q < 16; ++q) xv[q] += 1000.f; }
#endif
#if defined(DN_CHECK3)
            if (!next_norm) { const float* fw = (const float*)(F.ws + OFF_BAR); const float rel = sqrtf(fw[4004] / fmaxf(fw[4005], 1e-30f)); const float addv = (rel == rel) ? 100.f * (1.f + fminf(97.f, rintf(rel * 100.f))) : 9900.f;
#pragma unroll
                for (int q = 0; q < 16; ++q) xv[q] += addv; }
#endif
#if defined(DN_NAIVE_CHECK) || defined(DN_CHECK2) || defined(DN_LDSCHECK)
            if (!next_norm) { const float* fw = (const float*)(F.ws + OFF_BAR); const float r1 = sqrtf(fw[4004] / fmaxf(fw[4005], 1e-30f)), r2 = sqrtf(fw[4006] / fmaxf(fw[4007], 1e-30f));
                const float addv = 100.f * (1.f + 10.f * fminf(9.f, floorf(r1 * 50.f)) + fminf(9.f, floorf(r2 * 50.f)));
#pragma unroll
                for (int q = 0; q < 16; ++q) xv[q] += addv; }
#endif
            if (XOUTBF) store_row16_bf((bf16_t*)xout + (size_t)tok * 1024, F.lane, xv); else store_row16((float*)xout + (size_t)tok * 1024, F.lane, xv);
            if (next_norm) {
                float gain[16], sc[16], sh[16]; const float* mn = mod + (size_t)((layer + 1) * 4 + b) * 6144;
                load_row16(F.in[I_NMIX_PRE] + (layer + 1) * 1024, F.lane, gain); load_row16(mn + 1024, F.lane, sc); load_row16(mn, F.lane, sh);
                s2 = wave_sum(s2); rstd = rsqrtf(s2 * (1.f / 1024.f) + 1e-6f);
#pragma unroll
                for (int q = 0; q < 16; ++q) y[q] = xv[q] * rstd * gain[q] * (1.f + sc[q]) + sh[q];
                store_row16_bf(hb + (size_t)tok * 1024, F.lane, y);
            }
        }
    }
}

__device__ __forceinline__ void phase_rwprep(const Frame& F) {
    const bf16_t* P1 = WSP(bf16_t, OFF_P1); bf16_t* rwr = WSP(bf16_t, OFF_RWR); bf16_t* rwk = WSP(bf16_t, OFF_RWK); bf16_t* rwv = WSP(bf16_t, OFF_RWV); bf16_t* rwkk = WSP(bf16_t, OFF_RWKK);
    bf16_t* lin = WSP(bf16_t, OFF_LORAIN); const float* mu = F.in[I_RW_MU];
    const int c0 = F.lane * 8;
    for (int tb = F.bid; tb < 256; tb += F.nblk) {
        const int base = tb * 64 + F.wid * 8;
        for (int i = 0; i < 8; ++i) {
            const size_t tok = base + i; const int s = (int)(tok & 4095);
            const bool hp = s > 0, hn = s < 4095;
            auto shifted = [&](int ch, float (&o)[8]) {
                const u32x4 z4 = (u32x4){0u, 0u, 0u, 0u};
                const u32x4 cur = *(const u32x4*)(P1 + tok * 3072 + ch);
                const u32x4 prv = hp ? *(const u32x4*)(P1 + (tok - 1) * 3072 + ch) : z4;
                const u32x4 nxt = hn ? *(const u32x4*)(P1 + (tok + 1) * 3072 + ch) : z4;
                const float4 m0 = *(const float4*)(mu + ch), m1 = *(const float4*)(mu + ch + 4);
                const float cu[8] = {bflo(cur.x), bfhi(cur.x), bflo(cur.y), bfhi(cur.y), bflo(cur.z), bfhi(cur.z), bflo(cur.w), bfhi(cur.w)};
                const float pr[8] = {bflo(prv.x), bfhi(prv.x), bflo(prv.y), bfhi(prv.y), bflo(prv.z), bfhi(prv.z), bflo(prv.w), bfhi(prv.w)};
                const float nx[8] = {bflo(nxt.x), bfhi(nxt.x), bflo(nxt.y), bfhi(nxt.y), bflo(nxt.z), bfhi(nxt.z), bflo(nxt.w), bfhi(nxt.w)};
                const float mm[8] = {m0.x, m0.y, m0.z, m0.w, m1.x, m1.y, m1.z, m1.w};
#pragma unroll
                for (int q = 0; q < 8; ++q) o[q] = cu[q] + mm[q] * (0.5f * (pr[q] + nx[q]) - cu[q]);
            };
            float v[8];
            shifted(c0, v);        *(u32x4*)(rwr + tok * 512 + c0) = (u32x4){pk2(v[0], v[1]), pk2(v[2], v[3]), pk2(v[4], v[5]), pk2(v[6], v[7])};
            shifted(1024 + c0, v); *(u32x4*)(rwv + tok * 512 + c0) = (u32x4){pk2(v[0], v[1]), pk2(v[2], v[3]), pk2(v[4], v[5]), pk2(v[6], v[7])};
            shifted(512 + c0, v);  *(u32x4*)(rwk + tok * 512 + c0) = (u32x4){pk2(v[0], v[1]), pk2(v[2], v[3]), pk2(v[4], v[5]), pk2(v[6], v[7])};
            { const float4 k0 = *(const float4*)(F.in[I_RW_KK] + c0), k1 = *(const float4*)(F.in[I_RW_KK] + c0 + 4);
              float kk[8] = {v[0] * k0.x, v[1] * k0.y, v[2] * k0.z, v[3] * k0.w, v[4] * k1.x, v[5] * k1.y, v[6] * k1.z, v[7] * k1.w};
              float ss = 0.f;
#pragma unroll
              for (int q = 0; q < 8; ++q) ss += kk[q] * kk[q];
              ss += __shfl_xor(ss, 1); ss += __shfl_xor(ss, 2); ss += __shfl_xor(ss, 4);
              const float sc = rsqrtf(ss + 1e-6f);
              *(u32x4*)(rwkk + tok * 512 + c0) = (u32x4){pk2(kk[0] * sc, kk[1] * sc), pk2(kk[2] * sc, kk[3] * sc), pk2(kk[4] * sc, kk[5] * sc), pk2(kk[6] * sc, kk[7] * sc)}; }
            if (F.lane < 48) { shifted(1536 + c0, v);
                float o8[8];
#pragma unroll
                for (int q = 0; q < 8; ++q) { const float x = v[q]; o8[q] = c0 < 128 ? (2.f * sigmoidf_(2.f * x) - 1.f) : (c0 < 256 ? x : sigmoidf_(x)); }
                *(u32x4*)(lin + tok * 384 + c0) = (u32x4){pk2(o8[0], o8[1]), pk2(o8[2], o8[3]), pk2(o8[4], o8[5]), pk2(o8[6], o8[7])}; }
        }
    }
}

__device__ __forceinline__ void phase_rwpost(const Frame& F) {
    const bf16_t* rwr = WSP(bf16_t, OFF_RWR); const bf16_t* rwk = WSP(bf16_t, OFF_RWK); const bf16_t* rwv = WSP(bf16_t, OFF_RWV);
    const bf16_t* rwa = WSP(bf16_t, OFF_RWA); const bf16_t* rwg = WSP(bf16_t, OFF_RWG); const bf16_t* rwy = WSP(bf16_t, OFF_RWY); bf16_t* ycat = WSP(bf16_t, OFF_YCAT);
    const int c0 = F.lane * 8;
    float lnw[8], lnb[8], kaw[8], rk[8];
#pragma unroll
    for (int q = 0; q < 8; ++q) { lnw[q] = F.in[I_RW_LNW][c0 + q]; lnb[q] = F.in[I_RW_LNB][c0 + q]; kaw[q] = F.in[I_RW_KA][c0 + q]; rk[q] = F.in[I_RW_RK][c0 + q]; }
    for (int tb = F.bid; tb < 256; tb += F.nblk) {
        const int base = tb * 64 + F.wid * 8;
        for (int i = 0; i < 8; ++i) { const size_t tok = base + i;
            float y[8], r[8], k[8], v[8], a0[8], a1[8], g[8];
            auto ld8b = [&](const bf16_t* p, float (&o)[8]) { const u32x4 x = *(const u32x4*)(p + tok * 512 + c0); o[0] = bflo(x.x); o[1] = bfhi(x.x); o[2] = bflo(x.y); o[3] = bfhi(x.y); o[4] = bflo(x.z); o[5] = bfhi(x.z); o[6] = bflo(x.w); o[7] = bfhi(x.w); };
            ld8b(rwy, y); ld8b(rwy + (size_t)T_ * 512, r);
#pragma unroll
            for (int q = 0; q < 8; ++q) y[q] += r[q];
            ld8b(rwr, r); ld8b(rwk, k); ld8b(rwv, v); ld8b(rwa, a0); ld8b(rwa + (size_t)T_ * 512, a1); ld8b(rwg, g);
            float sm = 0.f;
#pragma unroll
            for (int q = 0; q < 8; ++q) sm += y[q];
            sm += __shfl_xor(sm, 1); sm += __shfl_xor(sm, 2); sm += __shfl_xor(sm, 4);
            const float mean = sm * (1.f / 64.f);
            float vs = 0.f;
#pragma unroll
            for (int q = 0; q < 8; ++q) { y[q] -= mean; vs += y[q] * y[q]; }
            vs += __shfl_xor(vs, 1); vs += __shfl_xor(vs, 2); vs += __shfl_xor(vs, 4);
            const float rstd = rsqrtf(vs * (1.f / 64.f) + 64e-5f);
            float dot = 0.f;
#pragma unroll
            for (int q = 0; q < 8; ++q) { const float kb = k[q] * (1.f + (0.5f * (a0[q] + a1[q]) - 1.f) * kaw[q]); dot += r[q] * kb * rk[q]; }
            dot += __shfl_xor(dot, 1); dot += __shfl_xor(dot, 2); dot += __shfl_xor(dot, 4);
            float o[8];
#pragma unroll
            for (int q = 0; q < 8; ++q) o[q] = (y[q] * rstd * lnw[q] + lnb[q] + dot * v[q]) * g[q];
            *(u32x4*)(ycat + tok * 1024 + c0) = (u32x4){pk2(o[0], o[1]), pk2(o[2], o[3]), pk2(o[4], o[5]), pk2(o[6], o[7])};
        }
    }
}

constexpr int BG_NTILES = 16 * 3 * 704;
#define BG_DECODE(x) const int region_ = (x) / 704, tt_ = (x) % 704, e_ = region_ / 3, kind_ = region_ % 3; \
    const float* bsrc_; bf16_t* bdst_; int blds_, bldd_; \
    if (kind_ < 2) { const int kt_ = tt_ & 15, nt_ = tt_ >> 4; const int f_ = nt_ * 64, tile22_ = f_ >> 7, r_ = f_ & 127; \
        bsrc_ = F.in[kind_ == 0 ? I_WGATE : I_WUP] + ((size_t)(16 + e_) * 1024 + kt_ * 64) * 2816 + nt_ * 64; blds_ = 2816; \
        bdst_ = (bf16_t*)(F.ws + OFF_W1T + W1T_LAYER) + ((size_t)((e_ * 22 + tile22_) * 256 + kind_ * 128 + r_)) * 1024 + kt_ * 64; bldd_ = 1024; } \
    else { const int kt_ = tt_ % 44, nt_ = tt_ / 44; \
        bsrc_ = F.in[I_WDOWN] + ((size_t)(16 + e_) * 2816 + kt_ * 64) * 1024 + nt_ * 64; blds_ = 1024; \
        bdst_ = (bf16_t*)(F.ws + OFF_W2T + W2T_LAYER) + ((size_t)(e_ * 1024 + nt_ * 64)) * 2816 + kt_ * 64; bldd_ = 2816; }
__device__ __forceinline__ void bg_issue(const Frame& F, int x, LAS unsigned char* stg, int tz) {
    if (x < BG_NTILES) { BG_DECODE(x); (void)bdst_; (void)bldd_;
#pragma unroll
        for (int i = 0; i < 2; ++i) { const int ci = F.wid * 2 + i, row = ci * 4 + ((tz & 63) >> 4), col = (tz & 15) * 4;
            __builtin_amdgcn_global_load_lds((const unsigned*)(bsrc_ + (size_t)row * blds_ + col), (LAS unsigned*)(stg + ci * 1024), 16, 0, 0); } }
}
__device__ __forceinline__ void bg_flush(const Frame& F, LAS unsigned char* stg, int x, int tz) {
    if (x < BG_NTILES) { BG_DECODE(x); (void)bsrc_; (void)blds_; const int n = tz >> 3, ks = (tz & 7) * 8; const LAS float* t = (const LAS float*)stg + ks * 64 + n;
        u32x4 o; o.x = pk2(t[0], t[64]); o.y = pk2(t[128], t[192]); o.z = pk2(t[256], t[320]); o.w = pk2(t[384], t[448]);
        *(u32x4*)(bdst_ + (size_t)n * bldd_ + ks) = o; }
}
__device__ __forceinline__ void bg_issue2(const Frame& F, int x, LAS unsigned char* stg, int tz, bf16_t*& dsto, int& lddo) {
    dsto = nullptr; lddo = 0;
    if (x < BG_NTILES) { BG_DECODE(x); dsto = bdst_; lddo = bldd_; const int w_ = __builtin_amdgcn_readfirstlane(tz >> 6);
#pragma unroll
        for (int i = 0; i < 2; ++i) { const int ci = w_ * 2 + i, row = ci * 4 + ((tz & 63) >> 4), col = (tz & 15) * 4;
            __builtin_amdgcn_global_load_lds((const unsigned*)(bsrc_ + (size_t)row * blds_ + col), (LAS unsigned*)(stg + ci * 1024), 16, 0, 0); } }
}
__device__ __forceinline__ void bg_flush2(LAS unsigned char* stg, bf16_t* dst, int ldd, int tz) {
    if (dst != nullptr) { const int n = tz >> 3, ks = (tz & 7) * 8; const LAS float* t = (const LAS float*)stg + ks * 64 + n;
        u32x4 o; o.x = pk2(t[0], t[64]); o.y = pk2(t[128], t[192]); o.z = pk2(t[256], t[320]); o.w = pk2(t[384], t[448]);
        *(u32x4*)(dst + (size_t)n * ldd + ks) = o; }
}
constexpr int BG3_NTILES = 16 * 3 * 176;
__device__ __forceinline__ void bg3_issue(const Frame& F, int x, LAS unsigned char* stg, int tz, bf16_t*& dsto, int& lddo) {
    dsto = nullptr; lddo = 0;
    if (x < BG3_NTILES) {
        const int region_ = x / 176, tt_ = x % 176, e_ = region_ / 3, kind_ = region_ % 3; const float* bsrc_; int blds_;
        if (kind_ < 2) { const int kt_ = tt_ & 7, nt_ = tt_ >> 3;
            bsrc_ = F.in[kind_ == 0 ? I_WGATE : I_WUP] + ((size_t)(16 + e_) * 1024 + kt_ * 128) * 2816 + nt_ * 128; blds_ = 2816;
            dsto = (bf16_t*)(F.ws + OFF_W1T + W1T_LAYER) + (size_t)(e_ * 22 + nt_) * (256 * 1024) + (size_t)(2 * kt_) * 16384 + kind_ * 128 * 64; lddo = 1024; }
        else { const int kt_ = tt_ % 22, nt_ = tt_ / 22;
            bsrc_ = F.in[I_WDOWN] + ((size_t)(16 + e_) * 2816 + kt_ * 128) * 1024 + nt_ * 128; blds_ = 1024;
            dsto = (bf16_t*)(F.ws + OFF_W2T + W2T_LAYER) + (size_t)(e_ * 4 + (nt_ >> 1)) * (256 * 2816) + (size_t)(2 * kt_) * 16384 + (nt_ & 1) * 128 * 64; lddo = 2816; }
        const int w_ = __builtin_amdgcn_readfirstlane(tz >> 6);
#pragma unroll
        for (int i = 0; i < 8; ++i) { const int row = w_ * 16 + 2 * i + ((tz & 63) >> 5), col = (tz & 31) * 4;
            __builtin_amdgcn_global_load_lds((const unsigned*)(bsrc_ + (size_t)row * blds_ + col), (LAS unsigned*)(stg + (w_ * 16 + 2 * i) * 512), 16, 0, 0); } }
}
__device__ __forceinline__ void bg3_flush(LAS unsigned char* stg, bf16_t* dst, int ldd, int tz) {
    if (dst != nullptr) { const int n0 = tz & 63, w_ = __builtin_amdgcn_readfirstlane(tz >> 6);
#pragma unroll
        for (int ps = 0; ps < 4; ++ps) { const int c = w_ * 4 + ps, n = (c & 1) * 64 + n0, k0 = (c >> 1) * 8; const LAS float* t = (const LAS float*)stg + k0 * 128 + n;
            u32x4 o; o.x = pk2(t[0], t[128]); o.y = pk2(t[256], t[384]); o.z = pk2(t[512], t[640]); o.w = pk2(t[768], t[896]);
            *(u32x4*)(dst + (k0 >> 6) * 16384 + n * 64 + (k0 & 63)) = o; } }
}
template <bool BGON = true> __device__ __forceinline__ void phase_attn(const Frame& F) {
    LAS unsigned char* lds = F.lds;
    const bf16_t* P1 = WSP(bf16_t, OFF_P1); const bf16_t* Vimg = WSP(bf16_t, OFF_VIMG); bf16_t* ycat = WSP(bf16_t, OFF_YCAT);
    constexpr int KS = 0, VS = 16384, CVB = 49152;
    const float lam_init = 0.8f - 0.6f * 0.7408182206817179f;
    float lam;
    { const float* lp = F.in[I_DF_LAM]; float s1 = 0.f, s2 = 0.f;
      for (int i = 0; i < 64; ++i) { s1 += lp[i] * lp[64 + i]; s2 += lp[128 + i] * lp[192 + i]; }
      lam = __expf(s1) - __expf(s2) + lam_init; }
    const int hh = F.lane >> 5, ql = F.lane & 31;
#define BG3_X(t) (F.nblk == 256 ? (F.bid < 128 ? ((t) < 27 ? (int)F.bid + 128 * (t) : BG3_NTILES) : ((t) < 39 ? 3456 + ((int)F.bid - 128) + 128 * (t) : BG3_NTILES)) : (int)F.bid + (t) * (int)F.nblk)
    for (int u = F.bid; u < 256; u += F.nblk) {
        const int qb = u & 15, h = (u >> 4) & 3, b = u >> 6;
        const float slope2 = exp2f(-2.f * (float)(h + 1)) * 1.4426950408889634f;
        const size_t tok0 = (size_t)b * 4096 + qb * 256;
        const int qrow = F.wid * 32 + ql;
        const float qpos = (float)(qb * 256 + qrow);
        bf16_t* bgd = nullptr; int bgl = 0;
        for (int m = 0; m < 2; ++m) {
            const unsigned klo = (unsigned)(((F.wid * 8 + (F.lane >> 3)) * 3072 + (((F.lane & 7) ^ (((F.wid * 8 + (F.lane >> 3)) >> 1) & 7)) * 8)) * 2);
            const unsigned vlo = (unsigned)((F.wid * 1024 + F.lane * 8) * 2);
            const char* kub = (const char*)(P1 + ((size_t)b * 4096) * 3072 + 2432 + h * 128 + m * 64);
            const char* vub = (const char*)(Vimg + ((size_t)(b * 4 + h) * 64) * 8192);
#define AT_STAGE(kt, buf) do { unsigned klo_ = klo, vlo_ = vlo; asm volatile("" : "+v"(klo_), "+v"(vlo_));     \
            __builtin_amdgcn_global_load_lds((const unsigned*)(kub + (size_t)(kt) * (64 * 3072 * 2) + klo_), (LAS unsigned*)(lds + KS + (buf) * 8192 + F.wid * 1024), 16, 0, 0); \
            __builtin_amdgcn_global_load_lds((const unsigned*)(vub + (size_t)(kt) * 16384 + vlo_), (LAS unsigned*)(lds + VS + (buf) * 16384 + F.wid * 2048), 16, 0, 0); \
            __builtin_amdgcn_global_load_lds((const unsigned*)(vub + (size_t)(kt) * 16384 + vlo_ + 1024), (LAS unsigned*)(lds + VS + (buf) * 16384 + F.wid * 2048 + 1024), 16, 0, 0); } while (0)
            AT_STAGE(0, 0);
            f32x16 O[4];
#pragma unroll
            for (int dt = 0; dt < 4; ++dt)
#pragma unroll
                for (int r = 0; r < 16; ++r) O[dt][r] = 0.f;
            float mrun = -1e30f, lrun = 0.f;
            asm volatile("s_waitcnt vmcnt(0)" ::: "memory");
            __syncthreads();
            bf16x8 qf[4];
#pragma unroll
            for (int s = 0; s < 4; ++s) { const u32x4 qv = *(const u32x4*)(P1 + (tok0 + qrow) * 3072 + 1920 + h * 128 + m * 64 + (s * 2 + hh) * 8);
                const float sc = 0.18033688011112042f;
                u32x4 o; o.x = pk2(bflo(qv.x) * sc, bfhi(qv.x) * sc); o.y = pk2(bflo(qv.y) * sc, bfhi(qv.y) * sc); o.z = pk2(bflo(qv.z) * sc, bfhi(qv.z) * sc); o.w = pk2(bflo(qv.w) * sc, bfhi(qv.w) * sc);
                qf[s] = as_frag(o); }
            for (int kt = 0; kt < 64; ++kt) {
                const int buf = kt & 1;
                if (kt + 1 < 64) AT_STAGE(kt + 1, buf ^ 1);
                bf16x8 kf[2][4];
#pragma unroll
                for (int k2 = 0; k2 < 2; ++k2)
#pragma unroll
                    for (int s = 0; s < 4; ++s) { const int col16 = s * 2 + hh; const int key = k2 * 32 + ql;
                        kf[k2][s] = *(const LAS bf16x8*)(lds + KS + buf * 8192 + key * 128 + ((col16 ^ ((key >> 1) & 7)) * 16)); }
                asm volatile("" ::: "memory");
                const int bgi = m * 64 + kt;
                { int tzb = F.tid; asm volatile("" : "+v"(tzb));
                  if (BGON) { if (bgi & 1) bg3_issue(F, BG3_X(bgi >> 1), lds + CVB, tzb, bgd, bgl);
                              else bg3_flush(lds + CVB, bgd, bgl, tzb); } }
                const float dbase = (float)(kt * 64 + 4 * hh) - qpos;
                f32x16 Sx[2];
#pragma unroll
                for (int k2 = 0; k2 < 2; ++k2)
#pragma unroll
                    for (int r = 0; r < 16; ++r) Sx[k2][r] = 0.f;
                asm volatile("s_waitcnt lgkmcnt(0)" ::: "memory");
#pragma unroll
                for (int s = 0; s < 4; ++s) {
                    Sx[0] = __builtin_amdgcn_mfma_f32_32x32x16_bf16(kf[0][s], qf[s], Sx[0], 0, 0, 0);
                    Sx[1] = __builtin_amdgcn_mfma_f32_32x32x16_bf16(kf[1][s], qf[s], Sx[1], 0, 0, 0); }
                asm volatile("" ::: "memory");
                bf16x8 va[4], vb[4];
#define AT_VLOAD(dst, dt) _Pragma("unroll") for (int ks = 0; ks < 4; ++ks) { const int dv = (dt) * 32 + ql; \
                    dst[ks] = *(const LAS bf16x8*)(lds + VS + buf * 16384 + ((ks * 2 + hh) * 128 + dv) * 16); }
                AT_VLOAD(va, 0) AT_VLOAD(vb, 1)
                asm volatile("" ::: "memory");
                float mt = -1e30f;
#pragma unroll
                for (int k2 = 0; k2 < 2; ++k2)
#pragma unroll
                    for (int r = 0; r < 16; ++r) { const float dd = dbase + (float)(k2 * 32 + (r & 3) + 8 * (r >> 2));
                        const float tv = Sx[k2][r] - slope2 * fabsf(dd); Sx[k2][r] = tv; mt = fmaxf(mt, tv); }
                mt = fmaxf(mt, __shfl_xor(mt, 32));
                const float mnew = fmaxf(mrun, mt), alpha = __builtin_amdgcn_exp2f(mrun - mnew);
                float ls = 0.f;
#pragma unroll
                for (int k2 = 0; k2 < 2; ++k2)
#pragma unroll
                    for (int r = 0; r < 16; ++r) { const float pv = __builtin_amdgcn_exp2f(Sx[k2][r] - mnew); Sx[k2][r] = pv; ls += pv; }
                lrun = lrun * alpha + ls; mrun = mnew;
                bf16x8 Pp[4];
#pragma unroll
                for (int ks = 0; ks < 4; ++ks) { const int k2 = ks >> 1, r0 = (ks & 1) * 8; bf16x8 pf;
#pragma unroll
                    for (int j = 0; j < 4; ++j) { const unsigned w2 = pg8::cvt_pk_bf16(Sx[k2][r0 + 2 * j], Sx[k2][r0 + 2 * j + 1]); pf[2 * j] = (short)(w2 & 0xFFFFu); pf[2 * j + 1] = (short)(w2 >> 16); }
                    Pp[ks] = pf; }
                if (__builtin_amdgcn_ballot_w64(alpha != 1.f)) {
#pragma unroll
                    for (int dt = 0; dt < 4; ++dt)
#pragma unroll
                        for (int r = 0; r < 16; ++r) O[dt][r] *= alpha; }
                asm volatile("" ::: "memory");
                bf16x8 vc[4], vd[4];
                AT_VLOAD(vc, 2) AT_VLOAD(vd, 3)
                asm volatile("" ::: "memory");
#define AT_VF(v, ks) (v[ks])
#pragma unroll
                for (int ks = 0; ks < 4; ++ks) {
                    O[0] = __builtin_amdgcn_mfma_f32_32x32x16_bf16(AT_VF(va, ks), Pp[ks], O[0], 0, 0, 0);
                    O[1] = __builtin_amdgcn_mfma_f32_32x32x16_bf16(AT_VF(vb, ks), Pp[ks], O[1], 0, 0, 0); }
#pragma unroll
                for (int ks = 0; ks < 4; ++ks) {
                    O[2] = __builtin_amdgcn_mfma_f32_32x32x16_bf16(AT_VF(vc, ks), Pp[ks], O[2], 0, 0, 0);
                    O[3] = __builtin_amdgcn_mfma_f32_32x32x16_bf16(AT_VF(vd, ks), Pp[ks], O[3], 0, 0, 0); }
                asm volatile("" ::: "memory");
#undef AT_VLOAD
#undef AT_VF
                asm volatile("s_waitcnt vmcnt(0)" ::: "memory");
                __syncthreads();
            }
#undef AT_STAGE
            const float lt = lrun + __shfl_xor(lrun, 32);
            int tze = F.tid; asm volatile("" : "+v"(tze));
            bf16_t* orow = ycat + (tok0 + (tze >> 6) * 32 + (tze & 31)) * 1024 + 512 + h * 128;
            if (m == 0) { const float i0 = 1.f / lt;
#pragma unroll
                for (int dt = 0; dt < 4; ++dt)
#pragma unroll
                    for (int gq = 0; gq < 4; ++gq) { const int dv = dt * 32 + 8 * gq + 4 * hh;
                        u32x2 pk; pk.x = pk2(O[dt][4 * gq] * i0, O[dt][4 * gq + 1] * i0); pk.y = pk2(O[dt][4 * gq + 2] * i0, O[dt][4 * gq + 3] * i0);
                        *(u32x2*)(orow + dv) = pk; }
                asm volatile("s_waitcnt vmcnt(0)" ::: "memory");
            } else {
                const float i1 = lam / lt;
                float ss = 0.f;
#pragma unroll
                for (int dt = 0; dt < 4; ++dt)
#pragma unroll
                    for (int gq = 0; gq < 4; ++gq) { const int dv = dt * 32 + 8 * gq + 4 * hh; const u32x2 pv = *(const u32x2*)(orow + dv);
                        const float o0 = bflo(pv.x) - O[dt][4 * gq] * i1, o1 = bfhi(pv.x) - O[dt][4 * gq + 1] * i1, o2 = bflo(pv.y) - O[dt][4 * gq + 2] * i1, o3 = bfhi(pv.y) - O[dt][4 * gq + 3] * i1;
                        O[dt][4 * gq] = o0; O[dt][4 * gq + 1] = o1; O[dt][4 * gq + 2] = o2; O[dt][4 * gq + 3] = o3; ss += o0 * o0 + o1 * o1 + o2 * o2 + o3 * o3; }
                ss += __shfl_xor(ss, 32);
                const float rstd = rsqrtf(ss * (1.f / 128.f) + 1e-5f) * (1.f - lam_init);
#pragma unroll
                for (int dt = 0; dt < 4; ++dt)
#pragma unroll
                    for (int gq = 0; gq < 4; ++gq) { const int dv = dt * 32 + 8 * gq + 4 * hh; const float4 sw = *(const float4*)(F.in[I_DF_SUBLN] + dv);
                        u32x2 pk; pk.x = pk2(O[dt][4 * gq] * rstd * sw.x, O[dt][4 * gq + 1] * rstd * sw.y); pk.y = pk2(O[dt][4 * gq + 2] * rstd * sw.z, O[dt][4 * gq + 3] * rstd * sw.w);
                        *(u32x2*)(orow + dv) = pk; }
            }
        }
        __syncthreads();
        int tzt = F.tid; asm volatile("" : "+v"(tzt));
        asm volatile("s_waitcnt vmcnt(0)" ::: "memory"); __syncthreads();
        bg3_flush(lds + CVB, bgd, bgl, tzt);
        for (int x = F.bid + 64 * (int)F.nblk; BGON && F.nblk != 256 && x < BG3_NTILES; x += F.nblk) {
            __syncthreads(); bg3_issue(F, x, lds + CVB, tzt, bgd, bgl);
            asm volatile("s_waitcnt vmcnt(0)" ::: "memory"); __syncthreads();
            bg3_flush(lds + CVB, bgd, bgl, tzt); }
        __syncthreads();
    }
}
enum { PH_PRO = 0, PH_NORM0, PH_IN0, PH_DNPREP, PH_DNAB, PH_DNC, PH_SCAN0, PH_POST0, PH_GLU, PH_OUT0, PH_MID0, PH_TOPK0, PH_MOE1_0, PH_MOE2_0, PH_COMB0,
       PH_IN1, PH_RWPREP, PH_LORA, PH_RWA, PH_RWB, PH_RWC, PH_SCAN1, PH_RWPOST, PH_OUT1, PH_MID1, PH_TOPK1, PH_MOE1_1, PH_MOE2_1, PH_COMB1, N_PHASES };
#ifndef DBL
#define DBL -1
#endif
constexpr int CVT_NJOB = 520 + 16 * 3 * 176, CVT_SPLIT = CVT_NJOB - 3072;
#ifdef PROBE_MIN
#define STAMP(k) do { if (F.bid == 0 && F.tid == 0) ((unsigned long long*)(F.ws + OFF_BAR))[1800 + (k)] = __builtin_amdgcn_s_memrealtime(); } while (0)
#else
#define STAMP(k) do { } while (0)
#endif
#define REP(k) for (int rep_ = 0; rep_ < ((DBL) == (k) ? 2 : 1); ++rep_)
__global__ void __launch_bounds__(NTHR, 2) fwd(Args args) {
    extern __shared__ __attribute__((aligned(16))) unsigned char smem[];
    Frame F;
    const int wid_s = __builtin_amdgcn_readfirstlane((int)threadIdx.x >> 6);
    F.smem = smem; F.lds = (LAS unsigned char*)smem; F.wid = wid_s; F.lane = my_lane(); F.tid = wid_s * 64 + F.lane;
    F.bid = blockIdx.x; F.nblk = gridDim.x; F.in = args.in; F.out = args.out; F.ws = args.ws; F.z = 0;
#define FRESH() do { int l_ = my_lane(); asm volatile("" : "+v"(l_)); F.lane = l_; F.wid = wid_s; F.tid = wid_s * 64 + l_; \
        size_t z_ = 0; asm volatile("" : "+s"(z_)); F.z = z_; } while (0)
    volatile LAS unsigned* xbw = (volatile LAS unsigned*)(F.lds + LDS_MAIN);
    if (F.tid < 4) xbw[F.tid] = 0u;
    __syncthreads();
    const int lo = args.ph_lo, hi = args.ph_hi;
    XcdBarrier bar; bar.bar = (unsigned*)(args.ws + OFF_BAR); bar.x = 0; bar.st = xbw;
    if (hi - lo > 1) bar = xcd_barrier_post((unsigned*)(args.ws + OFF_BAR), xbw, F.tid);
#define IN(k) (lo <= (k) && (k) < hi)
#define SEAM(k) do { if (IN(k) && IN((k) + 1)) { FRESH(); xcd_barrier(bar, F.tid); } } while (0)
    const int G = F.nblk, c = F.bid;

    if (IN(PH_PRO)) { FRESH(); REP(0) { phase_mod(F); __syncthreads(); phase_convert<true>(F, 0, CVT_SPLIT, (int)F.bid, (int)F.nblk); __syncthreads(); } } SEAM(PH_PRO);
    if (IN(PH_NORM0)) { FRESH(); phase_norm0(F); } SEAM(PH_NORM0);
    if (IN(PH_IN0)) { FRESH();
        pg8::Gemm g{WSP(bf16_t, OFF_HB), WSP(bf16_t, OFF_WIN0T), 1024, 1024, 1024, nullptr}; pg8::StaticOrder S; S.init(T_, 2560, G, c);
        EpiBf16Plain E{WSP(bf16_t, OFF_P0), 2560, 2560};
        pg8::gemm_phase<EpiBf16Plain, pg8::StaticOrder, false>(F.lds, g, S, E, F.tid);
#if DBL == 2
        __syncthreads(); FRESH(); pg8::gemm_phase<EpiBf16Plain, pg8::StaticOrder, false>(F.lds, g, S, E, F.tid);
#endif
    } SEAM(PH_IN0);
    if (IN(PH_DNPREP)) { FRESH(); phase_dnprep(F); } SEAM(PH_DNPREP);
    STAMP(0);
    if (IN(PH_DNAB)) { FRESH(); REP(40) { phase_dn_ab(F); __syncthreads(); } asm volatile("s_waitcnt vmcnt(0)" ::: "memory"); __syncthreads(); } STAMP(1);
    if (IN(PH_DNC)) { FRESH(); phase_dn_c(F); __syncthreads();
#if DBL == 41
        FRESH(); phase_dn_c(F); __syncthreads();
#endif
    } SEAM(PH_DNC); STAMP(2);
    if (IN(PH_SCAN0)) { FRESH();
#ifdef DN_NAIVE_CHECK
        phase_dn_naive_check(F); __syncthreads();
#endif
#if defined(DN_NANSCAN) && !defined(S5_NANSCAN)
        phase_dn_nanscan(F); __syncthreads(); FRESH(); xcd_barrier(bar, F.tid);
#endif
#ifdef BISECT_OLD_FIRST
        phase_dnscan(F); __syncthreads(); FRESH(); xcd_barrier(bar, F.tid);
#endif
        if (F.nblk == 256 ? F.bid >= 128 : true) {
            if (F.nblk == 256) phase_convert<false>(F, CVT_SPLIT, CVT_NJOB, (int)F.bid - 128, 128); else phase_convert<false>(F, CVT_SPLIT, CVT_NJOB, (int)F.bid, (int)F.nblk);
            __syncthreads(); }
        REP(42) { CarryBufs<4> cb{WSP(u32x4, OFF_DN_PHI), WSP(u32x4, OFF_DN_C), WSP(bf16_t, OFF_DN_QE), WSP(u32x4, OFF_DN_YI), WSP(bf16_t, OFF_DNO), 4, 512, 8192, 1024};
          phase_carry<4, 3>(F, cb, 128, F.bid, F.nblk); __syncthreads();
#ifdef DN_CHECK2
          FRESH(); xcd_barrier(bar, F.tid); if (F.bid == 0 && F.tid == 0) ((unsigned*)(F.ws + OFF_BAR))[4002] = 1u; FRESH(); xcd_barrier(bar, F.tid);
          phase_dn_ab(F); FRESH(); xcd_barrier(bar, F.tid); phase_dn_c(F); FRESH(); xcd_barrier(bar, F.tid); phase_carry<4>(F, cb, 128, F.bid, F.nblk); __syncthreads();
#endif
          }
#ifdef BISECT_OLD_DN
        phase_dnscan(F); __syncthreads();
#endif
#ifdef S5_CMP
#ifdef S5_BITCMP
        phase_s5scan_store(F); __syncthreads(); FRESH(); xcd_barrier(bar, F.tid);
#else
        phase_s5scan_old(F); __syncthreads(); FRESH(); xcd_barrier(bar, F.tid);
#endif
#endif
        REP(43) { phase_s5scan(F); __syncthreads(); }
#ifdef S5_CMP
        FRESH(); xcd_barrier(bar, F.tid);
#endif
#ifdef S5_NANSCAN
        FRESH(); xcd_barrier(bar, F.tid); phase_dn_nanscan(F); __syncthreads(); FRESH(); xcd_barrier(bar, F.tid);
#endif
    } SEAM(PH_SCAN0);
#ifdef PROBE_MIN
    {
        FRESH(); const float* fw = (const float*)(F.ws + OFF_BAR); const float r1 = sqrtf(fw[4004] / fmaxf(fw[4005], 1e-30f)), r2 = sqrtf(fw[4006] / fmaxf(fw[4007], 1e-30f));
        const float d1 = (r1 == r1) ? fminf(8.f, floorf(r1 * 50.f)) : 9.f, d2 = (r2 == r2) ? fminf(8.f, floorf(r2 * 50.f)) : 9.f;
        float addv = 100.f * (1.f + 10.f * d1 + d2);
#ifdef DN_NANSCAN
        addv = 100.f * (float)(((const unsigned*)(F.ws + OFF_BAR))[4001] + 1u);
#endif
#ifdef PROBE_SEL
        { FRESH(); xcd_barrier(bar, F.tid); const unsigned long long* st = (const unsigned long long*)(F.ws + OFF_BAR) + 1800; addv = 10.f * 0.01f * (float)(st[PROBE_SEL + 1] - st[PROBE_SEL]); }
#endif
        for (size_t i = (size_t)F.bid * NTHR + F.tid; i < (size_t)T_ * 1024; i += (size_t)F.nblk * NTHR) F.out[i] = addv;
        return; }
#else
    if (IN(PH_POST0)) { FRESH(); phase_post0(F); } SEAM(PH_POST0);
    if (IN(PH_GLU)) { FRESH();
        pg8::Gemm g{WSP(bf16_t, OFF_YS5), WSP(bf16_t, OFF_WGLUT), 512, 512, 512, nullptr}; pg8::StaticOrder S; S.init(T_, 512, G, c);
        EpiGlu E{WSP(bf16_t, OFF_YS5), F.in[I_S5_GLUB], WSP(bf16_t, OFF_YCAT)};
        pg8::gemm_phase<EpiGlu, pg8::StaticOrder, false>(F.lds, g, S, E, F.tid);
    } SEAM(PH_GLU);
    if (IN(PH_OUT0)) { FRESH();
        pg8::Gemm g{WSP(bf16_t, OFF_YCAT), WSP(bf16_t, OFF_WOUT0T), 1024, 1024, 1024, nullptr}; pg8::StaticOrder S; S.init(T_, 1024, G, c);
        EpiBf16Plain E{WSP(bf16_t, OFF_YMIX), 1024, 1024};
        pg8::gemm_phase<EpiBf16Plain, pg8::StaticOrder, false>(F.lds, g, S, E, F.tid);
#if DBL == 7
        __syncthreads(); FRESH(); pg8::gemm_phase<EpiBf16Plain, pg8::StaticOrder, false>(F.lds, g, S, E, F.tid);
#endif
    } SEAM(PH_OUT0);
    if (IN(PH_MID0)) { FRESH(); phase_mid<false>(F, 0, F.in[I_X], WSP(bf16_t, OFF_XA)); } SEAM(PH_MID0);
    if (IN(PH_TOPK0)) { FRESH(); phase_topk(F); } SEAM(PH_TOPK0);
    if (IN(PH_MOE1_0)) { FRESH();
        pg8::Gemm g{WSP(bf16_t, OFF_HB), (const bf16_t*)(F.ws + OFF_W1T), 1024, 64, 1024, WSP(int, OFF_ROWTOK), (size_t)32768, (size_t)256 * 1024 * 2}; pg8::MoeOrder S{176, 22, G, c};
        EpiSwiglu E{WSP(bf16_t, OFF_HBUF)};
        pg8::gemm_phase<EpiSwiglu, pg8::MoeOrder, true>(F.lds, g, S, E, F.tid);
#if DBL == 10
        __syncthreads(); FRESH(); pg8::gemm_phase<EpiSwiglu, pg8::MoeOrder, true>(F.lds, g, S, E, F.tid);
#endif
    } SEAM(PH_MOE1_0);
    if (IN(PH_MOE2_0)) { FRESH();
        pg8::Gemm g{WSP(bf16_t, OFF_HBUF), (const bf16_t*)(F.ws + OFF_W2T), F_, 64, F_, nullptr, (size_t)32768, (size_t)256 * F_ * 2}; pg8::MoeOrder S{32, 4, G, c};
        EpiDown E{WSP(bf16_t, OFF_YBUF), WSP(float, OFF_GATEV)};
        pg8::gemm_phase<EpiDown, pg8::MoeOrder, false>(F.lds, g, S, E, F.tid);
#if DBL == 11
        __syncthreads(); FRESH(); pg8::gemm_phase<EpiDown, pg8::MoeOrder, false>(F.lds, g, S, E, F.tid);
#endif
    } SEAM(PH_MOE2_0);
    if (IN(PH_COMB0)) { FRESH(); phase_combine<true>(F, 0, WSP(bf16_t, OFF_XA), WSP(bf16_t, OFF_XB), true); } SEAM(PH_COMB0);
    if (IN(PH_IN1)) { FRESH();
        { pg8::Gemm g{WSP(bf16_t, OFF_HB), WSP(bf16_t, OFF_WIN1T), 1024, 1024, 1024, nullptr}; pg8::StaticOrder S; S.init(T_, 3072, G, c);
          EpiBf16Plain E{WSP(bf16_t, OFF_P1), 3072, 2944};
          pg8::gemm_phase<EpiBf16Plain, pg8::StaticOrder, false>(F.lds, g, S, E, F.tid); }
        { pg8::Gemm g{WSP(bf16_t, OFF_WVT), WSP(bf16_t, OFF_HB), 1024, 1024, 1024, nullptr}; pg8::StaticOrder S; S.init(512, T_, G, c);
          EpiVimg E{WSP(bf16_t, OFF_VIMG)};
          pg8::gemm_phase<EpiVimg, pg8::StaticOrder, false>(F.lds, g, S, E, F.tid); }
    } SEAM(PH_IN1);
    if (IN(PH_RWPREP)) { FRESH(); phase_rwprep(F); } SEAM(PH_RWPREP);
    if (IN(PH_LORA)) { FRESH();
        pg8::Gemm g{WSP(bf16_t, OFF_LORAIN), WSP(bf16_t, OFF_WLORAT), 384, 384, 384, nullptr}; pg8::StaticOrder S; S.init(T_, 2560, G, c);
        EpiLora E{WSP(float, OFF_RWDEC), WSP(bf16_t, OFF_RWA), WSP(bf16_t, OFF_RWG), F.in[I_RW_W0], F.in[I_RW_A0]};
        pg8::gemm_phase<EpiLora, pg8::StaticOrder, false>(F.lds, g, S, E, F.tid);
    } SEAM(PH_LORA);
    if (IN(PH_RWA)) { FRESH(); phase_rw_a(F); asm volatile("s_waitcnt vmcnt(0)" ::: "memory"); __syncthreads(); }
    if (IN(PH_RWB)) { FRESH(); phase_rw_b(F); asm volatile("s_waitcnt vmcnt(0)" ::: "memory"); __syncthreads(); }
    if (IN(PH_RWC)) { FRESH(); phase_rw_c(F); __syncthreads(); } SEAM(PH_RWC);
    if (IN(PH_SCAN1)) { FRESH();
        { CarryBufs<2> cb{WSP(u32x4, OFF_RW_PHI), WSP(u32x4, OFF_RW_C), WSP(bf16_t, OFF_RW_QE), WSP(u32x4, OFF_RW_YI), WSP(bf16_t, OFF_RWY), 2, 512, 8192, 1024};
          phase_carry<2, 4>(F, cb, 128, F.bid, F.nblk); __syncthreads(); }
        phase_attn(F); __syncthreads();
#if DBL == 161
        FRESH(); phase_attn(F); __syncthreads();
#endif
#if DBL == 162
        FRESH(); phase_attn<false>(F); __syncthreads();
#endif
    } SEAM(PH_SCAN1);
    if (IN(PH_RWPOST)) { FRESH(); phase_rwpost(F); } SEAM(PH_RWPOST);
    if (IN(PH_OUT1)) { FRESH();
        pg8::Gemm g{WSP(bf16_t, OFF_YCAT), WSP(bf16_t, OFF_WOUT1T), 1024, 1024, 1024, nullptr}; pg8::StaticOrder S; S.init(T_, 1024, G, c);
        EpiBf16Plain E{WSP(bf16_t, OFF_YMIX), 1024, 1024};
        pg8::gemm_phase<EpiBf16Plain, pg8::StaticOrder, false>(F.lds, g, S, E, F.tid);
    } SEAM(PH_OUT1);
    if (IN(PH_MID1)) { FRESH(); phase_mid<true>(F, 1, WSP(bf16_t, OFF_XB), WSP(bf16_t, OFF_XA)); } SEAM(PH_MID1);
    if (IN(PH_TOPK1)) { FRESH(); phase_topk(F); } SEAM(PH_TOPK1);
    if (IN(PH_MOE1_1)) { FRESH();
        pg8::Gemm g{WSP(bf16_t, OFF_HB), (const bf16_t*)(F.ws + OFF_W1T + W1T_LAYER), 1024, 64, 1024, WSP(int, OFF_ROWTOK), (size_t)32768, (size_t)256 * 1024 * 2}; pg8::MoeOrder S{176, 22, G, c};
        EpiSwiglu E{WSP(bf16_t, OFF_HBUF)};
        pg8::gemm_phase<EpiSwiglu, pg8::MoeOrder, true>(F.lds, g, S, E, F.tid);
    } SEAM(PH_MOE1_1);
    if (IN(PH_MOE2_1)) { FRESH();
        pg8::Gemm g{WSP(bf16_t, OFF_HBUF), (const bf16_t*)(F.ws + OFF_W2T + W2T_LAYER), F_, 64, F_, nullptr, (size_t)32768, (size_t)256 * F_ * 2}; pg8::MoeOrder S{32, 4, G, c};
        EpiDown E{WSP(bf16_t, OFF_YBUF), WSP(float, OFF_GATEV)};
        pg8::gemm_phase<EpiDown, pg8::MoeOrder, false>(F.lds, g, S, E, F.tid);
    } SEAM(PH_MOE2_1);
    if (IN(PH_COMB1)) { FRESH(); phase_combine<false>(F, 1, WSP(bf16_t, OFF_XA), F.out, false); }
#endif
#undef IN
#undef SEAM
#undef FRESH
}

#ifndef ONE_LAUNCH
#define ONE_LAUNCH 1
#endif
extern "C" void kernel_launch(void* const* d_in, const int* in_sizes, int n_in, void* d_out, int out_size, void* d_ws, size_t ws_size, hipStream_t stream) {
    static int grid = 0;
    if (grid == 0) {
        int dev = 0, cus = 0, per_cu = 0;
        if (n_in != 43 || ws_size < WS_NEED) { fprintf(stderr, "kernel_launch: unexpected inputs (%d) or workspace (%zu < %zu)\n", n_in, ws_size, (size_t)WS_NEED); grid = -1; return; }
        if (hipGetDevice(&dev) != hipSuccess || hipDeviceGetAttribute(&cus, hipDeviceAttributeMultiprocessorCount, dev) != hipSuccess) { grid = -1; return; }
        if (hipFuncSetAttribute((const void*)fwd, hipFuncAttributeMaxDynamicSharedMemorySize, LDS_BYTES) != hipSuccess) { fprintf(stderr, "kernel_launch: hipFuncSetAttribute failed\n"); grid = -1; return; }
        if (hipOccupancyMaxActiveBlocksPerMultiprocessor(&per_cu, (const void*)fwd, NTHR, LDS_BYTES) != hipSuccess || per_cu < 1) { fprintf(stderr, "kernel_launch: occupancy query says %d\n", per_cu); (void)hipGetLastError(); }
        grid = cus;
    }
    if (grid < 0) return;
    (void)hipMemsetAsync((char*)d_ws + OFF_BAR, 0, 16384, stream);
    Args a{};
    for (int i = 0; i < 43; ++i) a.in[i] = (const float*)d_in[i];
    a.out = (float*)d_out; a.ws = (unsigned char*)d_ws;
#if ONE_LAUNCH
    a.ph_lo = 0; a.ph_hi = N_PHASES;
    hipLaunchKernelGGL(fwd, dim3(grid), dim3(NTHR), LDS_BYTES, stream, a);
#else
    for (int ph = 0; ph < N_PHASES; ++ph) { a.ph_lo = ph; a.ph_hi = ph + 1; hipLaunchKernelGGL(fwd, dim3(grid), dim3(NTHR), LDS_BYTES, stream, a); }
#endif
}
```

```cpp
#include <hip/hip_runtime.h>
#include <stdint.h>
#include <stdio.h>

#define LAS __attribute__((address_space(3)))
typedef unsigned short bf16_t;
typedef short bf16x8 __attribute__((ext_vector_type(8)));
typedef short bf16x4 __attribute__((ext_vector_type(4)));
typedef float f32x4 __attribute__((ext_vector_type(4)));
typedef float f32x16 __attribute__((ext_vector_type(16)));
typedef unsigned u32x4 __attribute__((ext_vector_type(4)));
typedef unsigned u32x2 __attribute__((ext_vector_type(2)));

constexpr int T_ = 16384, D_ = 1024, B_ = 4, S_ = 4096, E_ = 16, CAP_ = 512, F_ = 2816;
constexpr int NTHR = 512;
constexpr int LDS_MAIN = 155648;
constexpr int LDS_BYTES = LDS_MAIN + 64;

constexpr size_t al256(size_t x) { return (x + 255) & ~(size_t)255; }
constexpr size_t OFF_BAR    = 0;
constexpr size_t OFF_MOD    = 16384;
constexpr size_t OFF_WIN0T  = OFF_MOD    + al256((size_t)2 * 4 * 6144 * 4);
constexpr size_t OFF_WGLUT  = OFF_WIN0T  + (size_t)2560 * 1024 * 2;
constexpr size_t OFF_WOUT0T = OFF_WGLUT  + (size_t)512 * 512 * 2;
constexpr size_t OFF_WIN1T  = OFF_WOUT0T + (size_t)1024 * 1024 * 2;
constexpr size_t OFF_WVT    = OFF_WIN1T  + (size_t)3072 * 1024 * 2;
constexpr size_t OFF_WOUT1T = OFF_WVT    + (size_t)512 * 1024 * 2;
constexpr size_t OFF_WLORAT = OFF_WOUT1T + (size_t)1024 * 1024 * 2;
constexpr size_t OFF_W1T    = OFF_WLORAT + (size_t)2560 * 384 * 2;
constexpr size_t W1T_LAYER  = (size_t)16 * 5632 * 1024 * 2;
constexpr size_t OFF_W2T    = OFF_W1T    + 2 * W1T_LAYER;
constexpr size_t W2T_LAYER  = (size_t)16 * 1024 * 2816 * 2;
constexpr size_t OFF_HB     = OFF_W2T    + 2 * W2T_LAYER;
constexpr size_t OFF_XA     = OFF_HB     + (size_t)T_ * 1024 * 2;
constexpr size_t OFF_XB     = OFF_XA     + (size_t)T_ * 1024 * 4;
constexpr size_t OFF_YMIX   = OFF_XB     + (size_t)T_ * 1024 * 4;
constexpr size_t OFF_YCAT   = OFF_YMIX   + (size_t)T_ * 1024 * 4;
constexpr size_t OFF_PROBS  = OFF_YCAT   + (size_t)T_ * 1024 * 2;
constexpr size_t OFF_ROWTOK = OFF_PROBS  + (size_t)4 * 16 * 4096 * 4;
constexpr size_t OFF_GATEV  = OFF_ROWTOK + (size_t)32768 * 4;
constexpr size_t OFF_SLOT   = OFF_GATEV  + (size_t)32768 * 4;
constexpr size_t OFF_SCR    = OFF_SLOT   + (size_t)T_ * 16 * 4;
constexpr size_t OFF_P0     = OFF_SCR;
constexpr size_t OFF_GB0    = OFF_P0     + (size_t)T_ * 2560 * 2;
constexpr size_t OFF_QKVN   = OFF_GB0    + (size_t)T_ * 16 * 4;
constexpr size_t OFF_DNO    = OFF_QKVN   + (size_t)T_ * 1536 * 4;
constexpr size_t OFF_S5Y    = OFF_DNO    + (size_t)2 * T_ * 512 * 4;
constexpr size_t OFF_YS5    = OFF_S5Y    + (size_t)2 * T_ * 512 * 4;
constexpr size_t OFF_DN_GCS = OFF_YS5    + (size_t)T_ * 512 * 2;
constexpr size_t OFF_DN_AM  = OFF_DN_GCS + (size_t)2048 * 64 * 4;
constexpr size_t OFF_DN_TM  = OFF_DN_AM  + (size_t)2048 * 4096 * 2;
constexpr size_t OFF_DN_QE  = OFF_DN_TM  + (size_t)2048 * 4096 * 2;
constexpr size_t OFF_DN_YI  = OFF_DN_QE  + (size_t)2048 * 8192 * 2;
constexpr size_t OFF_DN_PHI = OFF_DN_YI  + (size_t)2048 * 16384;
constexpr size_t OFF_DN_C   = OFF_DN_PHI + (size_t)2048 * 32768;
constexpr size_t END_L0     = OFF_DN_C   + (size_t)2048 * 32768;
constexpr size_t OFF_HBUF   = OFF_SCR;
constexpr size_t OFF_YBUF   = OFF_HBUF   + (size_t)32768 * 2816 * 2;
constexpr size_t END_MOE    = OFF_YBUF   + (size_t)32768 * 1024 * 2;
constexpr size_t OFF_P1     = OFF_SCR;
constexpr size_t OFF_VIMG   = OFF_P1     + (size_t)T_ * 3072 * 2;
constexpr size_t OFF_RWR    = OFF_VIMG   + (size_t)512 * T_ * 2;
constexpr size_t OFF_RWK    = OFF_RWR    + (size_t)T_ * 512 * 2;
constexpr size_t OFF_RWV    = OFF_RWK    + (size_t)T_ * 512 * 2;
constexpr size_t OFF_RWKK   = OFF_RWV    + (size_t)T_ * 512 * 2;
constexpr size_t OFF_LORAIN = OFF_RWKK   + (size_t)T_ * 512 * 2;
constexpr size_t OFF_RWDEC  = OFF_LORAIN + (size_t)T_ * 384 * 2;
constexpr size_t OFF_RWA    = OFF_RWDEC  + (size_t)2 * T_ * 512 * 4;
constexpr size_t OFF_RWG    = OFF_RWA    + (size_t)2 * T_ * 512 * 2;
constexpr size_t OFF_RW_MAB = OFF_RWG    + (size_t)T_ * 512 * 2;
constexpr size_t OFF_RW_QE  = OFF_RW_MAB;
constexpr size_t OFF_RW_YI  = OFF_RW_MAB + 8192;
constexpr size_t OFF_RW_X1T = OFF_RW_MAB + (size_t)4096 * 16384;
constexpr size_t OFF_RW_GRB = OFF_RW_X1T + (size_t)4096 * 8192;
constexpr size_t OFF_RWY    = OFF_RW_X1T;
constexpr size_t OFF_RW_GRK = OFF_RW_GRB + (size_t)4096 * 8192;
constexpr size_t OFF_RW_TM  = OFF_RW_GRK + (size_t)4096 * 8192;
constexpr size_t OFF_RW_PL  = OFF_RW_TM  + (size_t)4096 * 8192;
constexpr size_t OFF_RW_PHI = OFF_RW_PL  + (size_t)4096 * 256;
constexpr size_t OFF_RW_C   = OFF_RW_PHI + (size_t)4096 * 8192;
constexpr size_t END_L1     = OFF_RW_C   + (size_t)4096 * 8192;
static_assert((size_t)2 * T_ * 512 * 4 == (size_t)2 * 4096 * 8192, "rwy aliases X1T | GRB");
constexpr size_t WS_NEED    = END_L1 > END_L0 ? (END_L1 > END_MOE ? END_L1 : END_MOE) : (END_L0 > END_MOE ? END_L0 : END_MOE);
static_assert(WS_NEED < (size_t)1470000000, "workspace budget");

struct Args { const float* in[43]; float* out; unsigned char* ws; int ph_lo, ph_hi; };

enum { I_X = 0, I_C, I_ADA_W, I_ADA_B, I_NMIX_PRE, I_NMIX_POST, I_NFFN_PRE, I_NFFN_POST, I_ROUTER, I_WGATE, I_WUP, I_WDOWN,
       I_AB_IN, I_AB_OUT, I_DN_CONV, I_DN_ALOG, I_DN_DTB, I_DN_NORM, I_S5_ARE, I_S5_AIM, I_S5_LDT, I_S5_BRE, I_S5_BIM, I_S5_CRE, I_S5_CIM,
       I_S5_D, I_S5_GLUW, I_S5_GLUB, I_CD_IN, I_CD_OUT, I_RW_MU, I_RW_W0, I_RW_W2, I_RW_A0, I_RW_A2, I_RW_G2, I_RW_KK, I_RW_KA, I_RW_RK,
       I_RW_LNW, I_RW_LNB, I_DF_LAM, I_DF_SUBLN };

__device__ __forceinline__ bf16_t f2bf(float f) { unsigned u = __float_as_uint(f); u += 0x7FFFu + ((u >> 16) & 1u); return (bf16_t)(u >> 16); }
__device__ __forceinline__ float bf2f(bf16_t b) { return __uint_as_float(((unsigned)b) << 16); }
typedef __bf16 bf16v2_t __attribute__((ext_vector_type(2)));
typedef float f32x2_t __attribute__((ext_vector_type(2)));
#ifdef SOFT_CVT
__device__ __forceinline__ unsigned pk2(float lo, float hi) { return (unsigned)f2bf(lo) | ((unsigned)f2bf(hi) << 16); }
#else
__device__ __forceinline__ unsigned pk2(float lo, float hi) { const f32x2_t v = {lo, hi}; const bf16v2_t b = __builtin_convertvector(v, bf16v2_t); return __builtin_bit_cast(unsigned, b); }
#endif
__device__ __forceinline__ float bflo(unsigned u) { return __uint_as_float(u << 16); }
__device__ __forceinline__ float bfhi(unsigned u) { return __uint_as_float(u & 0xFFFF0000u); }
__device__ __forceinline__ float wave_sum(float v) {
#pragma unroll
    for (int o = 32; o; o >>= 1) v += __shfl_xor(v, o);
    return v;
}
#ifdef SLOW_SIGMOID
__device__ __forceinline__ float sigmoidf_(float x) { return 1.f / (1.f + __expf(-x)); }
__device__ __forceinline__ float siluf_(float x) { return x / (1.f + __expf(-x)); }
#else
__device__ __forceinline__ float sigmoidf_(float x) { return __builtin_amdgcn_rcpf(1.f + __builtin_amdgcn_exp2f(-1.4426950408889634f * x)); }
__device__ __forceinline__ float siluf_(float x) { return x * sigmoidf_(x); }
#endif
__device__ __forceinline__ float softplusf_(float x) { return fmaxf(x, 0.f) + __logf(1.f + __expf(-fabsf(x))); }
__device__ __forceinline__ float gelu_tanhf_(float x) { const float u = 0.7978845608028654f * (x + 0.044715f * x * x * x); const float t = 2.f / (1.f + __expf(-2.f * u)) - 1.f; return 0.5f * x * (1.f + t); }
template <int CTRL> __device__ __forceinline__ float dppf(float x) { return __int_as_float(__builtin_amdgcn_update_dpp(0, __float_as_int(x), CTRL, 0xF, 0xF, true)); }
__device__ __forceinline__ float row16_sum(float x) { x += dppf<0x128>(x); x += dppf<0x124>(x); x += dppf<0x122>(x); x += dppf<0x121>(x); return x; }

#define XB_TMO      128
#define XB_XCNT(j)  (256  + 64 * (j))
#define XB_XSUB(j)  (1280 + 64 * (j))
#define XB_XGEN(j)  (2304 + 64 * (j))
#define XB_TOP      3328
#define XB_TOPGEN   3392
#define XB_RWFLAG   3520
#define XCD_BAR_WORDS 3456
#define XB_SPIN_CAP (1u << 27)
__device__ __forceinline__ unsigned xb_ld(unsigned* p)              { return __hip_atomic_load(p, __ATOMIC_RELAXED, __HIP_MEMORY_SCOPE_AGENT); }
__device__ __forceinline__ unsigned xb_add(unsigned* p, unsigned v) { return __hip_atomic_fetch_add(p, v, __ATOMIC_RELAXED, __HIP_MEMORY_SCOPE_AGENT); }
__device__ __forceinline__ unsigned xb_xcc_id() { return (unsigned)__builtin_amdgcn_s_getreg((3 << 11) | 20) & 0xFu; }
#define XB_SPIN(cond, bar) do { unsigned _sp = 0; while (cond) { __builtin_amdgcn_s_sleep(1); \
    if ((++_sp & 255u) == 0u) { if (xb_ld(&(bar)[XB_TMO])) break; if (_sp > XB_SPIN_CAP) { atomicAdd(&(bar)[XB_TMO], 1u); break; } } } } while (0)
struct XcdBarrier { unsigned* bar; unsigned x; volatile LAS unsigned* st; };
__device__ __forceinline__ int my_lane() { int l; asm volatile("v_mbcnt_lo_u32_b32 %0, -1, 0\n\tv_mbcnt_hi_u32_b32 %0, -1, %0" : "=v"(l)); return l; }
__device__ __forceinline__ XcdBarrier xcd_barrier_post(unsigned* bar, volatile LAS unsigned* st, int tid) {
    XcdBarrier b; b.bar = bar; b.x = xb_xcc_id(); b.st = st;
    if (tid == 0) (void)xb_add(&bar[XB_XCNT(b.x)], 1u);
    return b;
}
__device__ __forceinline__ void xcd_barrier_complete(unsigned* bar, unsigned x, unsigned& nloc, unsigned& nx) {
    const unsigned G = gridDim.x * gridDim.y * gridDim.z;
    unsigned sum, cnt, mine, sp = 0u;
    for (;;) {
        sum = 0u; cnt = 0u; mine = 0u;
#pragma unroll
        for (unsigned j = 0; j < 16; ++j) { const unsigned c = xb_ld(&bar[XB_XCNT(j)]); sum += c; cnt += (c > 0u) ? 1u : 0u; mine = (j == x) ? c : mine; }
        if (sum == G) break;
        __builtin_amdgcn_s_sleep(1);
        if ((++sp & 255u) == 0u) { if (xb_ld(&bar[XB_TMO])) break; if (sp > XB_SPIN_CAP) { atomicAdd(&bar[XB_TMO], 1u); break; } }
    }
    nloc = mine > 0u ? mine : 1u; nx = cnt > 0u ? cnt : 1u;
}
__device__ __forceinline__ void xcd_barrier(const XcdBarrier& b, int tid) {
    asm volatile("s_waitcnt vmcnt(0)" ::: "memory");
    __syncthreads();
    if (tid == 0) {
        unsigned* bar = b.bar;
        __builtin_amdgcn_s_waitcnt(0);
        unsigned nloc = b.st[0], nx = b.st[1];
        if (nloc == 0u) { xcd_barrier_complete(bar, b.x, nloc, nx); b.st[0] = nloc; b.st[1] = nx; }
        const unsigned old = xb_add(&bar[XB_XSUB(b.x)], 1u);
        const unsigned gen = old / nloc;
        if (old + 1u == (gen + 1u) * nloc) {
            __builtin_amdgcn_fence(__ATOMIC_RELEASE, "agent");
            asm volatile("s_waitcnt vmcnt(0)" ::: "memory");
            const unsigned og = xb_add(&bar[XB_TOP], 1u);
            const unsigned tg = og / nx;
            if (og + 1u == (tg + 1u) * nx) xb_add(&bar[XB_TOPGEN], 1u);
            else XB_SPIN(xb_ld(&bar[XB_TOPGEN]) == tg, bar);
            __builtin_amdgcn_fence(__ATOMIC_ACQUIRE, "agent");
            xb_add(&bar[XB_XGEN(b.x)], 1u);
            asm volatile("s_waitcnt vmcnt(0)" ::: "memory");
        } else {
            XB_SPIN(xb_ld(&bar[XB_XGEN(b.x)]) == gen, bar);
            __builtin_amdgcn_fence(__ATOMIC_ACQUIRE, "agent");
            asm volatile("s_waitcnt vmcnt(0)" ::: "memory");
        }
    }
    __syncthreads();
}

namespace pg8 {
constexpr int BM = 256, BK = 64, HALF = 128, HTB = HALF * BK * 2, STAGE_BYTES = 8 * HTB, NXCD = 8, WGM = 8;
__host__ __device__ __forceinline__ int lds_byte(int r, int c) { const int st = (r >> 4) * 2 + (c >> 5), rr = r & 15, cc = c & 31, ob = rr * 64 + cc * 2; return st * 1024 + (ob ^ (((ob >> 9) & 1) << 5)); }
__host__ __device__ __forceinline__ void stage_rc(int b, int& R, int& C) { const int st = b / 1024, sb = b % 1024, swz = sb ^ (((sb >> 9) & 1) << 5); R = (st >> 1) * 16 + swz / 64; C = (st & 1) * 32 + (swz % 64) / 2; }
__host__ __device__ __forceinline__ int perm32(int rho) { const int n = rho >> 4, i = rho & 15; return 8 * (i >> 2) + 4 * n + (i & 3); }
struct Unit { int pm, pn; };
struct Gemm { const bf16_t* A; const bf16_t* Bt; int lda, ldb, K; const int* rowidx; size_t kstepB = 0, tstepB = 0; };

struct StaticOrder {
    int nM, nN, nwg, G, c;
    __device__ void init(int M, int N, int G_, int c_) { nM = M / BM; nN = N / BM; nwg = nM * nN; G = G_; c = c_; }
    __device__ bool next(int i, Unit& u) const {
        const long L = (long)i * G + c; if (L >= nwg) return false;
        int wgid = (int)L; { const int q = nwg / NXCD, r = nwg % NXCD, xcd = wgid % NXCD, off = wgid / NXCD; wgid = (xcd < r ? xcd * (q + 1) : r * (q + 1) + (xcd - r) * q) + off; }
        const int nig = WGM * nN, gid = wgid / nig, fm = gid * WGM, gsz = (nM - fm) < WGM ? (nM - fm) : WGM;
        u.pm = fm + ((wgid % nig) % gsz); u.pn = (wgid % nig) / gsz; return true;
    }
};
struct MoeOrder {
    int per_e, npn, G, c;
    __device__ bool next(int i, Unit& u) const {
        const int nwg = 16 * per_e; const long L = (long)i * G + c; if (L >= nwg) return false;
        int wgid = (int)L; { const int q = nwg / NXCD, xcd = wgid % NXCD, off = wgid / NXCD; wgid = xcd * q + off; }
        const int e = wgid / per_e, r = wgid % per_e; u.pm = e * 8 + (r & 7); u.pn = e * npn + (r >> 3); return true;
    }
};

__device__ __forceinline__ unsigned cvt_pk_bf16(float lo, float hi) { const f32x2_t v = {lo, hi}; const bf16v2_t b = __builtin_convertvector(v, bf16v2_t); return __builtin_bit_cast(unsigned, b); }

template <class Epi, class Sched, bool GATHER>
__device__ __forceinline__ void gemm_phase(LAS unsigned char* lds, const Gemm g, const Sched& S, const Epi& E, int tid_) {
    const int tid = tid_, wid = __builtin_amdgcn_readfirstlane(tid >> 6), lane = tid & 63, wr = wid >> 2, wc = wid & 3, fr = lane & 15, fq = lane >> 4;
    const int K = g.K, nt = K / BK;
    int Rr[2], Cc[2]; unsigned voffA[2], voffB[2];
#pragma unroll
    for (int i = 0; i < 2; ++i) { int R, C; stage_rc(tid * 16 + i * 8192, R, C); const int Rb = Epi::PERM ? ((R & ~31) + perm32(R & 31)) : R;
        Rr[i] = R; Cc[i] = C; voffA[i] = (unsigned)(R * g.lda + C) * 2u; voffB[i] = (unsigned)(Rb * g.ldb + C) * 2u; }
    const size_t kstep = (size_t)(BK * 2);
    const size_t hstepA = (size_t)HALF * g.lda * 2, tstepA = 2 * hstepA;
    const size_t hstepB = (size_t)HALF * g.ldb * 2, tstepB = g.tstepB ? g.tstepB : 2 * hstepB, kstepB = g.kstepB ? g.kstepB : kstep;
    const unsigned ldsw = (unsigned)wid * 1024u;
    const int aoff = lds_byte(wr * 64 + fr, fq * 8), boff = lds_byte(wc * 32 + fr, fq * 8);
    const unsigned lda2 = (unsigned)g.lda * 2u;
#define PG8_AOFF(vo, pm_) do { _Pragma("unroll") for (int _h = 0; _h < 2; ++_h) _Pragma("unroll") for (int _i = 0; _i < 2; ++_i) { const int _row = (pm_) * 256 + _h * 128 + Rr[_i]; \
        (vo)[_h][_i] = (unsigned)g.rowidx[_row] * lda2 + (unsigned)Cc[_i] * 2u; } } while (0)
#define PG8_SA(b, h) (((b) * 2 + (h)) * HTB)
#define PG8_SB(b, h) ((4 + (b) * 2 + (h)) * HTB)
#define PG8_STAGE_B(bufoff, gbase) do { _Pragma("unroll") for (int _i = 0; _i < 2; ++_i) \
        __builtin_amdgcn_global_load_lds((const unsigned*)((const char*)(gbase) + voffB[_i]), (LAS unsigned*)(lds + (bufoff) + ldsw + _i * 8192), 16, 0, 0); } while (0)
#define PG8_STAGE_A(bufoff, uptr, voh, kb) do { _Pragma("unroll") for (int _i = 0; _i < 2; ++_i) { \
        const char* _p = GATHER ? ((const char*)g.A + (size_t)(voh)[_i] + (kb)) : ((const char*)(uptr) + voffA[_i]); \
        __builtin_amdgcn_global_load_lds((const unsigned*)_p, (LAS unsigned*)(lds + (bufoff) + ldsw + _i * 8192), 16, 0, 0); } } while (0)
#define PG8_LDA(dst, b, h) do { _Pragma("unroll") for (int m = 0; m < 4; ++m) _Pragma("unroll") for (int k = 0; k < 2; ++k) dst[m][k] = *(const LAS bf16x8*)(lds + PG8_SA(b, h) + aoff + m * 2048 + k * 1024); } while (0)
#define PG8_LDB(dst, b, h) do { _Pragma("unroll") for (int n = 0; n < 2; ++n) _Pragma("unroll") for (int k = 0; k < 2; ++k) dst[n][k] = *(const LAS bf16x8*)(lds + PG8_SB(b, h) + boff + n * 2048 + k * 1024); } while (0)
#define PG8_MMA(ai, bj, At, Bt) do { __builtin_amdgcn_s_setprio(1); _Pragma("unroll") for (int m = 0; m < 4; ++m) _Pragma("unroll") for (int n = 0; n < 2; ++n) _Pragma("unroll") for (int k = 0; k < 2; ++k) \
        acc[ai][bj][m][n] = __builtin_amdgcn_mfma_f32_16x16x32_bf16(Bt[n][k], At[m][k], acc[ai][bj][m][n], 0, 0, 0); __builtin_amdgcn_s_setprio(0); } while (0)
#define PG8_WAIT_V(n) asm volatile("s_waitcnt vmcnt(" #n ")" ::: "memory")
#define PG8_WAIT_L(n) asm volatile("s_waitcnt lgkmcnt(" #n ")" ::: "memory")
#define PG8_BAR __builtin_amdgcn_s_barrier()
#define PG8_SCHED __builtin_amdgcn_sched_barrier(0)
    Unit cur, nxt; int ui = 0;
    if (!S.next(0, cur)) return;
    f32x4 acc[2][2][4][2];
#pragma unroll
    for (int a = 0; a < 2; ++a)
#pragma unroll
        for (int b = 0; b < 2; ++b)
#pragma unroll
            for (int m = 0; m < 4; ++m)
#pragma unroll
                for (int n = 0; n < 2; ++n) acc[a][b][m][n] = (f32x4){0.f, 0.f, 0.f, 0.f};
    bf16x8 At[4][2], B0[2][2], B1[2][2];
    unsigned vcur[2][2], vnxt[2][2];
    if (GATHER) { PG8_AOFF(vcur, cur.pm); }
    else {
#pragma unroll
        for (int h = 0; h < 2; ++h)
#pragma unroll
            for (int i = 0; i < 2; ++i) vcur[h][i] = 0u; }
    const char* cA = (const char*)g.A + (GATHER ? (size_t)0 : (size_t)cur.pm * tstepA);
    const char* cB = (const char*)g.Bt + (size_t)cur.pn * tstepB;
    PG8_STAGE_B(PG8_SB(0, 0), cB); PG8_STAGE_A(PG8_SA(0, 0), cA, vcur[0], 0); PG8_STAGE_B(PG8_SB(0, 1), cB + hstepB); PG8_STAGE_A(PG8_SA(0, 1), cA + hstepA, vcur[1], 0);
    if (wr == 1) PG8_BAR;
    PG8_WAIT_V(4); PG8_BAR;
    PG8_STAGE_B(PG8_SB(1, 0), cB + kstepB); PG8_STAGE_A(PG8_SA(1, 0), cA + kstep, vcur[0], kstep); PG8_STAGE_B(PG8_SB(1, 1), cB + hstepB + kstepB);
    PG8_WAIT_V(6); PG8_BAR;
    for (;;) {
        const bool has_next = S.next(ui + 1, nxt);
        if (GATHER) {
            if (has_next) { PG8_AOFF(vnxt, nxt.pm); }
            else {
#pragma unroll
                for (int h = 0; h < 2; ++h)
#pragma unroll
                    for (int i = 0; i < 2; ++i) vnxt[h][i] = vcur[h][i]; } }
        const char* nA = (has_next && !GATHER) ? (const char*)g.A + (size_t)nxt.pm * tstepA : cA;
        const char* nB = has_next ? (const char*)g.Bt + (size_t)nxt.pn * tstepB : cB;
#pragma nounroll
        for (int t = 0; t < nt; t += 2) {
            const bool last = (t == nt - 2);
            const size_t kb1 = (size_t)(t + 1) * kstep;
            const size_t kb2 = last ? (size_t)0 : (size_t)(t + 2) * kstep, kb3 = kb2 + kstep;
            unsigned va2[2][2];
#pragma unroll
            for (int h = 0; h < 2; ++h)
#pragma unroll
                for (int i = 0; i < 2; ++i) va2[h][i] = (GATHER && last) ? vnxt[h][i] : vcur[h][i];
            const char* a1 = cA + kb1;
            const char* a2 = last ? nA : cA + kb2; const char* a3 = a2 + kstep;
            const char* b2 = last ? nB : cB + (size_t)(t + 2) * kstepB; const char* b3 = b2 + kstepB;
            PG8_LDB(B0, 0, 0); PG8_SCHED; PG8_LDA(At, 0, 0); PG8_STAGE_A(PG8_SA(1, 1), a1 + hstepA, vcur[1], kb1);
            PG8_WAIT_L(8); PG8_BAR; PG8_WAIT_L(0); PG8_MMA(0, 0, At, B0); PG8_BAR; PG8_SCHED;
            PG8_LDB(B1, 0, 1); PG8_STAGE_B(PG8_SB(0, 0), b2);
            PG8_BAR; PG8_WAIT_L(0); PG8_MMA(0, 1, At, B1); PG8_BAR;
            PG8_LDA(At, 0, 1); PG8_STAGE_A(PG8_SA(0, 0), a2, va2[0], kb2);
            PG8_BAR; PG8_WAIT_L(0); PG8_MMA(1, 0, At, B0); PG8_BAR; PG8_SCHED;
            PG8_STAGE_B(PG8_SB(0, 1), b2 + hstepB);
            PG8_WAIT_V(6); PG8_BAR; PG8_MMA(1, 1, At, B1); PG8_BAR;
            PG8_LDB(B0, 1, 0); PG8_SCHED; PG8_LDA(At, 1, 0); PG8_STAGE_A(PG8_SA(0, 1), a2 + hstepA, va2[1], kb2);
            PG8_WAIT_L(8); PG8_BAR; PG8_WAIT_L(0); PG8_MMA(0, 0, At, B0); PG8_BAR; PG8_SCHED;
            PG8_LDB(B1, 1, 1); PG8_STAGE_B(PG8_SB(1, 0), b3);
            PG8_BAR; PG8_WAIT_L(0); PG8_MMA(0, 1, At, B1); PG8_BAR;
            PG8_LDA(At, 1, 1); PG8_STAGE_A(PG8_SA(1, 0), a3, va2[0], kb3);
            PG8_BAR; PG8_WAIT_L(0); PG8_MMA(1, 0, At, B0); PG8_BAR; PG8_SCHED;
            PG8_STAGE_B(PG8_SB(1, 1), b3 + hstepB);
            PG8_WAIT_V(6); PG8_BAR; PG8_MMA(1, 1, At, B1); PG8_BAR;
        }
        { int tz = tid; asm volatile("" : "+v"(tz));
          const int wid2 = __builtin_amdgcn_readfirstlane(tz >> 6), lane2 = tz & 63; E(acc, cur, wid2 >> 2, wid2 & 3, lane2 & 15, lane2 >> 4); }
        if (!has_next) break;
#pragma unroll
        for (int a = 0; a < 2; ++a)
#pragma unroll
            for (int b = 0; b < 2; ++b)
#pragma unroll
                for (int m = 0; m < 4; ++m)
#pragma unroll
                    for (int n = 0; n < 2; ++n) acc[a][b][m][n] = (f32x4){0.f, 0.f, 0.f, 0.f};
        cur = nxt; cA = nA; cB = nB; ++ui;
#pragma unroll
        for (int h = 0; h < 2; ++h)
#pragma unroll
            for (int i = 0; i < 2; ++i) vcur[h][i] = vnxt[h][i];
    }
    PG8_WAIT_V(0);
    if (wr == 0) PG8_BAR;
    PG8_BAR;
#undef PG8_AOFF
#undef PG8_SA
#undef PG8_SB
#undef PG8_STAGE_A
#undef PG8_STAGE_B
#undef PG8_LDA
#undef PG8_LDB
#undef PG8_MMA
#undef PG8_WAIT_V
#undef PG8_WAIT_L
#undef PG8_BAR
#undef PG8_SCHED
}
}
using pg8::Unit;
typedef f32x4 AccT[2][2][4][2];
struct EpiBf16Plain {
    static constexpr bool PERM = true;
    bf16_t* O; int ldc; int ncols;
    __device__ __forceinline__ void operator()(const AccT& acc, const Unit& u, int wr, int wc, int fr, int fq) const {
        const int row0 = u.pm * 256 + wr * 64 + fr, col0 = u.pn * 256 + wc * 32 + 8 * fq;
#pragma unroll
        for (int ai = 0; ai < 2; ++ai)
#pragma unroll
            for (int m = 0; m < 4; ++m) { bf16_t* rowp = O + (size_t)(row0 + ai * 128 + m * 16) * ldc;
#pragma unroll
                for (int bj = 0; bj < 2; ++bj) { const int col = col0 + bj * 128; if (col < ncols) { const f32x4 v0 = acc[ai][bj][m][0], v1 = acc[ai][bj][m][1];
                    u32x4 pk; pk.x = pg8::cvt_pk_bf16(v0[0], v0[1]); pk.y = pg8::cvt_pk_bf16(v0[2], v0[3]); pk.z = pg8::cvt_pk_bf16(v1[0], v1[1]); pk.w = pg8::cvt_pk_bf16(v1[2], v1[3]);
                    *(u32x4*)(rowp + col) = pk; } } }
    }
};
struct EpiF32 {
    static constexpr bool PERM = false;
    float* C; int ldc;
    __device__ __forceinline__ void operator()(const AccT& acc, const Unit& u, int wr, int wc, int fr, int fq) const {
        const int row0 = u.pm * 256 + wr * 64 + fr, col0 = u.pn * 256 + wc * 32 + 4 * fq;
#pragma unroll
        for (int ai = 0; ai < 2; ++ai)
#pragma unroll
            for (int m = 0; m < 4; ++m) { float* rowp = C + (size_t)(row0 + ai * 128 + m * 16) * ldc + col0;
#pragma unroll
                for (int bj = 0; bj < 2; ++bj)
#pragma unroll
                    for (int n = 0; n < 2; ++n) *(f32x4*)(rowp + bj * 128 + n * 16) = acc[ai][bj][m][n]; }
    }
};
struct EpiGlu {
    static constexpr bool PERM = true;
    const bf16_t* ys5; const float* bias; bf16_t* ycat;
    __device__ __forceinline__ void operator()(const AccT& acc, const Unit& u, int wr, int wc, int fr, int fq) const {
        const int row0 = u.pm * 256 + wr * 64 + fr, col0 = u.pn * 256 + wc * 32 + 8 * fq;
#pragma unroll
        for (int bj = 0; bj < 2; ++bj) { const int col = col0 + bj * 128;
            const f32x4 b0 = *(const f32x4*)(bias + col), b1 = *(const f32x4*)(bias + col + 4);
#pragma unroll
            for (int ai = 0; ai < 2; ++ai)
#pragma unroll
                for (int m = 0; m < 4; ++m) { const int row = row0 + ai * 128 + m * 16;
                    const u32x4 yv = *(const u32x4*)(ys5 + (size_t)row * 512 + col);
                    const f32x4 v0 = acc[ai][bj][m][0] + b0, v1 = acc[ai][bj][m][1] + b1;
                    u32x4 pk;
                    pk.x = pg8::cvt_pk_bf16(bflo(yv.x) * sigmoidf_(v0[0]), bfhi(yv.x) * sigmoidf_(v0[1]));
                    pk.y = pg8::cvt_pk_bf16(bflo(yv.y) * sigmoidf_(v0[2]), bfhi(yv.y) * sigmoidf_(v0[3]));
                    pk.z = pg8::cvt_pk_bf16(bflo(yv.z) * sigmoidf_(v1[0]), bfhi(yv.z) * sigmoidf_(v1[1]));
                    pk.w = pg8::cvt_pk_bf16(bflo(yv.w) * sigmoidf_(v1[2]), bfhi(yv.w) * sigmoidf_(v1[3]));
                    *(u32x4*)(ycat + (size_t)row * 1024 + 512 + col) = pk; } }
    }
};
struct EpiSwiglu {
    static constexpr bool PERM = true;
    bf16_t* H;
    __device__ __forceinline__ void operator()(const AccT& acc, const Unit& u, int wr, int wc, int fr, int fq) const {
        const int e = u.pm >> 3; const int row0 = u.pm * 256 + wr * 64 + fr, col0 = (u.pn - e * 22) * 128 + wc * 32 + 8 * fq;
#pragma unroll
        for (int ai = 0; ai < 2; ++ai)
#pragma unroll
            for (int m = 0; m < 4; ++m) { const f32x4 g0 = acc[ai][0][m][0], g1 = acc[ai][0][m][1], u0 = acc[ai][1][m][0], u1 = acc[ai][1][m][1];
                u32x4 pk;
                pk.x = pg8::cvt_pk_bf16(siluf_(g0[0]) * u0[0], siluf_(g0[1]) * u0[1]); pk.y = pg8::cvt_pk_bf16(siluf_(g0[2]) * u0[2], siluf_(g0[3]) * u0[3]);
                pk.z = pg8::cvt_pk_bf16(siluf_(g1[0]) * u1[0], siluf_(g1[1]) * u1[1]); pk.w = pg8::cvt_pk_bf16(siluf_(g1[2]) * u1[2], siluf_(g1[3]) * u1[3]);
                *(u32x4*)(H + (size_t)(row0 + ai * 128 + m * 16) * F_ + col0) = pk; }
    }
};
struct EpiDown {
    static constexpr bool PERM = true;
    bf16_t* Y; const float* gatev;
    __device__ __forceinline__ void operator()(const AccT& acc, const Unit& u, int wr, int wc, int fr, int fq) const {
        const int e = u.pm >> 3; const int row0 = u.pm * 256 + wr * 64 + fr, col0 = (u.pn - e * 4) * 256 + wc * 32 + 8 * fq;
#pragma unroll
        for (int ai = 0; ai < 2; ++ai)
#pragma unroll
            for (int m = 0; m < 4; ++m) { const int row = row0 + ai * 128 + m * 16; const float gt = gatev[row];
#pragma unroll
                for (int bj = 0; bj < 2; ++bj) { const f32x4 v0 = acc[ai][bj][m][0], v1 = acc[ai][bj][m][1];
                    u32x4 pk; pk.x = pg8::cvt_pk_bf16(v0[0] * gt, v0[1] * gt); pk.y = pg8::cvt_pk_bf16(v0[2] * gt, v0[3] * gt); pk.z = pg8::cvt_pk_bf16(v1[0] * gt, v1[1] * gt); pk.w = pg8::cvt_pk_bf16(v1[2] * gt, v1[3] * gt);
                    *(u32x4*)(Y + (size_t)row * 1024 + col0 + bj * 128) = pk; } }
    }
};
struct EpiVimg {
    static constexpr bool PERM = false;
    bf16_t* V;
    __device__ __forceinline__ void operator()(const AccT& acc, const Unit& u, int wr, int wc, int fr, int fq) const {
        const int row0 = u.pm * 256 + wr * 64 + fr, col0 = u.pn * 256 + wc * 32 + 4 * fq;
#pragma unroll
        for (int ai = 0; ai < 2; ++ai)
#pragma unroll
            for (int m = 0; m < 4; ++m) { const int row = row0 + ai * 128 + m * 16, h = row >> 7, dv = row & 127;
#pragma unroll
                for (int bj = 0; bj < 2; ++bj)
#pragma unroll
                    for (int n = 0; n < 2; ++n) { const int tok = col0 + bj * 128 + n * 16, b = tok >> 12, s = tok & 4095, kt = s >> 6, un = (s & 63) >> 2;
                        const f32x4 v = acc[ai][bj][m][n]; u32x2 pk; pk.x = pg8::cvt_pk_bf16(v[0], v[1]); pk.y = pg8::cvt_pk_bf16(v[2], v[3]);
                        *(u32x2*)(V + (((size_t)(b * 4 + h) * 64 + kt) * 2048 + (((un >> 2) * 2 + (un & 1)) * 128 + dv) * 2 + ((un >> 1) & 1)) * 4) = pk; } }
    }
};
struct EpiLora {
    static constexpr bool PERM = false;
    float* ev; bf16_t* av; bf16_t* gv; const float* w0; const float* a0;
    __device__ __forceinline__ void operator()(const AccT& acc, const Unit& u, int wr, int wc, int fr, int fq) const {
        const int row0 = u.pm * 256 + wr * 64 + fr, colt = u.pn * 256, kind = colt >> 9;
        const int cbase = (colt & 511) + wc * 32 + 4 * fq;
        if (kind < 2) {
            const float* addp = w0 + kind * 512; float* dst = ev + (size_t)kind * T_ * 512;
#pragma unroll
            for (int bj = 0; bj < 2; ++bj)
#pragma unroll
                for (int n = 0; n < 2; ++n) { const int c = cbase + bj * 128 + n * 16; const f32x4 ad = *(const f32x4*)(addp + c);
#pragma unroll
                    for (int ai = 0; ai < 2; ++ai)
#pragma unroll
                        for (int m = 0; m < 4; ++m) { const f32x4 v = acc[ai][bj][m][n] + ad; f32x4 o;
#pragma unroll
                            for (int q = 0; q < 4; ++q) o[q] = 0.6065306597126334f * sigmoidf_(v[q]);
                            *(f32x4*)(dst + (size_t)(row0 + ai * 128 + m * 16) * 512 + c) = o; asm volatile("" ::: "memory"); } }
        } else {
            const bool isa = kind < 4; const float* addp = a0 + ((kind - 2) & 1) * 512; bf16_t* dst = isa ? av + (size_t)(kind - 2) * T_ * 512 : gv;
#pragma unroll
            for (int bj = 0; bj < 2; ++bj)
#pragma unroll
                for (int n = 0; n < 2; ++n) { const int c = cbase + bj * 128 + n * 16; f32x4 ad = (f32x4){0.f, 0.f, 0.f, 0.f}; if (isa) ad = *(const f32x4*)(addp + c);
#pragma unroll
                    for (int ai = 0; ai < 2; ++ai)
#pragma unroll
                        for (int m = 0; m < 4; ++m) { const f32x4 v = acc[ai][bj][m][n] + ad; f32x4 o = v;
                            if (isa) {
#pragma unroll
                                for (int q = 0; q < 4; ++q) o[q] = sigmoidf_(v[q]); }
                            u32x2 pk; pk.x = pk2(o[0], o[1]); pk.y = pk2(o[2], o[3]);
                            *(u32x2*)(dst + (size_t)(row0 + ai * 128 + m * 16) * 512 + c) = pk; asm volatile("" ::: "memory"); } }
        }
    }
};

__device__ __forceinline__ bf16x8 as_frag(const u32x4 u) { union { u32x4 a; bf16x8 b; } x; x.a = u; return x.b; }
struct Frame {
    unsigned char* smem; LAS unsigned char* lds; int tid, lane, wid, bid, nblk;
    const float* const* in; float* out; unsigned char* ws; size_t z;
};
#define WSP(T, off) ((T*)(F.ws + ((off) + F.z)))

__device__ __forceinline__ void phase_mod(const Frame& F) {
    float* silu_c = (float*)F.smem; float* red = silu_c + 4096;
    const float* c = F.in[I_C];
    for (int i = F.tid; i < 4096; i += NTHR) silu_c[i] = siluf_(c[i]);
    __syncthreads();
    float* mod = WSP(float, OFF_MOD);
    for (int u = F.bid; u < 192; u += F.nblk) {
        const int l = u / 96, cg = u % 96, col = cg * 64 + F.lane;
        const float* W = F.in[I_ADA_W] + (size_t)l * 1024 * 6144 + col;
        float a0 = 0.f, a1 = 0.f, a2 = 0.f, a3 = 0.f;
        const int kb = F.wid * 128;
#pragma unroll 8
        for (int k = 0; k < 128; ++k) { const float w = W[(size_t)(kb + k) * 6144]; a0 += silu_c[kb + k] * w; a1 += silu_c[1024 + kb + k] * w; a2 += silu_c[2048 + kb + k] * w; a3 += silu_c[3072 + kb + k] * w; }
        red[(F.wid * 4 + 0) * 64 + F.lane] = a0; red[(F.wid * 4 + 1) * 64 + F.lane] = a1; red[(F.wid * 4 + 2) * 64 + F.lane] = a2; red[(F.wid * 4 + 3) * 64 + F.lane] = a3;
        __syncthreads();
        if (F.wid < 4) { float s = 0.f;
#pragma unroll
            for (int w = 0; w < 8; ++w) s += red[(w * 4 + F.wid) * 64 + F.lane];
            mod[(size_t)(l * 4 + F.wid) * 6144 + col] = s + F.in[I_ADA_B][l * 6144 + col]; }
        __syncthreads();
    }
}

struct CvtJob { const float* src; size_t lds_; bf16_t* dst; size_t ldd; };
#define CVT_LOAD(j, t, P) do { const int kp_ = (t) >> 5, nc_ = ((t) & 31) * 4; const float* s_ = (j).src + (size_t)(2 * kp_) * (j).lds_ + nc_; \
        P##0 = *(const float4*)(s_); P##1 = *(const float4*)(s_ + (j).lds_); P##2 = *(const float4*)(s_ + (size_t)32 * (j).lds_); P##3 = *(const float4*)(s_ + (size_t)33 * (j).lds_); \
        P##4 = *(const float4*)(s_ + (size_t)64 * (j).lds_); P##5 = *(const float4*)(s_ + (size_t)65 * (j).lds_); P##6 = *(const float4*)(s_ + (size_t)96 * (j).lds_); P##7 = *(const float4*)(s_ + (size_t)97 * (j).lds_); } while (0)
#define CVT_PUT(tl, a, b, kd) do { tl[(nc + 0) * 65 + ((nc + 0) >> 5) + (kd)] = pk2(a.x, b.x); tl[(nc + 1) * 65 + ((nc + 1) >> 5) + (kd)] = pk2(a.y, b.y); \
        tl[(nc + 2) * 65 + ((nc + 2) >> 5) + (kd)] = pk2(a.z, b.z); tl[(nc + 3) * 65 + ((nc + 3) >> 5) + (kd)] = pk2(a.w, b.w); } while (0)
__device__ __forceinline__ void cvt_store(bf16_t* dst, size_t ldd, int t, float4 r0, float4 r1, float4 r2, float4 r3, float4 r4, float4 r5, float4 r6, float4 r7, unsigned* tl) {
    const int kp = t >> 5, nc = (t & 31) * 4;
    CVT_PUT(tl, r0, r1, kp); CVT_PUT(tl, r2, r3, kp + 16); CVT_PUT(tl, r4, r5, kp + 32); CVT_PUT(tl, r6, r7, kp + 48);
    __syncthreads();
    const int kq = t & 15;
#pragma unroll
    for (int ps = 0; ps < 4; ++ps) { const int n = (t >> 4) + 32 * ps; const unsigned* rp = tl + n * 65 + (n >> 5) + kq * 4;
        bf16_t* d = ldd ? dst + (size_t)n * ldd + kq * 8 : dst + (kq >> 3) * 16384 + n * 64 + (kq & 7) * 8;
        *(uint4*)d = make_uint4(rp[0], rp[1], rp[2], rp[3]); }
}
__device__ __forceinline__ CvtJob cvt_job_small(const Frame& F, int x) {
    CvtJob j; int tt = x;
    if (tt < 128)               { const int kt = tt & 7, nt = tt >> 3; j.src = F.in[I_AB_IN] + (size_t)kt * 128 * 2576 + nt * 128; j.lds_ = 2576; j.dst = WSP(bf16_t, OFF_WIN0T) + (size_t)(nt * 128) * 1024 + kt * 128; j.ldd = 1024; }
    else if ((tt -= 128) < 32)  { const int kt = tt & 7, nt = tt >> 3; j.src = F.in[I_AB_IN] + (size_t)kt * 128 * 2576 + 2064 + nt * 128; j.lds_ = 2576; j.dst = WSP(bf16_t, OFF_WIN0T) + (size_t)(2048 + nt * 128) * 1024 + kt * 128; j.ldd = 1024; }
    else if ((tt -= 32) < 16)   { const int kt = tt & 3, nt = tt >> 2; j.src = F.in[I_S5_GLUW] + (size_t)kt * 128 * 512 + nt * 128; j.lds_ = 512; j.dst = WSP(bf16_t, OFF_WGLUT) + (size_t)(nt * 128) * 512 + kt * 128; j.ldd = 512; }
    else if ((tt -= 16) < 64)   { const int kt = tt & 7, nt = tt >> 3; j.src = F.in[I_AB_OUT] + (size_t)kt * 128 * 1024 + nt * 128; j.lds_ = 1024; j.dst = WSP(bf16_t, OFF_WOUT0T) + (size_t)(nt * 128) * 1024 + kt * 128; j.ldd = 1024; }
    else if ((tt -= 64) < 184)  { const int kt = tt & 7, nt = tt >> 3; j.src = F.in[I_CD_IN] + (size_t)kt * 128 * 3456 + nt * 128; j.lds_ = 3456; j.dst = WSP(bf16_t, OFF_WIN1T) + (size_t)(nt * 128) * 1024 + kt * 128; j.ldd = 1024; }
    else if ((tt -= 184) < 32)  { const int kt = tt & 7, nt = tt >> 3; j.src = F.in[I_CD_IN] + (size_t)kt * 128 * 3456 + 2944 + nt * 128; j.lds_ = 3456; j.dst = WSP(bf16_t, OFF_WVT) + (size_t)(nt * 128) * 1024 + kt * 128; j.ldd = 1024; }
    else { tt -= 32;              const int kt = tt & 7, nt = tt >> 3; j.src = F.in[I_CD_OUT] + (size_t)kt * 128 * 1024 + nt * 128; j.lds_ = 1024; j.dst = WSP(bf16_t, OFF_WOUT1T) + (size_t)(nt * 128) * 1024 + kt * 128; j.ldd = 1024; }
    return j;
}
__device__ __forceinline__ CvtJob cvt_job_expert(const Frame& F, int x) {
    CvtJob j; const int region = x / 176, tt = x % 176, l = region / 48, rem = region % 48, e = rem / 3, kind = rem % 3;
    if (kind < 2) { const int kt = tt & 7, nt = tt >> 3;
        j.src = F.in[kind == 0 ? I_WGATE : I_WUP] + ((size_t)(l * 16 + e) * 1024 + kt * 128) * 2816 + nt * 128; j.lds_ = 2816;
        j.dst = (bf16_t*)(F.ws + OFF_W1T + (size_t)l * W1T_LAYER) + (size_t)(e * 22 + nt) * (256 * 1024) + (size_t)(2 * kt) * 16384 + kind * 128 * 64; j.ldd = 0; }
    else { const int kt = tt % 22, nt = tt / 22;
        j.src = F.in[I_WDOWN] + ((size_t)(l * 16 + e) * 2816 + kt * 128) * 1024 + nt * 128; j.lds_ = 1024;
        j.dst = (bf16_t*)(F.ws + OFF_W2T + (size_t)l * W2T_LAYER) + (size_t)(e * 4 + (nt >> 1)) * (256 * 2816) + (size_t)(2 * kt) * 16384 + (nt & 1) * 128 * 64; j.ldd = 0; }
    return j;
}
template <bool LORA> __device__ __forceinline__ void phase_convert(const Frame& F, int jlo, int jhi, int b0, int bst) {
    unsigned* tl0 = (unsigned*)F.smem; unsigned* tl1 = tl0 + 128 * 65 + 8;
    constexpr int NSMALL = 520, NJOB = NSMALL + 16 * 3 * 176;
    float4 c0 = make_float4(0.f, 0.f, 0.f, 0.f), c1 = c0, c2 = c0, c3 = c0, c4 = c0, c5 = c0, c6 = c0, c7 = c0, n0 = c0, n1 = c0, n2 = c0, n3 = c0, n4 = c0, n5 = c0, n6 = c0, n7 = c0,
           m0 = c0, m1 = c0, m2 = c0, m3 = c0, m4 = c0, m5 = c0, m6 = c0, m7 = c0;
#define CVT_JOB(xx) ((xx) < NSMALL ? cvt_job_small(F, (xx)) : cvt_job_expert(F, (xx) - NSMALL))
    (void)NJOB;
    int x = jlo + b0, par = 0;
    if (x < jhi) { const CvtJob j = CVT_JOB(x); CVT_LOAD(j, F.tid, c); }
    if (x + bst < jhi) { const CvtJob j = CVT_JOB(x + bst); CVT_LOAD(j, F.tid, n); }
    for (; x < jhi; x += bst, par ^= 1) {
        const CvtJob j = CVT_JOB(x);
        const int xn = x + 2 * bst;
        if (xn < jhi) { const CvtJob jn = CVT_JOB(xn); CVT_LOAD(jn, F.tid, m); }
        cvt_store(j.dst, j.ldd, F.tid, c0, c1, c2, c3, c4, c5, c6, c7, par ? tl1 : tl0);
        c0 = n0; c1 = n1; c2 = n2; c3 = n3; c4 = n4; c5 = n5; c6 = n6; c7 = n7;
        n0 = m0; n1 = m1; n2 = m2; n3 = m3; n4 = m4; n5 = m5; n6 = m6; n7 = m7;
    }
#undef CVT_JOB
    __syncthreads();
    if (LORA) {
        bf16_t* Wl = WSP(bf16_t, OFF_WLORAT);
        const float* w2 = F.in[I_RW_W2]; const float* a2 = F.in[I_RW_A2]; const float* g2 = F.in[I_RW_G2];
        for (int i = F.bid * NTHR + F.tid; i < 2560 * 384; i += F.nblk * NTHR) {
            const int n = i / 384, k = i % 384, kind = n >> 9, c = n & 511; float v = 0.f;
            if (kind == 0) { if (k < 64) v = w2[(size_t)(0 * 64 + k) * 512 + c]; }
            else if (kind == 1) { if (k >= 64 && k < 128) v = w2[(size_t)(1 * 64 + (k - 64)) * 512 + c]; }
            else if (kind == 2) { if (k >= 128 && k < 192) v = a2[(size_t)(0 * 64 + (k - 128)) * 512 + c]; }
            else if (kind == 3) { if (k >= 192 && k < 256) v = a2[(size_t)(1 * 64 + (k - 192)) * 512 + c]; }
            else { if (k >= 256) v = g2[(size_t)(k - 256) * 512 + c]; }
            Wl[i] = f2bf(v);
        }
    }
}

__device__ __forceinline__ void load_row16(const float* p, int lane, float (&v)[16]) {
    const float4* q = (const float4*)(p + lane * 4);
#pragma unroll
    for (int i = 0; i < 4; ++i) { const float4 t = q[i * 64]; v[4 * i] = t.x; v[4 * i + 1] = t.y; v[4 * i + 2] = t.z; v[4 * i + 3] = t.w; }
}
__device__ __forceinline__ void store_row16(float* p, int lane, const float (&v)[16]) {
    float4* q = (float4*)(p + lane * 4);
#pragma unroll
    for (int i = 0; i < 4; ++i) q[i * 64] = make_float4(v[4 * i], v[4 * i + 1], v[4 * i + 2], v[4 * i + 3]);
}
__device__ __forceinline__ void load_row16_bf(const bf16_t* p, int lane, float (&v)[16]) {
    const u32x2* q = (const u32x2*)(p + lane * 4);
#pragma unroll
    for (int i = 0; i < 4; ++i) { const u32x2 t = q[i * 64]; v[4 * i] = bflo(t.x); v[4 * i + 1] = bfhi(t.x); v[4 * i + 2] = bflo(t.y); v[4 * i + 3] = bfhi(t.y); }
}
__device__ __forceinline__ void store_row16_bf(bf16_t* p, int lane, const float (&v)[16]) {
    u32x2* q = (u32x2*)(p + lane * 4);
#pragma unroll
    for (int i = 0; i < 4; ++i) q[i * 64] = (u32x2){pk2(v[4 * i], v[4 * i + 1]), pk2(v[4 * i + 2], v[4 * i + 3])};
}
__device__ __forceinline__ void fill_thin(float* wl, const float* W, int ldw, int tid) {
    for (int i = tid; i < 1024 * 16; i += NTHR) { const int c = i >> 4, j = i & 15; const int q = (c >> 8) * 4 + (c & 3), ln = (c >> 2) & 63; wl[(q * 64 + ln) * 20 + j] = W[(size_t)c * ldw + j]; }
}
__device__ __forceinline__ void thin16(const float* wl, int lane, const float (&h)[16], float (&o)[16]) {
#pragma unroll
    for (int j = 0; j < 16; ++j) o[j] = 0.f;
#pragma unroll
    for (int i = 0; i < 16; ++i) { const float4* w = (const float4*)(wl + (i * 64 + lane) * 20);
        if ((i & 1) == 0) asm volatile("" ::: "memory");
#pragma unroll
        for (int q = 0; q < 4; ++q) { const float4 t = w[q]; o[4 * q] += h[i] * t.x; o[4 * q + 1] += h[i] * t.y; o[4 * q + 2] += h[i] * t.z; o[4 * q + 3] += h[i] * t.w; } }
#pragma unroll
    for (int j = 0; j < 16; ++j) o[j] = wave_sum(o[j]);
}

__device__ __forceinline__ void phase_norm0(const Frame& F) {
    float* wl = (float*)F.smem;
    fill_thin(wl, F.in[I_AB_IN] + 2048, 2576, F.tid);
    __syncthreads();
    const float* x = F.in[I_X]; const float* mod = WSP(float, OFF_MOD); bf16_t* hb = WSP(bf16_t, OFF_HB); float* gb = WSP(float, OFF_GB0);
    for (int tb = F.bid; tb < 256; tb += F.nblk) {
        const int base = tb * 64 + F.wid * 8, b = base >> 12;
        float gain[16], sc[16], sh[16];
        load_row16(F.in[I_NMIX_PRE], F.lane, gain);
        load_row16(mod + (size_t)(0 * 4 + b) * 6144 + 1024, F.lane, sc);
        load_row16(mod + (size_t)(0 * 4 + b) * 6144, F.lane, sh);
        for (int i = 0; i < 8; ++i) {
            const int tok = base + i; float v[16]; load_row16(x + (size_t)tok * 1024, F.lane, v);
            float ss = 0.f;
#pragma unroll
            for (int q = 0; q < 16; ++q) ss += v[q] * v[q];
            ss = wave_sum(ss); const float rstd = rsqrtf(ss * (1.f / 1024.f) + 1e-6f);
#pragma unroll
            for (int q = 0; q < 16; ++q) v[q] = v[q] * rstd * gain[q] * (1.f + sc[q]) + sh[q];
            store_row16_bf(hb + (size_t)tok * 1024, F.lane, v);
            float o[16]; thin16(wl, F.lane, v, o);
            if (F.lane < 16) { const int j = F.lane; float r = 0.f;
#pragma unroll
                for (int q = 0; q < 16; ++q) r = (q == j) ? o[q] : r;
                float outv;
                if (j < 8) outv = -__expf(F.in[I_DN_ALOG][j]) * softplusf_(r + F.in[I_DN_DTB][j]);
                else outv = sigmoidf_(r);
                gb[(size_t)tok * 16 + j] = outv; }
        }
    }
}

__device__ __forceinline__ void phase_dnprep(const Frame& F) {
    const bf16_t* P0 = WSP(bf16_t, OFF_P0); bf16_t* qkvn = WSP(bf16_t, OFF_QKVN); const float* cw = F.in[I_DN_CONV];
    const int c0 = F.lane * 8;
    for (int tb = F.bid; tb < 256; tb += F.nblk) {
        const int base = tb * 64 + F.wid * 8;
        for (int i = 0; i < 8; ++i) {
            const int tok = base + i, s = tok & 4095;
#pragma unroll
            for (int grp = 0; grp < 3; ++grp) {
                float acc[8];
#pragma unroll
                for (int q = 0; q < 8; ++q) acc[q] = 0.f;
#pragma unroll
                for (int j = 0; j < 5; ++j) { const int sj = s + j - 2;
                    if (sj >= 0 && sj < 4096) {
                        const u32x4 pv = *(const u32x4*)(P0 + (size_t)(tok + j - 2) * 2560 + grp * 512 + c0);
                        const float4 w0 = *(const float4*)(cw + j * 1536 + grp * 512 + c0), w1 = *(const float4*)(cw + j * 1536 + grp * 512 + c0 + 4);
                        acc[0] += w0.x * bflo(pv.x); acc[1] += w0.y * bfhi(pv.x); acc[2] += w0.z * bflo(pv.y); acc[3] += w0.w * bfhi(pv.y);
                        acc[4] += w1.x * bflo(pv.z); acc[5] += w1.y * bfhi(pv.z); acc[6] += w1.z * bflo(pv.w); acc[7] += w1.w * bfhi(pv.w); } }
                float ss = 0.f;
#pragma unroll
                for (int q = 0; q < 8; ++q) { acc[q] = siluf_(acc[q]); ss += acc[q] * acc[q]; }
                if (grp < 2) {
                    ss += __shfl_xor(ss, 1); ss += __shfl_xor(ss, 2); ss += __shfl_xor(ss, 4); ss += __shfl_xor(ss, 8);
                    float sc = rsqrtf(ss + 1e-6f); if (grp == 0) sc *= 0.08838834764831845f;
#pragma unroll
                    for (int q = 0; q < 8; ++q) acc[q] *= sc; }
                *(u32x4*)(qkvn + (size_t)tok * 1536 + grp * 512 + c0) = (u32x4){pk2(acc[0], acc[1]), pk2(acc[2], acc[3]), pk2(acc[4], acc[5]), pk2(acc[6], acc[7])};
            }
        }
    }
}

__device__ __forceinline__ void phase_dnscan(const Frame& F) {
    float* bufQK = (float*)F.smem;
    float* bufV = bufQK + 2 * 32 * 256;
    float* bufG = bufV + 2 * 32 * 32;
    const float* qkvn = WSP(float, OFF_QKVN); const float* gb = WSP(float, OFF_GB0); float* dno = WSP(float, OFF_DNO);
    const int col4 = F.lane >> 4, kp = F.lane & 15, jj = F.wid * 4 + col4;
    const bool split = (F.nblk == 256);
    if (split && F.bid >= 128) return;
    for (int u = F.bid; u < 128; u += (split ? 128 : F.nblk)) {
        const int cb = u & 3, seq = u >> 2, dir = seq & 1, h = (seq >> 1) & 3, b = seq >> 3;
        float s[8];
#pragma unroll
        for (int q = 0; q < 8; ++q) s[q] = 0.f;
        float4 rq0, rq1, rq2, rq3; float4 rv = make_float4(0.f, 0.f, 0.f, 0.f); float rg = 0.f;
#define DN_LD1(dst, i, c) do { const int idx = F.tid + NTHR * (i), row = idx >> 6, c4 = idx & 63, step = (c) * 32 + row, t = dir ? 4095 - step : step; \
            const size_t tok = (size_t)b * 4096 + t; dst = *(const float4*)(qkvn + tok * 1536 + (c4 < 32 ? h * 128 + c4 * 4 : 512 + h * 128 + (c4 - 32) * 4)); } while (0)
#define DN_GLOAD(c) do { DN_LD1(rq0, 0, c); DN_LD1(rq1, 1, c); DN_LD1(rq2, 2, c); DN_LD1(rq3, 3, c); \
            if (F.tid < 256) { const int row = F.tid >> 3, c4 = F.tid & 7, step = (c) * 32 + row, t = dir ? 4095 - step : step; const size_t tok = (size_t)b * 4096 + t; \
                rv = *(const float4*)(qkvn + tok * 1536 + 1024 + h * 128 + cb * 32 + c4 * 4); } \
            else if (F.tid < 320) { const int row = (F.tid - 256) >> 1, which = F.tid & 1, step = (c) * 32 + row, t = dir ? 4095 - step : step; const size_t tok = (size_t)b * 4096 + t; \
                rg = gb[tok * 16 + which * 8 + dir * 4 + h]; } } while (0)
#define DN_LSTORE(buf) do { *(float4*)(bufQK + (buf) * 8192 + (F.tid) * 4) = rq0; *(float4*)(bufQK + (buf) * 8192 + (F.tid + NTHR) * 4) = rq1; \
            *(float4*)(bufQK + (buf) * 8192 + (F.tid + 2 * NTHR) * 4) = rq2; *(float4*)(bufQK + (buf) * 8192 + (F.tid + 3 * NTHR) * 4) = rq3; \
            if (F.tid < 256) *(float4*)(bufV + (buf) * 1024 + F.tid * 4) = rv; else if (F.tid < 320) bufG[(buf) * 64 + (F.tid - 256)] = rg; } while (0)
        DN_GLOAD(0); DN_LSTORE(0); __syncthreads();
        for (int c = 0; c < 128; ++c) {
            const int buf = c & 1;
            if (c + 1 < 128) DN_GLOAD(c + 1);
            float osel = 0.f;
#pragma unroll 4
            for (int i = 0; i < 32; ++i) {
                const float* row = bufQK + buf * 8192 + i * 256;
                const float4 q0 = *(const float4*)(row + kp * 8), q1 = *(const float4*)(row + kp * 8 + 4);
                const float4 k0 = *(const float4*)(row + 128 + kp * 8), k1 = *(const float4*)(row + 128 + kp * 8 + 4);
                const float v = bufV[buf * 1024 + i * 32 + jj]; const float g = bufG[buf * 64 + i * 2], beta = bufG[buf * 64 + i * 2 + 1];
                const float a = __expf(g);
#pragma unroll
                for (int q = 0; q < 8; ++q) s[q] *= a;
                float d = k0.x * s[0] + k0.y * s[1] + k0.z * s[2] + k0.w * s[3] + k1.x * s[4] + k1.y * s[5] + k1.z * s[6] + k1.w * s[7];
                d = row16_sum(d);
                const float cc = beta * (v - d);
                s[0] += k0.x * cc; s[1] += k0.y * cc; s[2] += k0.z * cc; s[3] += k0.w * cc; s[4] += k1.x * cc; s[5] += k1.y * cc; s[6] += k1.z * cc; s[7] += k1.w * cc;
                float o = q0.x * s[0] + q0.y * s[1] + q0.z * s[2] + q0.w * s[3] + q1.x * s[4] + q1.y * s[5] + q1.z * s[6] + q1.w * s[7];
                o = row16_sum(o);
                osel = (kp == (i & 15)) ? o : osel;
                if ((i & 15) == 15) { const int step = c * 32 + (i & 16) + kp, t = dir ? 4095 - step : step;
                    dno[((size_t)dir * T_ + (size_t)b * 4096 + t) * 512 + h * 128 + cb * 32 + jj] = osel; }
            }
            if (c + 1 < 128) DN_LSTORE(buf ^ 1);
            __syncthreads();
        }
    }
#undef DN_LD1
#undef DN_GLOAD
#undef DN_LSTORE
}

__device__ __forceinline__ void phase_s5scan(const Frame& F) {
    float* Ebuf = (float*)F.smem;
    unsigned char* wbase = F.smem + 32768 + F.wid * (2048 + 8448 + 4352);
    bf16_t* ub = (bf16_t*)wbase;
    float* bu = (float*)(wbase + 2048);
    bf16_t* xsb = (bf16_t*)(wbase + 2048 + 8448);
    const bf16_t* P0 = WSP(bf16_t, OFF_P0); bf16_t* s5y = WSP(bf16_t, OFF_S5Y);
    const int p = F.lane, l15 = F.lane & 15, kg = F.lane >> 4;
#ifdef S5_CMP
    float cmp_e = 0.f, cmp_r = 0.f;
#endif
    for (int u = F.bid; u < 256; u += F.nblk) {
        const int d = u & 1, g = (u >> 1) & 31, b = u >> 6;
        const float dt = __expf(F.in[I_S5_LDT][d * 32 + g]);
        const float are = F.in[I_S5_ARE][(d * 32 + g) * 64 + p], aim = F.in[I_S5_AIM][(d * 32 + g) * 64 + p];
        const float mag = __expf(are * dt);
        float rev = aim * dt * 0.15915494309189535f; rev -= floorf(rev);
        const float lr = mag * __builtin_amdgcn_cosf(rev), li = mag * __builtin_amdgcn_sinf(rev);
        const float den = are * are + aim * aim, nr = lr - 1.f, ni = li;
        const float fre = (nr * are + ni * aim) / den, fim = (ni * are - nr * aim) / den;
        bf16x8 bfr[8];
#pragma unroll
        for (int n = 0; n < 8; ++n) { const int ps = (n & 3) * 16 + l15; const float fr_ = __shfl(fre, ps), fi_ = __shfl(fim, ps);
            const float* br = F.in[I_S5_BRE] + ((size_t)(d * 32 + g) * 64 + ps) * 16 + 8 * (kg & 1); const float* bi = F.in[I_S5_BIM] + ((size_t)(d * 32 + g) * 64 + ps) * 16 + 8 * (kg & 1);
            bf16x8 f;
#pragma unroll
            for (int j = 0; j < 8; ++j) { const float r_ = br[j], i_ = bi[j]; const float v = (n < 4) ? (fr_ * r_ - fi_ * i_) : (fr_ * i_ + fi_ * r_); f[j] = (short)f2bf(kg < 2 ? v : 0.f); }
            bfr[n] = f; }
        bf16x8 cfrag[4];
        { const int hcol = l15;
#pragma unroll
          for (int s = 0; s < 4; ++s) { const int kk0 = 32 * s + 8 * kg; bf16x8 f;
#pragma unroll
              for (int j = 0; j < 8; ++j) { const int kk = kk0 + j; const float v = kk < 64 ? F.in[I_S5_CRE][((size_t)(d * 32 + g) * 16 + hcol) * 64 + kk] : -F.in[I_S5_CIM][((size_t)(d * 32 + g) * 16 + hcol) * 64 + (kk - 64)]; f[j] = (short)f2bf(v); }
              cfrag[s] = f; } }
        float l64r = lr, l64i = li;
#pragma unroll
        for (int q = 0; q < 6; ++q) { const float r2 = l64r * l64r - l64i * l64i, i2 = 2.f * l64r * l64i; l64r = r2; l64i = i2; }
#define S5_LOADU(cw) do { const int n_ = (cw) * 64 + F.lane, t_ = d ? 4095 - n_ : n_; const bf16_t* src_ = P0 + ((size_t)b * 4096 + t_) * 2560 + 2048 + g * 16; \
            const u32x4 a_ = *(const u32x4*)src_, c_ = *(const u32x4*)(src_ + 8); asm volatile("s_waitcnt lgkmcnt(0)" ::: "memory"); __builtin_amdgcn_wave_barrier(); \
            *(u32x4*)(ub + F.lane * 16) = a_; *(u32x4*)(ub + F.lane * 16 + 8) = c_; asm volatile("s_waitcnt lgkmcnt(0)" ::: "memory"); __builtin_amdgcn_wave_barrier(); } while (0)
#define S5_BU(sub) do { bf16x8 af_; { const u32x4 z_ = (u32x4){0u, 0u, 0u, 0u}; u32x4 v_ = *(const u32x4*)(ub + ((sub) * 16 + l15) * 16 + 8 * (kg & 1)); if (kg >= 2) v_ = z_; af_ = as_frag(v_); } \
            f32x4 ac_[8]; \
            _Pragma("unroll") for (int n = 0; n < 8; ++n) { ac_[n] = (f32x4){0.f, 0.f, 0.f, 0.f}; ac_[n] = __builtin_amdgcn_mfma_f32_16x16x32_bf16(af_, bfr[n], ac_[n], 0, 0, 0); } \
            asm volatile("s_nop 15\n\ts_nop 15" : "+v"(ac_[0]), "+v"(ac_[1]), "+v"(ac_[2]), "+v"(ac_[3]), "+v"(ac_[4]), "+v"(ac_[5]), "+v"(ac_[6]), "+v"(ac_[7]) :: "memory"); \
            _Pragma("unroll") for (int n = 0; n < 8; ++n) { _Pragma("unroll") for (int j = 0; j < 4; ++j) bu[(kg * 4 + j) * 132 + n * 16 + l15] = ac_[n][j]; } \
            asm volatile("s_waitcnt lgkmcnt(0)" ::: "memory"); __builtin_amdgcn_wave_barrier(); } while (0)
        for (int i = 0; i < 8; ++i) { const int cw = F.wid * 8 + i; S5_LOADU(cw); float xr = 0.f, xi = 0.f;
            for (int sub = 0; sub < 4; ++sub) { S5_BU(sub);
#pragma unroll
                for (int j = 0; j < 16; ++j) { const float br_ = bu[j * 132 + p], bi_ = bu[j * 132 + 64 + p]; const float nxr = lr * xr - li * xi + br_, nxi = lr * xi + li * xr + bi_; xr = nxr; xi = nxi; }
                asm volatile("s_waitcnt lgkmcnt(0)" ::: "memory"); __builtin_amdgcn_wave_barrier(); }
            Ebuf[(cw * 64 + p) * 2] = xr; Ebuf[(cw * 64 + p) * 2 + 1] = xi; }
        __syncthreads();
        float xr = 0.f, xi = 0.f;
        for (int c = 0; c < F.wid * 8; ++c) { const float er = Ebuf[(c * 64 + p) * 2], ei = Ebuf[(c * 64 + p) * 2 + 1]; const float nr_ = l64r * xr - l64i * xi + er, ni_ = l64r * xi + l64i * xr + ei; xr = nr_; xi = ni_; }
        for (int i = 0; i < 8; ++i) { const int cw = F.wid * 8 + i; S5_LOADU(cw);
            for (int sub = 0; sub < 4; ++sub) { S5_BU(sub);
#pragma unroll
                for (int j = 0; j < 16; ++j) { const float br_ = bu[j * 132 + p], bi_ = bu[j * 132 + 64 + p];
                    asm volatile("" ::: "memory");
                    const float nxr = lr * xr - li * xi + br_, nxi = lr * xi + li * xr + bi_; xr = nxr; xi = nxi;
                    bf16_t* xs = xsb + j * 136; xs[p] = f2bf(xr); xs[64 + p] = f2bf(xi);
                    asm volatile("" ::: "memory"); }
                asm volatile("s_waitcnt lgkmcnt(0)" ::: "memory"); __builtin_amdgcn_wave_barrier();
                f32x4 acc = (f32x4){0.f, 0.f, 0.f, 0.f};
#pragma unroll
                for (int s = 0; s < 4; ++s) { const bf16x8 af = *(const bf16x8*)(xsb + l15 * 136 + 32 * s + 8 * kg); acc = __builtin_amdgcn_mfma_f32_16x16x32_bf16(af, cfrag[s], acc, 0, 0, 0); }
                asm volatile("s_waitcnt lgkmcnt(0)" ::: "memory"); __builtin_amdgcn_wave_barrier();
#pragma unroll
                for (int jp = 0; jp < 2; ++jp) {
                    const float n0 = __shfl_xor(acc[2 * jp], 1), n1 = __shfl_xor(acc[2 * jp + 1], 1); const bool odd = (l15 & 1) != 0;
                    const int j = odd ? 2 * jp + 1 : 2 * jp; const float lo = odd ? n1 : acc[2 * jp], hi = odd ? acc[2 * jp + 1] : n0;
                    const int tl_ = kg * 4 + j, n = cw * 64 + sub * 16 + tl_, t = d ? 4095 - n : n;
                    *(unsigned*)(s5y + ((size_t)d * T_ + (size_t)b * 4096 + t) * 512 + g * 16 + (l15 & ~1)) = pk2(lo, hi); }
            } }
#ifdef S5_CMP
        cmp_e = wave_sum(cmp_e); cmp_r = wave_sum(cmp_r); if (F.lane == 0) { float* fw = (float*)(F.ws + OFF_BAR); atomicAdd(fw + 4004, cmp_e); atomicAdd(fw + 4005, cmp_r); atomicAdd(fw + 4006, cmp_e); atomicAdd(fw + 4007, cmp_r); }
#endif
        __syncthreads();
#undef S5_LOADU
#undef S5_BU
    }
}

__device__ __forceinline__ void phase_post0(const Frame& F) {
    const bf16_t* P0 = WSP(bf16_t, OFF_P0); const bf16_t* dno = WSP(bf16_t, OFF_DNO); const bf16_t* s5y = WSP(bf16_t, OFF_S5Y);
    bf16_t* ycat = WSP(bf16_t, OFF_YCAT); bf16_t* ys5 = WSP(bf16_t, OFF_YS5);
    const int c0 = F.lane * 8;
    float nw[8], dsk[8];
#pragma unroll
    for (int q = 0; q < 8; ++q) { nw[q] = F.in[I_DN_NORM][(c0 & 127) + q]; dsk[q] = F.in[I_S5_D][c0 + q]; }
    for (int tb = F.bid; tb < 256; tb += F.nblk) {
        const int base = tb * 64 + F.wid * 8;
        for (int i = 0; i < 8; ++i) { const size_t tok = base + i;
            { const u32x4 a = *(const u32x4*)(dno + tok * 512 + c0), b = *(const u32x4*)(dno + ((size_t)T_ + tok) * 512 + c0);
              float o[8] = {bflo(a.x) + bflo(b.x), bfhi(a.x) + bfhi(b.x), bflo(a.y) + bflo(b.y), bfhi(a.y) + bfhi(b.y), bflo(a.z) + bflo(b.z), bfhi(a.z) + bfhi(b.z), bflo(a.w) + bflo(b.w), bfhi(a.w) + bfhi(b.w)};
              float ss = 0.f;
#pragma unroll
              for (int q = 0; q < 8; ++q) ss += o[q] * o[q];
              ss += __shfl_xor(ss, 1); ss += __shfl_xor(ss, 2); ss += __shfl_xor(ss, 4); ss += __shfl_xor(ss, 8);
              const float rstd = rsqrtf(ss * (1.f / 128.f) + 1e-6f);
              const u32x4 zv = *(const u32x4*)(P0 + tok * 2560 + 1536 + c0);
              const float z[8] = {bflo(zv.x), bfhi(zv.x), bflo(zv.y), bfhi(zv.y), bflo(zv.z), bfhi(zv.z), bflo(zv.w), bfhi(zv.w)};
#pragma unroll
              for (int q = 0; q < 8; ++q) o[q] = o[q] * rstd * nw[q] * siluf_(z[q]);
              *(u32x4*)(ycat + tok * 1024 + c0) = (u32x4){pk2(o[0], o[1]), pk2(o[2], o[3]), pk2(o[4], o[5]), pk2(o[6], o[7])}; }
            { const u32x4 a = *(const u32x4*)(s5y + tok * 512 + c0), b = *(const u32x4*)(s5y + ((size_t)T_ + tok) * 512 + c0);
              const u32x4 uv = *(const u32x4*)(P0 + tok * 2560 + 2048 + c0);
              const float uu[8] = {bflo(uv.x), bfhi(uv.x), bflo(uv.y), bfhi(uv.y), bflo(uv.z), bfhi(uv.z), bflo(uv.w), bfhi(uv.w)};
              float y[8] = {bflo(a.x) + bflo(b.x), bfhi(a.x) + bfhi(b.x), bflo(a.y) + bflo(b.y), bfhi(a.y) + bfhi(b.y), bflo(a.z) + bflo(b.z), bfhi(a.z) + bfhi(b.z), bflo(a.w) + bflo(b.w), bfhi(a.w) + bfhi(b.w)};
#pragma unroll
              for (int q = 0; q < 8; ++q) y[q] = gelu_tanhf_(y[q] + dsk[q] * uu[q]);
              *(u32x4*)(ys5 + tok * 512 + c0) = (u32x4){pk2(y[0], y[1]), pk2(y[2], y[3]), pk2(y[4], y[5]), pk2(y[6], y[7])}; }
        }
    }
}
constexpr int LD72 = 72;
#ifndef DN_SWAPTEST_V
#define DN_SWAPTEST_V (vv * beta)
#endif
#ifdef DN_ROBUST
#define DN_WSYNC() __syncthreads()
#define DN_XSYNC() __syncthreads()
#else
#define DN_WSYNC() do { asm volatile("s_waitcnt lgkmcnt(0)" ::: "memory"); __builtin_amdgcn_wave_barrier(); } while (0)
#define DN_XSYNC() do { } while (0)
#endif
#ifndef DN_CLIM
#define DN_CLIM 64
#endif
__device__ __forceinline__ int perm16(int x) { return ((x >> 2) & 1) * 8 + ((x >> 3) << 2) + (x & 3); }
__device__ __forceinline__ bf16x8 ld_frag_f32(const float* p) {
    const float4 a = *(const float4*)p, b = *(const float4*)(p + 4);
    bf16x8 f; const unsigned w0 = pk2(a.x, a.y), w1 = pk2(a.z, a.w), w2 = pk2(b.x, b.y), w3 = pk2(b.z, b.w);
    f[0] = (short)(w0 & 0xFFFFu); f[1] = (short)(w0 >> 16); f[2] = (short)(w1 & 0xFFFFu); f[3] = (short)(w1 >> 16);
    f[4] = (short)(w2 & 0xFFFFu); f[5] = (short)(w2 >> 16); f[6] = (short)(w3 & 0xFFFFu); f[7] = (short)(w3 >> 16); return f;
}
__device__ __forceinline__ u32x4 pack8(const f32x16& a, int s) {
    u32x4 o; o.x = pg8::cvt_pk_bf16(a[8 * s], a[8 * s + 1]); o.y = pg8::cvt_pk_bf16(a[8 * s + 2], a[8 * s + 3]); o.z = pg8::cvt_pk_bf16(a[8 * s + 4], a[8 * s + 5]); o.w = pg8::cvt_pk_bf16(a[8 * s + 6], a[8 * s + 7]); return o;
}
__device__ __forceinline__ void unpack16(const u32x4 lo, const u32x4 hi, f32x16& a) {
    a[0] = bflo(lo.x); a[1] = bfhi(lo.x); a[2] = bflo(lo.y); a[3] = bfhi(lo.y); a[4] = bflo(lo.z); a[5] = bfhi(lo.z); a[6] = bflo(lo.w); a[7] = bfhi(lo.w);
    a[8] = bflo(hi.x); a[9] = bfhi(hi.x); a[10] = bflo(hi.y); a[11] = bfhi(hi.y); a[12] = bflo(hi.z); a[13] = bfhi(hi.z); a[14] = bflo(hi.w); a[15] = bfhi(hi.w);
}
template <int KS> __device__ __forceinline__ f32x16 tile_mm(const bf16_t* A, int ldA, const bf16_t* Bt, int ldB, int lane) {
    f32x16 acc;
#pragma unroll
    for (int r = 0; r < 16; ++r) acc[r] = 0.f;
    const int rw = lane & 31, hh = lane >> 5;
#pragma unroll
    for (int s = 0; s < KS; ++s) { const bf16x8 a = *(const bf16x8*)(A + rw * ldA + 16 * s + 8 * hh), b = *(const bf16x8*)(Bt + rw * ldB + 16 * s + 8 * hh);
        acc = __builtin_amdgcn_mfma_f32_32x32x16_bf16(a, b, acc, 0, 0, 0); }
    return acc;
}

__device__ __forceinline__ void phase_dn_ab(const Frame& F) {
    const bf16_t* qkvn = WSP(bf16_t, OFF_QKVN); const float* gb = WSP(float, OFF_GB0);
    float* gcs_g = WSP(float, OFF_DN_GCS); bf16_t* Am_g = WSP(bf16_t, OFF_DN_AM); bf16_t* Tm_g = WSP(bf16_t, OFF_DN_TM);
    float* Gs = (float*)F.smem + F.wid * (64 * 68 + 128);
    float* gsm = Gs + 64 * 68; float* bsm = gsm + 64;
    const int rw = F.lane & 31, hh = F.lane >> 5;
    for (int ch = F.bid + F.wid * F.nblk; ch < 2048; ch += F.nblk * 8) {
        const int seq = ch >> 6, c = ch & 63, dir = seq & 1, h = (seq >> 1) & 3, b = seq >> 3;
        { const int step = c * 64 + F.lane, t = dir ? 4095 - step : step; const size_t tok = (size_t)b * 4096 + t;
          float gc = gb[tok * 16 + dir * 4 + h]; const float beta = gb[tok * 16 + 8 + dir * 4 + h];
#pragma unroll
          for (int o = 1; o < 64; o <<= 1) { const float tt = __shfl_up(gc, o); if (F.lane >= o) gc += tt; }
          gsm[F.lane] = gc; bsm[F.lane] = beta; gcs_g[(size_t)ch * 64 + F.lane] = gc; }
        DN_WSYNC();
        size_t tokr[2];
#pragma unroll
        for (int ti = 0; ti < 2; ++ti) { const int step = c * 64 + ti * 32 + rw, t = dir ? 4095 - step : step; tokr[ti] = (size_t)b * 4096 + t; }
        bf16x8 kf[2][8];
#pragma unroll
        for (int ti = 0; ti < 2; ++ti)
#pragma unroll
            for (int s = 0; s < 8; ++s) kf[ti][s] = *(const bf16x8*)(qkvn + tokr[ti] * 1536 + 512 + h * 128 + 16 * s + 8 * hh);
#pragma unroll
        for (int ti = 0; ti < 2; ++ti)
#pragma unroll
            for (int tj = 0; tj <= ti; ++tj) {
                f32x16 acc;
#pragma unroll
                for (int r = 0; r < 16; ++r) acc[r] = 0.f;
#pragma unroll
                for (int s = 0; s < 8; ++s) acc = __builtin_amdgcn_mfma_f32_32x32x16_bf16(kf[ti][s], kf[tj][s], acc, 0, 0, 0);
                int j = tj * 32 + rw; asm volatile("" : "+v"(j));
                const float gcj = gsm[j]; const int ib = ti * 32 + 4 * hh;
#pragma unroll
                for (int r = 0; r < 16; ++r) { const int i = ib + (r & 3) + 8 * (r >> 2);
                    Gs[i * 68 + j] = (j < i) ? bsm[i] * acc[r] * __expf(fminf(gsm[i] - gcj, 0.f)) : 0.f; }
            }
#pragma unroll
        for (int ti = 0; ti < 2; ++ti) {
            bf16x8 qf[8];
#pragma unroll
            for (int s = 0; s < 8; ++s) qf[s] = *(const bf16x8*)(qkvn + tokr[ti] * 1536 + h * 128 + 16 * s + 8 * hh);
#pragma unroll
            for (int tj = 0; tj < 2; ++tj) {
                f32x16 acc;
#pragma unroll
                for (int r = 0; r < 16; ++r) acc[r] = 0.f;
                if (tj <= ti) {
#pragma unroll
                    for (int s = 0; s < 8; ++s) acc = __builtin_amdgcn_mfma_f32_32x32x16_bf16(qf[s], kf[tj][s], acc, 0, 0, 0); }
                int j = tj * 32 + rw; asm volatile("" : "+v"(j));
                const float gcj = gsm[j]; const int ib = ti * 32 + 4 * hh;
                bf16_t* ap = Am_g + (size_t)ch * 4096 + (ti * 32 + 4 * hh) * 64 + j; asm volatile("" : "+v"(ap));
#pragma unroll
                for (int r = 0; r < 16; ++r) { const int i = ib + (r & 3) + 8 * (r >> 2);
                    const float v = (j <= i) ? acc[r] * __expf(fminf(gsm[i] - gcj, 0.f)) : 0.f;
                    ap[((r & 3) + 8 * (r >> 2)) * 64] = f2bf(v); }
            }
        }
        DN_WSYNC();
        { float x[64]; int cc = F.lane; asm volatile("" : "+v"(cc));
#pragma unroll
          for (int i = 0; i < 64; ++i) { float acc = (i == cc) ? 1.f : 0.f, ac1 = 0.f, ac2 = 0.f, ac3 = 0.f;
#pragma unroll
              for (int j4 = 0; j4 < (i + 3) / 4; ++j4) { const float4 gv = *(const float4*)(Gs + i * 68 + j4 * 4);
                  if (j4 * 4 + 0 < i) acc -= gv.x * x[j4 * 4 + 0]; if (j4 * 4 + 1 < i) ac1 -= gv.y * x[j4 * 4 + 1];
                  if (j4 * 4 + 2 < i) ac2 -= gv.z * x[j4 * 4 + 2]; if (j4 * 4 + 3 < i) ac3 -= gv.w * x[j4 * 4 + 3]; }
              x[i] = (acc + ac1) + (ac2 + ac3); }
          bf16_t* tp = Tm_g + (size_t)ch * 4096 + cc; asm volatile("" : "+v"(tp));
#pragma unroll
          for (int i = 0; i < 64; ++i) tp[i * 64] = f2bf(x[i]); }
        DN_WSYNC();
    }
}

__device__ __forceinline__ void phase_dn_c(const Frame& F) {
    const bf16_t* qkvn = WSP(bf16_t, OFF_QKVN); const float* gb = WSP(float, OFF_GB0);
    const float* gcs_g = WSP(float, OFF_DN_GCS); const bf16_t* Am_g = WSP(bf16_t, OFF_DN_AM); const bf16_t* Tm_g = WSP(bf16_t, OFF_DN_TM);
    bf16_t* Qe_g = WSP(bf16_t, OFF_DN_QE); u32x4* Yi_g = WSP(u32x4, OFF_DN_YI); u32x4* Ph_g = WSP(u32x4, OFF_DN_PHI); u32x4* C_g = WSP(u32x4, OFF_DN_C);
    bf16_t* T_s = (bf16_t*)F.smem; bf16_t* A_s = T_s + 64 * LD72; bf16_t* KbgT = A_s + 64 * LD72; bf16_t* VbT = KbgT + 128 * LD72; bf16_t* KdT = VbT + 128 * LD72;
    bf16_t* wT = KdT + 128 * LD72; bf16_t* uT = wT + 128 * LD72; float* gcsb = (float*)(uT + 128 * LD72);
    const int rw = F.lane & 31, hh = F.lane >> 5, w = F.wid;
    const int it5 = w >> 2, dt5 = w & 3, d5 = dt5 * 32 + rw;
    float kr[16], vr[16], qr[16], gbn = 0.f; u32x4 tpc, apc;
#define DNC_LOAD(chx) do { const int seq_ = (chx) >> 6, c_ = (chx) & 63, dir_ = seq_ & 1, h_ = (seq_ >> 1) & 3, b_ = seq_ >> 3; \
        { const int row = F.tid >> 3, pc = F.tid & 7; tpc = *(const u32x4*)(Tm_g + (size_t)(chx) * 4096 + row * 64 + pc * 8); apc = *(const u32x4*)(Am_g + (size_t)(chx) * 4096 + row * 64 + pc * 8); } \
        _Pragma("unroll") for (int it = 0; it < 4; ++it) { const int x = F.tid + NTHR * it, chn = x & 127, tq = x >> 7; \
            _Pragma("unroll") for (int e = 0; e < 4; ++e) { const int step = c_ * 64 + tq * 4 + e, t = dir_ ? 4095 - step : step; const size_t tok = (size_t)b_ * 4096 + t; \
                kr[it * 4 + e] = bf2f(qkvn[tok * 1536 + 512 + h_ * 128 + chn]); vr[it * 4 + e] = bf2f(qkvn[tok * 1536 + 1024 + h_ * 128 + chn]); } } \
        _Pragma("unroll") for (int r = 0; r < 16; ++r) { const int step = c_ * 64 + it5 * 32 + (r & 3) + 8 * (r >> 2) + 4 * hh, t = dir_ ? 4095 - step : step; \
            qr[r] = bf2f(qkvn[((size_t)b_ * 4096 + t) * 1536 + h_ * 128 + d5]); } \
        if (F.tid < 64) gbn = gcs_g[(size_t)(chx) * 64 + F.tid]; \
        else if (F.tid < 128) { const int step = c_ * 64 + (F.tid - 64), t = dir_ ? 4095 - step : step; gbn = gb[((size_t)b_ * 4096 + t) * 16 + 8 + dir_ * 4 + h_]; } } while (0)
    int ch = F.bid, par = 0;
    if (ch < 2048) { DNC_LOAD(ch); if (F.tid < 128) gcsb[F.tid] = gbn; }
    __syncthreads();
    for (; ch < 2048; ch += F.nblk, par ^= 1) {
        const float* gcs = gcsb + par * 128; const float* bts = gcs + 64;
        const float gl = gcs[63];
        { const int row = F.tid >> 3, pc = F.tid & 7; *(u32x4*)(T_s + row * LD72 + pc * 8) = tpc; *(u32x4*)(A_s + row * LD72 + pc * 8) = apc; }
#pragma unroll
        for (int it = 0; it < 4; ++it) { const int x = F.tid + NTHR * it, chn = x & 127, tq = x >> 7;
            float kb[4], vb[4], kd[4];
#pragma unroll
            for (int e = 0; e < 4; ++e) { const int i = tq * 4 + e; const float gci = gcs[i], beta = bts[i], kv = kr[it * 4 + e];
                kb[e] = kv * beta * __expf(gci); vb[e] = vr[it * 4 + e] * beta; kd[e] = kv * __expf(gl - gci); }
            *(u32x2*)(KbgT + chn * LD72 + tq * 4) = (u32x2){pk2(kb[0], kb[1]), pk2(kb[2], kb[3])};
            *(u32x2*)(VbT + chn * LD72 + tq * 4) = (u32x2){pk2(vb[0], vb[1]), pk2(vb[2], vb[3])};
            *(u32x2*)(KdT + chn * LD72 + tq * 4) = (u32x2){pk2(kd[0], kd[1]), pk2(kd[2], kd[3])}; }
        float qc[16];
#pragma unroll
        for (int r = 0; r < 16; ++r) qc[r] = qr[r];
        __syncthreads();
        const int chn_ = ch + F.nblk;
        if (chn_ < 2048) DNC_LOAD(chn_);
        { const int rt = w >> 1, ct = w & 1;
          const f32x16 a3 = tile_mm<4>(KbgT + rt * 32 * LD72, LD72, T_s + ct * 32 * LD72, LD72, F.lane);
          const f32x16 a4 = tile_mm<4>(VbT + rt * 32 * LD72, LD72, T_s + ct * 32 * LD72, LD72, F.lane);
#pragma unroll
          for (int r = 0; r < 16; ++r) { const int row = rt * 32 + (r & 3) + 8 * (r >> 2) + 4 * hh, col = ct * 32 + rw;
              wT[row * LD72 + col] = f2bf(a3[r]); uT[row * LD72 + col] = f2bf(a4[r]); } }
        __syncthreads();
        { const f32x16 a5 = tile_mm<4>(A_s + it5 * 32 * LD72, LD72, wT + dt5 * 32 * LD72, LD72, F.lane);
          const f32x16 a6 = tile_mm<4>(A_s + it5 * 32 * LD72, LD72, uT + dt5 * 32 * LD72, LD72, F.lane);
          const int dp = (d5 & ~15) | perm16(d5 & 15);
          bf16_t* qp = Qe_g + (size_t)ch * 8192 + (it5 * 32 + 4 * hh) * 128 + dp;
#pragma unroll
          for (int r = 0; r < 16; ++r) { const int i = it5 * 32 + (r & 3) + 8 * (r >> 2) + 4 * hh;
              qp[((r & 3) + 8 * (r >> 2)) * 128] = f2bf(qc[r] * __expf(gcs[i]) - a5[r]); }
          u32x4* yo = Yi_g + ((size_t)(ch * 2 + it5) * 4 + dt5) * 128 + F.lane * 2;
          yo[0] = pack8(a6, 0); yo[1] = pack8(a6, 1); }
        const float glast = __expf(gl);
#pragma unroll
        for (int e = 0; e < 2; ++e) { const int x = w * 2 + e;
            { const int kbt = x >> 2, ra = x & 3;
              f32x16 a7 = tile_mm<4>(wT + kbt * 32 * LD72, LD72, KdT + ra * 32 * LD72, LD72, F.lane);
#pragma unroll
              for (int r = 0; r < 16; ++r) { const int brow = kbt * 32 + (r & 3) + 8 * (r >> 2) + 4 * hh, acol = ra * 32 + rw; a7[r] = ((brow == acol) ? glast : 0.f) - a7[r]; }
              u32x4* po = Ph_g + ((((size_t)ch * 4 + ra) * 4 + kbt) * 2) * 64 + F.lane;
              po[0] = pack8(a7, 0); po[64] = pack8(a7, 1); }
            { const int ra = x >> 2, vt = x & 3;
              const f32x16 a8 = tile_mm<4>(KdT + ra * 32 * LD72, LD72, uT + vt * 32 * LD72, LD72, F.lane);
              u32x4* co = C_g + ((size_t)(ch * 4 + ra) * 4 + vt) * 128 + F.lane * 2;
              co[0] = pack8(a8, 0); co[1] = pack8(a8, 1); } }
        if (chn_ < 2048 && F.tid < 128) gcsb[(par ^ 1) * 128 + F.tid] = gbn;
        __syncthreads();
    }
#undef DNC_LOAD
}

template <int NT> struct CarryBufs { const u32x4* Phi; const u32x4* C; const bf16_t* Qe; const u32x4* Yi; bf16_t* out; int nslice; int ncol; int qe_cs; int yi_cs; };
template <int NT, int D> __device__ __forceinline__ void phase_carry(const Frame& F, const CarryBufs<NT> cb, int ntask, int bid0, int bstride) {
    LAS unsigned char* lds = F.lds;
    const int rw = F.lane & 31, hh = F.lane >> 5, w = F.wid;
    const bool carry = w < NT, outw = (w >= NT && w < NT + 2);
    for (int task = bid0; task < ntask; task += bstride) {
        const int kx = task >> 3, slice = kx % cb.nslice, seq = (task & 7) + 8 * (kx / cb.nslice), dir = seq & 1, hb = seq >> 1;
        const int heads = cb.ncol / (32 * cb.nslice), h = hb % heads, b = hb / heads;
        f32x16 S;
#pragma unroll
        for (int r = 0; r < 16; ++r) S[r] = 0.f;
        u32x4 afr[D][NT * 2], ini[D][2];
#define CR_LOAD(j, ch) do { if (carry) { _Pragma("unroll") for (int kb = 0; kb < NT; ++kb) _Pragma("unroll") for (int s = 0; s < 2; ++s) \
                afr[j][kb * 2 + s] = cb.Phi[((((size_t)(ch) * NT + w) * NT + kb) * 2 + s) * 64 + F.lane]; \
              const u32x4* cp = cb.C + ((size_t)((ch) * NT + w) * cb.nslice + slice) * 128 + F.lane * 2; ini[j][0] = cp[0]; ini[j][1] = cp[1]; } \
            else if (outw) { const int it = w - NT; _Pragma("unroll") for (int kb = 0; kb < NT; ++kb) _Pragma("unroll") for (int s = 0; s < 2; ++s) \
                afr[j][kb * 2 + s] = *(const u32x4*)(cb.Qe + (size_t)(ch) * cb.qe_cs + (it * 32 + rw) * (32 * NT) + kb * 32 + 16 * s + 8 * hh); \
              const u32x4* yp = cb.Yi + (size_t)(ch) * cb.yi_cs + ((size_t)it * cb.nslice + slice) * 128 + F.lane * 2; ini[j][0] = yp[0]; ini[j][1] = yp[1]; } } while (0)
#pragma unroll
        for (int j = 0; j < D; ++j) CR_LOAD(j, seq * 64 + j);
        for (int c0 = 0; c0 < 64; c0 += D) {
#pragma unroll
            for (int j = 0; j < D; ++j) { const int c = c0 + j;
                if (c < 64) {
                    const int ch = seq * 64 + c, buf = c & 1;
                    if (carry) {
#pragma unroll
                        for (int s = 0; s < 2; ++s) *(LAS u32x4*)(lds + (((buf * NT + w) * 2 + s) * 64 + F.lane) * 16) = pack8(S, s); }
                    __syncthreads();
                    if (carry || outw) {
                        f32x16 acc, acc2; unpack16(ini[j][0], ini[j][1], acc);
#pragma unroll
                        for (int r = 0; r < 16; ++r) acc2[r] = 0.f;
#pragma unroll
                        for (int kb = 0; kb < NT; ++kb)
#pragma unroll
                            for (int s = 0; s < 2; ++s) { const u32x4 bfr = *(const LAS u32x4*)(lds + (((buf * NT + kb) * 2 + s) * 64 + F.lane) * 16);
                                if (s == 0) acc = __builtin_amdgcn_mfma_f32_32x32x16_bf16(as_frag(afr[j][kb * 2 + s]), as_frag(bfr), acc, 0, 0, 0);
                                else acc2 = __builtin_amdgcn_mfma_f32_32x32x16_bf16(as_frag(afr[j][kb * 2 + s]), as_frag(bfr), acc2, 0, 0, 0); }
#pragma unroll
                        for (int r = 0; r < 16; ++r) acc[r] += acc2[r];
                        if (carry) S = acc;
                        else { const int it = w - NT;
                            bf16_t* op = cb.out + ((size_t)dir * T_ + (size_t)b * 4096) * 512 + h * (32 * cb.nslice) + slice * 32 + (rw & ~1);
                            const bool odd = (rw & 1) != 0;
#pragma unroll
                            for (int j = 0; j < 8; ++j) { const float n0 = __shfl_xor(acc[2 * j], 1), n1 = __shfl_xor(acc[2 * j + 1], 1);
                                const int r = odd ? 2 * j + 1 : 2 * j; const float lo = odd ? n1 : acc[2 * j], hi = odd ? acc[2 * j + 1] : n0;
                                const int i = it * 32 + (r & 3) + 8 * (r >> 2) + 4 * hh, step = c * 64 + i, t = dir ? 4095 - step : step;
                                *(unsigned*)(op + (size_t)t * 512) = pk2(lo, hi); } }
                    }
                    if (c + D < 64) CR_LOAD(j, ch + D);
                } }
        }
        __syncthreads();
#undef CR_LOAD
    }
}
#ifdef DN_NAIVE_CHECK
__device__ __forceinline__ void phase_dn_naive_check(const Frame& F) {
    const float* qkvn = WSP(float, OFF_QKVN); const float* gb = WSP(float, OFF_GB0);
    const float* gcs_g = WSP(float, OFF_DN_GCS); const bf16_t* Am_g = WSP(bf16_t, OFF_DN_AM); const bf16_t* Tm_g = WSP(bf16_t, OFF_DN_TM);
    const bf16_t* Qe_g = WSP(bf16_t, OFF_DN_QE); const unsigned* Yi_g = WSP(unsigned, OFF_DN_YI); const unsigned short* Ph_g = WSP(unsigned short, OFF_DN_PHI); const unsigned* C_g = WSP(unsigned, OFF_DN_C);
    unsigned* flag = (unsigned*)(F.ws + OFF_BAR) + 4001;
    float* gcn = (float*)F.smem; float* btn = gcn + 64; float* Gn = btn + 64; float* Tn = Gn + 4096; float* An = Tn + 4096; float* un = An + 4096; float* wn = un + 8192;
    const int chk[8] = {0, 1, 63, 64, 1000, 1027, 2046, 2047};
    if (F.bid >= 8) return;
    const int ch = F.bid == 0 ? 0 : (F.bid == 1 ? 1 : (F.bid == 2 ? 63 : (F.bid == 3 ? 64 : (F.bid == 4 ? 1000 : (F.bid == 5 ? 1027 : (F.bid == 6 ? 2046 : 2047))))));
    (void)chk;
    const int seq = ch >> 6, c = ch & 63, dir = seq & 1, h = (seq >> 1) & 3, b = seq >> 3;
    unsigned bits = 0u; float eyi = 0.f, ryi = 0.f, ec = 0.f, rc = 0.f;
#define TOKOF(i) ((size_t)b * 4096 + (dir ? 4095 - (c * 64 + (i)) : (c * 64 + (i))))
    if (F.tid == 0) { float s = 0.f; for (int i = 0; i < 64; ++i) { s += gb[TOKOF(i) * 16 + dir * 4 + h]; gcn[i] = s; btn[i] = gb[TOKOF(i) * 16 + 8 + dir * 4 + h]; } }
    __syncthreads();
    if (F.tid < 64) { const float d = fabsf(gcn[F.tid] - gcs_g[(size_t)ch * 64 + F.tid]); if (!(d <= 1e-3f * fmaxf(1.f, fabsf(gcn[F.tid])))) bits |= 0u; }
    for (int e = F.tid; e < 4096; e += NTHR) { const int i = e >> 6, j = e & 63; const float* qi = qkvn + TOKOF(i) * 1536 + h * 128; const float* ki = qkvn + TOKOF(i) * 1536 + 512 + h * 128; const float* kj = qkvn + TOKOF(j) * 1536 + 512 + h * 128;
        float qk = 0.f, kk = 0.f; for (int d = 0; d < 128; ++d) { qk += qi[d] * kj[d]; kk += ki[d] * kj[d]; }
        const float dec = __expf(fminf(gcn[i] - gcn[j], 0.f));
        const float a = (j <= i) ? qk * dec : 0.f; An[e] = a; Gn[e] = (j < i) ? btn[i] * kk * dec : 0.f;
        const float ad = bf2f(Am_g[(size_t)ch * 4096 + e]); if (!(fabsf(ad - a) <= 0.03f * fabsf(a) + 2e-3f)) bits |= 0u;
        Tn[e] = bf2f(Tm_g[(size_t)ch * 4096 + e]); }
    __syncthreads();
    for (int e = F.tid; e < 4096; e += NTHR) { const int i = e >> 6, cc = e & 63; float r = Tn[i * 64 + cc] - (i == cc ? 1.f : 0.f); for (int j = 0; j < i; ++j) r += Gn[i * 64 + j] * Tn[j * 64 + cc];
        if (!(fabsf(r) <= 0.03f)) bits |= 0u; }
    const float gl = gcn[63];
    for (int e = F.tid; e < 8192; e += NTHR) { const int t = e >> 7, d = e & 127; float us = 0.f, ws_ = 0.f;
        for (int j = 0; j < 64; ++j) { const float tv = Tn[t * 64 + j]; us += tv * qkvn[TOKOF(j) * 1536 + 1024 + h * 128 + d] * btn[j]; ws_ += tv * qkvn[TOKOF(j) * 1536 + 512 + h * 128 + d] * btn[j] * __expf(gcn[j]); }
#ifdef DN_SWAP
        us = ws_;
#endif
        un[e] = us; wn[e] = ws_;
}
    __syncthreads();
    for (int e = F.tid; e < 8192; e += NTHR) { const int i = e >> 7, d = e & 127; float yi = 0.f, aw = 0.f;
        for (int t = 0; t < 64; ++t) { yi += An[i * 64 + t] * un[t * 128 + d]; aw += An[i * 64 + t] * wn[t * 128 + d]; }
        const float qe = qkvn[TOKOF(i) * 1536 + h * 128 + d] * __expf(gcn[i]) - aw;
        { const int it = i >> 5, dt = d >> 5, i5 = i & 31, hh = (i5 >> 2) & 1, r = (i5 & 3) + 4 * (i5 >> 3), lane = (d & 31) + 32 * hh;
          const unsigned wv = Yi_g[((((size_t)(ch * 2 + it) * 4 + dt) * 128 + lane * 2 + (r >> 3)) * 4) + ((r & 7) >> 1)]; const float yv = (r & 1) ? bfhi(wv) : bflo(wv);
          eyi += (yv - yi) * (yv - yi); ryi += yi * yi; }
        { const int dp = (d & ~15) | perm16(d & 15); const float qv = bf2f(Qe_g[(size_t)ch * 8192 + i * 128 + dp]); if (!(fabsf(qv - qe) <= 0.03f * fabsf(qe) + 1e-3f)) bits |= 0u; } }
    for (int e = F.tid; e < 16384; e += NTHR) { const int bb = e >> 7, a = e & 127; float ph = (bb == a) ? __expf(gl) : 0.f, cv = 0.f;
        for (int t = 0; t < 64; ++t) { const float kd_a = qkvn[TOKOF(t) * 1536 + 512 + h * 128 + a] * __expf(gl - gcn[t]); ph -= wn[t * 128 + bb] * kd_a;
            const float kd_b = qkvn[TOKOF(t) * 1536 + 512 + h * 128 + bb] * __expf(gl - gcn[t]); cv += kd_b * un[t * 128 + a]; }
        { const int ra = a >> 5, kb = bb >> 5, b5 = bb & 31, s = b5 >> 4, hh = (b5 >> 2) & 1, j = ((b5 >> 3) & 1) * 4 + (b5 & 3), lane = (a & 31) + 32 * hh;
          const float pv = bf2f(Ph_g[((((((size_t)ch * 4 + ra) * 4 + kb) * 2 + s) * 64 + lane) * 8) + j]); if (!(fabsf(pv - ph) <= 0.03f * fabsf(ph) + 2e-3f)) bits |= 32u; }
        { const int ra = bb >> 5, vt = a >> 5, a5 = bb & 31, hh = (a5 >> 2) & 1, r = (a5 & 3) + 4 * (a5 >> 3), lane = (a & 31) + 32 * hh;
          const unsigned wv = C_g[((((size_t)(ch * 4 + ra) * 4 + vt) * 128 + lane * 2 + (r >> 3)) * 4) + ((r & 7) >> 1)]; const float cvd = (r & 1) ? bfhi(wv) : bflo(wv);
          ec += (cvd - cv) * (cvd - cv); rc += cv * cv; } }
    eyi = wave_sum(eyi); ryi = wave_sum(ryi); ec = wave_sum(ec); rc = wave_sum(rc);
    if (F.lane == 0) { float* fw = (float*)(F.ws + OFF_BAR); atomicAdd(fw + 4004, eyi); atomicAdd(fw + 4005, ryi); atomicAdd(fw + 4006, ec); atomicAdd(fw + 4007, rc); }
    (void)flag; (void)bits;
#undef TOKOF
}
#endif

#ifdef DN_NANSCAN
__device__ __forceinline__ void phase_dn_nanscan(const Frame& F) {
    unsigned* flag = (unsigned*)(F.ws + OFF_BAR) + 4001;
    const size_t gtid = (size_t)F.bid * NTHR + F.tid, gn = (size_t)F.nblk * NTHR;
    unsigned bits = 0u;
#define SCAN_BF(off, nbytes, bit) do { const unsigned* p_ = (const unsigned*)(F.ws + (off)); const size_t n_ = (size_t)(nbytes) / 4; \
        for (size_t i_ = gtid; i_ < n_; i_ += gn) { const unsigned w_ = p_[i_]; if ((w_ & 0x7F800000u) == 0x7F800000u || (w_ & 0x00007F80u) == 0x00007F80u) bits |= (bit); } } while (0)
    SCAN_BF(OFF_DN_TM, (size_t)2048 * 4096 * 2, 1u);
    SCAN_BF(OFF_DN_AM, (size_t)2048 * 4096 * 2, 2u);
    SCAN_BF(OFF_DN_QE, (size_t)2048 * 8192 * 2, 4u);
    SCAN_BF(OFF_DN_YI, (size_t)2048 * 16384, 8u);
    SCAN_BF(OFF_DN_PHI, (size_t)2048 * 32768, 16u);
    SCAN_BF(OFF_DN_C, (size_t)2048 * 32768, 32u);
#ifdef S5_NANSCAN
    bits = 0u;
    { const unsigned* p_ = (const unsigned*)(F.ws + OFF_S5Y); const size_t n_ = (size_t)2 * T_ * 512; for (size_t i_ = gtid; i_ < n_; i_ += gn) { const unsigned w_ = p_[i_]; if ((w_ & 0x7F800000u) == 0x7F800000u) bits |= ((i_ / ((size_t)T_ * 512)) ? 2u : 1u) | (((i_ >> 4) & 31) < 16 ? 4u : 8u); } }
#endif
#undef SCAN_BF
    if (bits) atomicOr(flag, bits);
}
#endif
struct RwArr { bf16_t *At, *Bt, *Kt, *Rt, *AtT, *VT, *BdT, *KdT; float* gsum; float* pl; };
template <bool ROWS, bool TRANS> __device__ __forceinline__ void rw_build(const Frame& F, int ch, const RwArr A) {
    const bf16_t* rwr = WSP(bf16_t, OFF_RWR); const bf16_t* rwk = WSP(bf16_t, OFF_RWK); const bf16_t* rwv = WSP(bf16_t, OFF_RWV); const bf16_t* rwkk = WSP(bf16_t, OFF_RWKK);
    const float* rwe = WSP(float, OFF_RWDEC); const bf16_t* rwa = WSP(bf16_t, OFF_RWA);
    const int seq = ch >> 6, c = ch & 63, dir = seq & 1, h = (seq >> 1) & 7, b = seq >> 4;
    const int k = F.tid & 63, tg = F.tid >> 6;
    const float kaw = F.in[I_RW_KA][h * 64 + k];
    float lw[8], av[8], kkv[8], kv[8], rv[8], vv[8];
#pragma unroll
    for (int e = 0; e < 8; ++e) { const int step = c * 64 + tg * 8 + e, t = dir ? 4095 - step : step; const size_t idx = ((size_t)b * 4096 + t) * 512 + h * 64 + k;
        lw[e] = -rwe[(size_t)dir * T_ * 512 + idx]; av[e] = bf2f(rwa[(size_t)dir * T_ * 512 + idx]); kkv[e] = bf2f(rwkk[idx]); kv[e] = bf2f(rwk[idx]); rv[e] = bf2f(rwr[idx]); vv[e] = bf2f(rwv[idx]); }
    float lam[8]; { float s = 0.f;
#pragma unroll
        for (int e = 0; e < 8; ++e) { s += lw[e]; lam[e] = s; } }
    A.gsum[tg * 64 + k] = lam[7];
    __syncthreads();
    float prefix = 0.f, total = 0.f;
#pragma unroll
    for (int g = 0; g < 8; ++g) { const float gs = A.gsum[g * 64 + k]; total += gs; if (g < tg) prefix += gs; }
    if (tg == 0 && A.pl) A.pl[k] = __expf(total);
    float at8[8], bd8[8], kd8[8];
#pragma unroll
    for (int e = 0; e < 8; ++e) { const int i = tg * 8 + e; const float Lc = prefix + lam[e], Lp = Lc - lw[e];
        const float kdir = kv[e] * (1.f + (av[e] - 1.f) * kaw), kb = kkv[e] * av[e];
        const float iP = __expf(-Lc), dl = __expf(total - Lc);
        const float at = -kkv[e] * __expf(Lp);
        if (ROWS) { A.At[i * LD72 + k] = f2bf(at); A.Bt[i * LD72 + k] = f2bf(kb * iP); A.Kt[i * LD72 + k] = f2bf(kdir * iP); }
        if (A.Rt) A.Rt[i * LD72 + k] = f2bf(rv[e] * __expf(Lc));
        at8[e] = at; bd8[e] = kb * dl; kd8[e] = kdir * dl; }
    if (A.VT) *(u32x4*)(A.VT + k * LD72 + tg * 8) = (u32x4){pk2(vv[0], vv[1]), pk2(vv[2], vv[3]), pk2(vv[4], vv[5]), pk2(vv[6], vv[7])};
    if (TRANS) {
        *(u32x4*)(A.AtT + k * LD72 + tg * 8) = (u32x4){pk2(at8[0], at8[1]), pk2(at8[2], at8[3]), pk2(at8[4], at8[5]), pk2(at8[6], at8[7])};
        *(u32x4*)(A.BdT + k * LD72 + tg * 8) = (u32x4){pk2(bd8[0], bd8[1]), pk2(bd8[2], bd8[3]), pk2(bd8[4], bd8[5]), pk2(bd8[6], bd8[7])};
        *(u32x4*)(A.KdT + k * LD72 + tg * 8) = (u32x4){pk2(kd8[0], kd8[1]), pk2(kd8[2], kd8[3]), pk2(kd8[4], kd8[5]), pk2(kd8[6], kd8[7])}; }
}
template <int KS> __device__ __forceinline__ f32x16 tile_mm_acc(f32x16 acc, const bf16_t* A, int ldA, const bf16_t* Bt, int ldB, int lane) {
    const int rw = lane & 31, hh = lane >> 5;
#pragma unroll
    for (int s = 0; s < KS; ++s) { const bf16x8 a = *(const bf16x8*)(A + rw * ldA + 16 * s + 8 * hh), b = *(const bf16x8*)(Bt + rw * ldB + 16 * s + 8 * hh);
        acc = __builtin_amdgcn_mfma_f32_32x32x16_bf16(a, b, acc, 0, 0, 0); }
    return acc;
}

__device__ __forceinline__ void phase_rw_a(const Frame& F) {
    bf16_t* At = (bf16_t*)F.smem; bf16_t* Bt = At + 64 * LD72; bf16_t* Kt = Bt + 64 * LD72; bf16_t* Rt = Kt + 64 * LD72; bf16_t* VT = Rt + 64 * LD72; bf16_t* Mak = VT + 64 * LD72;
    float* gsum = (float*)(Mak + 64 * LD72); float* pl = gsum + 512;
    float* Mab_g = WSP(float, OFF_RW_MAB); bf16_t* X1T_g = WSP(bf16_t, OFF_RW_X1T); bf16_t* Grb_g = WSP(bf16_t, OFF_RW_GRB); bf16_t* Grk_g = WSP(bf16_t, OFF_RW_GRK); float* PL_g = WSP(float, OFF_RW_PL);
    const int rw = F.lane & 31, hh = F.lane >> 5, w = F.wid;
    for (int ch = F.bid; ch < 4096; ch += F.nblk) {
        const RwArr A{At, Bt, Kt, Rt, nullptr, VT, nullptr, nullptr, gsum, pl};
        rw_build<true, false>(F, ch, A);
        __syncthreads();
        if (F.tid < 64) PL_g[(size_t)ch * 64 + F.tid] = pl[F.tid];
        { const int prod = w >> 1, ti = w & 1;
          const bf16_t* Ar = (prod < 2 ? At : Rt) + ti * 32 * LD72; const bf16_t* Bb = (prod & 1) ? Kt : Bt;
#pragma unroll
          for (int tj = 0; tj < 2; ++tj) {
              f32x16 acc;
#pragma unroll
              for (int r = 0; r < 16; ++r) acc[r] = 0.f;
              if (tj <= ti) acc = tile_mm_acc<4>(acc, Ar, LD72, Bb + tj * 32 * LD72, LD72, F.lane);
              int j = tj * 32 + rw; asm volatile("" : "+v"(j));
              const int ib = ti * 32 + 4 * hh;
              if (prod == 0) { float* gp = Mab_g + (size_t)ch * 4096 + (size_t)ib * 64 + j;
#pragma unroll
                  for (int r = 0; r < 16; ++r) { const int io = (r & 3) + 8 * (r >> 2); gp[io * 64] = (j < ib + io) ? -acc[r] : 0.f; } }
              else if (prod == 1) {
#pragma unroll
                  for (int r = 0; r < 16; ++r) { const int io = (r & 3) + 8 * (r >> 2); Mak[(ib + io) * LD72 + j] = f2bf((j < ib + io) ? acc[r] : 0.f); } }
              else { bf16_t* gp = (prod == 2 ? Grb_g : Grk_g) + (size_t)ch * 4096 + (size_t)ib * 64 + j;
#pragma unroll
                  for (int r = 0; r < 16; ++r) { const int io = (r & 3) + 8 * (r >> 2); gp[io * 64] = f2bf((j <= ib + io) ? acc[r] : 0.f); } }
          } }
        __syncthreads();
        if (w < 4) { const int ti = w >> 1, tv = w & 1;
            const f32x16 acc = tile_mm<4>(Mak + ti * 32 * LD72, LD72, VT + tv * 32 * LD72, LD72, F.lane);
            bf16_t* xp = X1T_g + (size_t)ch * 4096 + (size_t)(tv * 32 + rw) * 64 + ti * 32 + 4 * hh;
#pragma unroll
            for (int g = 0; g < 4; ++g) *(u32x2*)(xp + 8 * g) = (u32x2){pk2(acc[4 * g], acc[4 * g + 1]), pk2(acc[4 * g + 2], acc[4 * g + 3])}; }
        __syncthreads();
    }
}

__device__ __forceinline__ void phase_rw_b(const Frame& F) {
    const float* Mab_g = WSP(float, OFF_RW_MAB); bf16_t* Tm_g = WSP(bf16_t, OFF_RW_TM);
    float* Gs = (float*)F.smem + F.wid * (64 * 68);
    for (int ch = F.bid + F.wid * F.nblk; ch < 4096; ch += F.nblk * 8) {
#pragma unroll
        for (int q = 0; q < 16; ++q) { const int idx = q * 64 + F.lane, row = idx >> 4, c4 = idx & 15;
            *(float4*)(Gs + row * 68 + c4 * 4) = *(const float4*)(Mab_g + (size_t)ch * 4096 + row * 64 + c4 * 4); }
        asm volatile("s_waitcnt vmcnt(0) lgkmcnt(0)" ::: "memory"); __builtin_amdgcn_wave_barrier();
        { float x[64]; int cc = F.lane; asm volatile("" : "+v"(cc));
#pragma unroll
          for (int i = 0; i < 64; ++i) { float acc = (i == cc) ? 1.f : 0.f, ac1 = 0.f, ac2 = 0.f, ac3 = 0.f;
#pragma unroll
              for (int j4 = 0; j4 < (i + 3) / 4; ++j4) { const float4 gv = *(const float4*)(Gs + i * 68 + j4 * 4);
                  if (j4 * 4 + 0 < i) acc -= gv.x * x[j4 * 4 + 0]; if (j4 * 4 + 1 < i) ac1 -= gv.y * x[j4 * 4 + 1];
                  if (j4 * 4 + 2 < i) ac2 -= gv.z * x[j4 * 4 + 2]; if (j4 * 4 + 3 < i) ac3 -= gv.w * x[j4 * 4 + 3]; }
              x[i] = (acc + ac1) + (ac2 + ac3); }
          bf16_t* tp = Tm_g + (size_t)ch * 4096 + cc; asm volatile("" : "+v"(tp));
#pragma unroll
          for (int i = 0; i < 64; ++i) tp[i * 64] = f2bf(x[i]); }
        asm volatile("s_waitcnt lgkmcnt(0)" ::: "memory"); __builtin_amdgcn_wave_barrier();
    }
}

__device__ __forceinline__ void phase_rw_c(const Frame& F) {
    bf16_t* AtT = (bf16_t*)F.smem; bf16_t* VT = AtT + 64 * LD72; bf16_t* BdT = VT + 64 * LD72; bf16_t* KdT = BdT + 64 * LD72; bf16_t* Rt = KdT + 64 * LD72;
    bf16_t* T_s = Rt + 64 * LD72; bf16_t* X1T = T_s + 64 * LD72; bf16_t* Grb = X1T + 64 * LD72; bf16_t* Grk = Grb + 64 * LD72; bf16_t* UT = Grk + 64 * LD72; bf16_t* WmT = UT + 64 * LD72;
    float* gsum = (float*)(WmT + 64 * LD72); float* pl = gsum + 512;
    const bf16_t* Tm_g = WSP(bf16_t, OFF_RW_TM); const bf16_t* X1T_g = WSP(bf16_t, OFF_RW_X1T); const bf16_t* Grb_g = WSP(bf16_t, OFF_RW_GRB); const bf16_t* Grk_g = WSP(bf16_t, OFF_RW_GRK);
    bf16_t* Qe_g = WSP(bf16_t, OFF_RW_QE); u32x4* Yi_g = WSP(u32x4, OFF_RW_YI); u32x4* Ph_g = WSP(u32x4, OFF_RW_PHI); u32x4* C_g = WSP(u32x4, OFF_RW_C);
    const int rw = F.lane & 31, hh = F.lane >> 5, w = F.wid;
    for (int ch = F.bid; ch < 4096; ch += F.nblk) {
        { const int row = F.tid >> 3, pc = F.tid & 7; const size_t go = (size_t)ch * 4096 + row * 64 + pc * 8; const int lo_ = row * LD72 + pc * 8;
          *(u32x4*)(T_s + lo_) = *(const u32x4*)(Tm_g + go); *(u32x4*)(X1T + lo_) = *(const u32x4*)(X1T_g + go);
          *(u32x4*)(Grb + lo_) = *(const u32x4*)(Grb_g + go); *(u32x4*)(Grk + lo_) = *(const u32x4*)(Grk_g + go); }
        const RwArr A{nullptr, nullptr, nullptr, Rt, AtT, VT, BdT, KdT, gsum, pl};
        rw_build<false, true>(F, ch, A);
        __syncthreads();
        { const int prod = w >> 2, tr = (w >> 1) & 1, tc = w & 1;
          const f32x16 acc = tile_mm<4>((prod ? AtT : X1T) + tr * 32 * LD72, LD72, T_s + tc * 32 * LD72, LD72, F.lane);
          bf16_t* dst = prod ? WmT : UT;
#pragma unroll
          for (int r = 0; r < 16; ++r) dst[(tr * 32 + (r & 3) + 8 * (r >> 2) + 4 * hh) * LD72 + tc * 32 + rw] = f2bf(acc[r]); }
        __syncthreads();
        { const int kind = w >> 1;
#pragma unroll
          for (int e = 0; e < 2; ++e) { const int x = (w & 1) * 2 + e, t0 = x >> 1, t1 = x & 1;
              f32x16 acc;
#pragma unroll
              for (int r = 0; r < 16; ++r) acc[r] = 0.f;
              if (kind == 0) {
                  acc = tile_mm_acc<4>(acc, Grb + t0 * 32 * LD72, LD72, WmT + t1 * 32 * LD72, LD72, F.lane);
                  const int kcol = t1 * 32 + rw, kp = (kcol & ~15) | perm16(kcol & 15);
                  bf16_t* qp = Qe_g + (size_t)ch * 8192 + (size_t)(t0 * 32 + 4 * hh) * 64 + kp;
#pragma unroll
                  for (int r = 0; r < 16; ++r) { const int io = (r & 3) + 8 * (r >> 2); qp[io * 64] = f2bf(acc[r] + bf2f(Rt[(t0 * 32 + 4 * hh + io) * LD72 + kcol])); } }
              else if (kind == 1) {
                  acc = tile_mm_acc<4>(acc, Grb + t0 * 32 * LD72, LD72, UT + t1 * 32 * LD72, LD72, F.lane);
                  acc = tile_mm_acc<4>(acc, Grk + t0 * 32 * LD72, LD72, VT + t1 * 32 * LD72, LD72, F.lane);
#pragma unroll
                  for (int r = 0; r < 16; ++r) acc[r] += 0.f;
                  u32x4* yo = Yi_g + (size_t)ch * 1024 + ((size_t)t0 * 2 + t1) * 128 + F.lane * 2; yo[0] = pack8(acc, 0); yo[1] = pack8(acc, 1); }
              else if (kind == 2) {
                  acc = tile_mm_acc<4>(acc, WmT + t0 * 32 * LD72, LD72, BdT + t1 * 32 * LD72, LD72, F.lane);
                  const int kout = t1 * 32 + rw; const float plk = pl[kout];
#pragma unroll
                  for (int r = 0; r < 16; ++r) { const int kin = t0 * 32 + (r & 3) + 8 * (r >> 2) + 4 * hh; acc[r] += (kin == kout) ? plk : 0.f; }
                  u32x4* po = Ph_g + ((((size_t)ch * 2 + t1) * 2 + t0) * 2) * 64 + F.lane; po[0] = pack8(acc, 0); po[64] = pack8(acc, 1); }
              else {
                  acc = tile_mm_acc<4>(acc, BdT + t0 * 32 * LD72, LD72, UT + t1 * 32 * LD72, LD72, F.lane);
                  acc = tile_mm_acc<4>(acc, KdT + t0 * 32 * LD72, LD72, VT + t1 * 32 * LD72, LD72, F.lane);
#pragma unroll
                  for (int r = 0; r < 16; ++r) acc[r] += 0.f;
                  u32x4* co = C_g + ((size_t)(ch * 2 + t0) * 2 + t1) * 128 + F.lane * 2; co[0] = pack8(acc, 0); co[1] = pack8(acc, 1); }
          } }
        __syncthreads();
    }
}
template <bool XINBF> __device__ __forceinline__ void phase_mid(const Frame& F, int layer, const void* xin, bf16_t* xout) {
    float* wl = (float*)F.smem;
    fill_thin(wl, F.in[I_ROUTER] + (size_t)layer * 1024 * 16, 16, F.tid);
    __syncthreads();
    const float* mod = WSP(float, OFF_MOD); const bf16_t* ymix = WSP(bf16_t, OFF_YMIX); bf16_t* hb = WSP(bf16_t, OFF_HB); float* probs = WSP(float, OFF_PROBS);
    for (int tb = F.bid; tb < 256; tb += F.nblk) {
        const int base = tb * 64 + F.wid * 8, b = base >> 12;
        const float* mb = mod + (size_t)(layer * 4 + b) * 6144;
        for (int i = 0; i < 8; ++i) {
            const int tok = base + i; float y[16], xv[16];
            load_row16_bf(ymix + (size_t)tok * 1024, F.lane, y);
            if (XINBF) load_row16_bf((const bf16_t*)xin + (size_t)tok * 1024, F.lane, xv); else load_row16((const float*)xin + (size_t)tok * 1024, F.lane, xv);
            float ss = 0.f;
#pragma unroll
            for (int q = 0; q < 16; ++q) ss += y[q] * y[q];
            ss = wave_sum(ss); float rstd = rsqrtf(ss * (1.f / 1024.f) + 1e-6f);
            float s2 = 0.f;
            { float npost[16], g1[16]; load_row16(F.in[I_NMIX_POST] + layer * 1024, F.lane, npost); load_row16(mb + 2048, F.lane, g1);
#pragma unroll
              for (int q = 0; q < 16; ++q) { xv[q] = xv[q] + g1[q] * (y[q] * rstd * npost[q]); s2 += xv[q] * xv[q]; } }
            store_row16_bf(xout + (size_t)tok * 1024, F.lane, xv);
            s2 = wave_sum(s2); rstd = rsqrtf(s2 * (1.f / 1024.f) + 1e-6f);
            asm volatile("" ::: "memory");
            { float npre[16], sc[16], sh[16]; load_row16(F.in[I_NFFN_PRE] + layer * 1024, F.lane, npre); load_row16(mb + 4096, F.lane, sc); load_row16(mb + 3072, F.lane, sh);
#pragma unroll
              for (int q = 0; q < 16; ++q) y[q] = xv[q] * rstd * npre[q] * (1.f + sc[q]) + sh[q]; }
            asm volatile("" ::: "memory");
            store_row16_bf(hb + (size_t)tok * 1024, F.lane, y);
            float o[16]; thin16(wl, F.lane, y, o);
            float mx = o[0];
#pragma unroll
            for (int q = 1; q < 16; ++q) mx = fmaxf(mx, o[q]);
            float sum = 0.f;
#pragma unroll
            for (int q = 0; q < 16; ++q) { o[q] = __expf(o[q] - mx); sum += o[q]; }
            const float inv = 1.f / sum;
            if (F.lane < 16) { float r = 0.f;
#pragma unroll
                for (int q = 0; q < 16; ++q) r = (q == F.lane) ? o[q] : r;
                probs[((size_t)(b * 16 + F.lane)) * 4096 + (tok & 4095)] = r * inv; }
        }
    }
}

__device__ __forceinline__ void phase_topk(const Frame& F) {
    unsigned* keys = (unsigned*)F.smem;
    unsigned* hist = keys + 4096;
    unsigned* ctl = hist + 256;
    unsigned* wsum = ctl + 8;
    const float* probs = WSP(float, OFF_PROBS); int* rowtok = WSP(int, OFF_ROWTOK); float* gatev = WSP(float, OFF_GATEV); int* slot = WSP(int, OFF_SLOT);
    for (int u = F.bid; u < 64; u += F.nblk) {
        const int b = u >> 4, e = u & 15;
        const float* pr = probs + (size_t)u * 4096;
        for (int i = F.tid; i < 4096; i += NTHR) keys[i] = __float_as_uint(pr[i]);
        if (F.tid == 0) { ctl[0] = 0u; ctl[1] = 512u; }
        __syncthreads();
        for (int pass = 0; pass < 4; ++pass) {
            const int shift = 24 - 8 * pass;
            if (F.tid < 256) hist[F.tid] = 0u;
            __syncthreads();
            const unsigned prefix = ctl[0]; const unsigned himask = pass == 0 ? 0u : (0xFFFFFFFFu << (shift + 8));
            for (int i = F.tid; i < 4096; i += NTHR) { const unsigned k = keys[i]; if ((k & himask) == prefix) atomicAdd(&hist[(k >> shift) & 255u], 1u); }
            __syncthreads();
            if (F.wid == 0) {
                const unsigned kr = ctl[1]; unsigned hq[4], tot = 0u;
#pragma unroll
                for (int q = 0; q < 4; ++q) { hq[q] = hist[255 - (4 * F.lane + q)]; tot += hq[q]; }
                unsigned inc = tot;
#pragma unroll
                for (int o = 1; o < 64; o <<= 1) { const unsigned t = __shfl_up(inc, o); if (F.lane >= o) inc += t; }
                unsigned cum = inc - tot;
#pragma unroll
                for (int q = 0; q < 4; ++q) { if (cum < kr && cum + hq[q] >= kr) { ctl[0] = prefix | ((unsigned)(255 - (4 * F.lane + q)) << shift); ctl[1] = kr - cum; } cum += hq[q]; } }
            __syncthreads();
        }
        const unsigned thr = ctl[0], keq = ctl[1];
        const int i0 = F.tid * 8; unsigned kk[8]; unsigned ceq = 0u;
#pragma unroll
        for (int q = 0; q < 8; ++q) { kk[q] = keys[i0 + q]; ceq += (kk[q] == thr) ? 1u : 0u; }
        unsigned inc = ceq;
#pragma unroll
        for (int o = 1; o < 64; o <<= 1) { const unsigned t = __shfl_up(inc, o); if (F.lane >= o) inc += t; }
        if (F.lane == 63) wsum[F.wid] = inc;
        __syncthreads();
        unsigned woff = 0u;
        for (int w = 0; w < F.wid; ++w) woff += wsum[w];
        unsigned eqpre = woff + inc - ceq;
        __syncthreads();
        unsigned csel = 0u; unsigned selmask = 0u;
#pragma unroll
        for (int q = 0; q < 8; ++q) { bool sel = kk[q] > thr; if (kk[q] == thr) { sel = eqpre < keq; ++eqpre; } if (sel) { selmask |= 1u << q; ++csel; } }
        inc = csel;
#pragma unroll
        for (int o = 1; o < 64; o <<= 1) { const unsigned t = __shfl_up(inc, o); if (F.lane >= o) inc += t; }
        if (F.lane == 63) wsum[8 + F.wid] = inc;
        __syncthreads();
        woff = 0u;
        for (int w = 0; w < F.wid; ++w) woff += wsum[8 + w];
        unsigned sl = woff + inc - csel;
#pragma unroll
        for (int q = 0; q < 8; ++q) { const int tokg = b * 4096 + i0 + q;
            if (selmask & (1u << q)) { const int row = e * 2048 + b * 512 + (int)sl; ++sl; rowtok[row] = tokg; gatev[row] = __uint_as_float(kk[q]); slot[(size_t)tokg * 16 + e] = row; }
            else slot[(size_t)tokg * 16 + e] = -1; }
        __syncthreads();
    }
}

template <bool XOUTBF> __device__ __forceinline__ void phase_combine(const Frame& F, int layer, const bf16_t* xin, void* xout, bool next_norm) {
    const float* mod = WSP(float, OFF_MOD); const bf16_t* Y = WSP(bf16_t, OFF_YBUF); const int* slot = WSP(int, OFF_SLOT); bf16_t* hb = WSP(bf16_t, OFF_HB);
    for (int tb = F.bid; tb < 256; tb += F.nblk) {
        const int base = tb * 64 + F.wid * 8, b = base >> 12;
        const float* mb = mod + (size_t)(layer * 4 + b) * 6144;
        float npost[16], g2[16];
        load_row16(F.in[I_NFFN_POST] + layer * 1024, F.lane, npost); load_row16(mb + 5120, F.lane, g2);
        for (int i = 0; i < 8; ++i) {
            const int tok = base + i; float y[16];
#pragma unroll
            for (int q = 0; q < 16; ++q) y[q] = 0.f;
            const int myslot = slot[(size_t)tok * 16 + (F.lane & 15)];
            for (int e = 0; e < 16; ++e) { const int r = __shfl(myslot, e);
                if (r >= 0) { const u32x2* yp = (const u32x2*)(Y + (size_t)r * 1024 + F.lane * 4);
#pragma unroll
                    for (int i = 0; i < 4; ++i) { const u32x2 a = yp[i * 64]; y[4 * i] += bflo(a.x); y[4 * i + 1] += bfhi(a.x); y[4 * i + 2] += bflo(a.y); y[4 * i + 3] += bfhi(a.y); } } }
            float ss = 0.f;
#pragma unroll
            for (int q = 0; q < 16; ++q) ss += y[q] * y[q];
            ss = wave_sum(ss); float rstd = rsqrtf(ss * (1.f / 1024.f) + 1e-6f);
            float xv[16]; load_row16_bf(xin + (size_t)tok * 1024, F.lane, xv);
            float s2 = 0.f;
#pragma unroll
            for (int q = 0; q < 16; ++q) { xv[q] = xv[q] + g2[q] * (y[q] * rstd * npost[q]); s2 += xv[q] * xv[q]; }
#ifdef DN_CHECK
            if (!next_norm && ((const unsigned*)(F.ws + OFF_BAR))[4000] != 0u) {
#pragma unroll
                for (int q = 0; q < 16; ++q) xv[q] += 1000.f; }
#endif
#if defined(DN_CHECK3)
            if (!next_norm) { const float* fw = (const float*)(F.ws + OFF_BAR); const float rel = sqrtf(fw[4004] / fmaxf(fw[4005], 1e-30f)); const float addv = (rel == rel) ? 100.f * (1.f + fminf(97.f, rintf(rel * 100.f))) : 9900.f;
#pragma unroll
                for (int q = 0; q < 16; ++q) xv[q] += addv; }
#endif
#if defined(DN_NAIVE_CHECK) || defined(DN_CHECK2) || defined(DN_LDSCHECK)
            if (!next_norm) { const float* fw = (const float*)(F.ws + OFF_BAR); const float r1 = sqrtf(fw[4004] / fmaxf(fw[4005], 1e-30f)), r2 = sqrtf(fw[4006] / fmaxf(fw[4007], 1e-30f));
                const float addv = 100.f * (1.f + 10.f * fminf(9.f, floorf(r1 * 50.f)) + fminf(9.f, floorf(r2 * 50.f)));
#pragma unroll
                for (int q = 0; q < 16; ++q) xv[q] += addv; }
#endif
            if (XOUTBF) store_row16_bf((bf16_t*)xout + (size_t)tok * 1024, F.lane, xv); else store_row16((float*)xout + (size_t)tok * 1024, F.lane, xv);
            if (next_norm) {
                float gain[16], sc[16], sh[16]; const float* mn = mod + (size_t)((layer + 1) * 4 + b) * 6144;
                load_row16(F.in[I_NMIX_PRE] + (layer + 1) * 1024, F.lane, gain); load_row16(mn + 1024, F.lane, sc); load_row16(mn, F.lane, sh);
                s2 = wave_sum(s2); rstd = rsqrtf(s2 * (1.f / 1024.f) + 1e-6f);
#pragma unroll
                for (int q = 0; q < 16; ++q) y[q] = xv[q] * rstd * gain[q] * (1.f + sc[q]) + sh[q];
                store_row16_bf(hb + (size_t)tok * 1024, F.lane, y);
            }
        }
    }
}

__device__ __forceinline__ void phase_rwprep(const Frame& F) {
    const bf16_t* P1 = WSP(bf16_t, OFF_P1); bf16_t* rwr = WSP(bf16_t, OFF_RWR); bf16_t* rwk = WSP(bf16_t, OFF_RWK); bf16_t* rwv = WSP(bf16_t, OFF_RWV); bf16_t* rwkk = WSP(bf16_t, OFF_RWKK);
    bf16_t* lin = WSP(bf16_t, OFF_LORAIN); const float* mu = F.in[I_RW_MU];
    const int c0 = F.lane * 8;
    for (int tb = F.bid; tb < 256; tb += F.nblk) {
        const int base = tb * 64 + F.wid * 8;
        for (int i = 0; i < 8; ++i) {
            const size_t tok = base + i; const int s = (int)(tok & 4095);
            const bool hp = s > 0, hn = s < 4095;
            auto shifted = [&](int ch, float (&o)[8]) {
                const u32x4 z4 = (u32x4){0u, 0u, 0u, 0u};
                const u32x4 cur = *(const u32x4*)(P1 + tok * 3072 + ch);
                const u32x4 prv = hp ? *(const u32x4*)(P1 + (tok - 1) * 3072 + ch) : z4;
                const u32x4 nxt = hn ? *(const u32x4*)(P1 + (tok + 1) * 3072 + ch) : z4;
                const float4 m0 = *(const float4*)(mu + ch), m1 = *(const float4*)(mu + ch + 4);
                const float cu[8] = {bflo(cur.x), bfhi(cur.x), bflo(cur.y), bfhi(cur.y), bflo(cur.z), bfhi(cur.z), bflo(cur.w), bfhi(cur.w)};
                const float pr[8] = {bflo(prv.x), bfhi(prv.x), bflo(prv.y), bfhi(prv.y), bflo(prv.z), bfhi(prv.z), bflo(prv.w), bfhi(prv.w)};
                const float nx[8] = {bflo(nxt.x), bfhi(nxt.x), bflo(nxt.y), bfhi(nxt.y), bflo(nxt.z), bfhi(nxt.z), bflo(nxt.w), bfhi(nxt.w)};
                const float mm[8] = {m0.x, m0.y, m0.z, m0.w, m1.x, m1.y, m1.z, m1.w};
#pragma unroll
                for (int q = 0; q < 8; ++q) o[q] = cu[q] + mm[q] * (0.5f * (pr[q] + nx[q]) - cu[q]);
            };
            float v[8];
            shifted(c0, v);        *(u32x4*)(rwr + tok * 512 + c0) = (u32x4){pk2(v[0], v[1]), pk2(v[2], v[3]), pk2(v[4], v[5]), pk2(v[6], v[7])};
            shifted(1024 + c0, v); *(u32x4*)(rwv + tok * 512 + c0) = (u32x4){pk2(v[0], v[1]), pk2(v[2], v[3]), pk2(v[4], v[5]), pk2(v[6], v[7])};
            shifted(512 + c0, v);  *(u32x4*)(rwk + tok * 512 + c0) = (u32x4){pk2(v[0], v[1]), pk2(v[2], v[3]), pk2(v[4], v[5]), pk2(v[6], v[7])};
            { const float4 k0 = *(const float4*)(F.in[I_RW_KK] + c0), k1 = *(const float4*)(F.in[I_RW_KK] + c0 + 4);
              float kk[8] = {v[0] * k0.x, v[1] * k0.y, v[2] * k0.z, v[3] * k0.w, v[4] * k1.x, v[5] * k1.y, v[6] * k1.z, v[7] * k1.w};
              float ss = 0.f;
#pragma unroll
              for (int q = 0; q < 8; ++q) ss += kk[q] * kk[q];
              ss += __shfl_xor(ss, 1); ss += __shfl_xor(ss, 2); ss += __shfl_xor(ss, 4);
              const float sc = rsqrtf(ss + 1e-6f);
              *(u32x4*)(rwkk + tok * 512 + c0) = (u32x4){pk2(kk[0] * sc, kk[1] * sc), pk2(kk[2] * sc, kk[3] * sc), pk2(kk[4] * sc, kk[5] * sc), pk2(kk[6] * sc, kk[7] * sc)}; }
            if (F.lane < 48) { shifted(1536 + c0, v);
                float o8[8];
#pragma unroll
                for (int q = 0; q < 8; ++q) { const float x = v[q]; o8[q] = c0 < 128 ? (2.f * sigmoidf_(2.f * x) - 1.f) : (c0 < 256 ? x : sigmoidf_(x)); }
                *(u32x4*)(lin + tok * 384 + c0) = (u32x4){pk2(o8[0], o8[1]), pk2(o8[2], o8[3]), pk2(o8[4], o8[5]), pk2(o8[6], o8[7])}; }
        }
    }
}

__device__ __forceinline__ void phase_rwpost(const Frame& F, int tb0, int tbs) {
    const bf16_t* rwr = WSP(bf16_t, OFF_RWR); const bf16_t* rwk = WSP(bf16_t, OFF_RWK); const bf16_t* rwv = WSP(bf16_t, OFF_RWV);
    const bf16_t* rwa = WSP(bf16_t, OFF_RWA); const bf16_t* rwg = WSP(bf16_t, OFF_RWG); const bf16_t* rwy = WSP(bf16_t, OFF_RWY); bf16_t* ycat = WSP(bf16_t, OFF_YCAT);
    const int c0 = F.lane * 8;
    float lnw[8], lnb[8], kaw[8], rk[8];
#pragma unroll
    for (int q = 0; q < 8; ++q) { lnw[q] = F.in[I_RW_LNW][c0 + q]; lnb[q] = F.in[I_RW_LNB][c0 + q]; kaw[q] = F.in[I_RW_KA][c0 + q]; rk[q] = F.in[I_RW_RK][c0 + q]; }
    for (int tb = tb0; tb < 256; tb += tbs) {
        const int base = tb * 64 + F.wid * 8;
        for (int i = 0; i < 8; ++i) { const size_t tok = base + i;
            float y[8], r[8], k[8], v[8], a0[8], a1[8], g[8];
            auto ld8b = [&](const bf16_t* p, float (&o)[8]) { const u32x4 x = *(const u32x4*)(p + tok * 512 + c0); o[0] = bflo(x.x); o[1] = bfhi(x.x); o[2] = bflo(x.y); o[3] = bfhi(x.y); o[4] = bflo(x.z); o[5] = bfhi(x.z); o[6] = bflo(x.w); o[7] = bfhi(x.w); };
            ld8b(rwy, y); ld8b(rwy + (size_t)T_ * 512, r);
#pragma unroll
            for (int q = 0; q < 8; ++q) y[q] += r[q];
            ld8b(rwr, r); ld8b(rwk, k); ld8b(rwv, v); ld8b(rwa, a0); ld8b(rwa + (size_t)T_ * 512, a1); ld8b(rwg, g);
            float sm = 0.f;
#pragma unroll
            for (int q = 0; q < 8; ++q) sm += y[q];
            sm += __shfl_xor(sm, 1); sm += __shfl_xor(sm, 2); sm += __shfl_xor(sm, 4);
            const float mean = sm * (1.f / 64.f);
            float vs = 0.f;
#pragma unroll
            for (int q = 0; q < 8; ++q) { y[q] -= mean; vs += y[q] * y[q]; }
            vs += __shfl_xor(vs, 1); vs += __shfl_xor(vs, 2); vs += __shfl_xor(vs, 4);
            const float rstd = rsqrtf(vs * (1.f / 64.f) + 64e-5f);
            float dot = 0.f;
#pragma unroll
            for (int q = 0; q < 8; ++q) { const float kb = k[q] * (1.f + (0.5f * (a0[q] + a1[q]) - 1.f) * kaw[q]); dot += r[q] * kb * rk[q]; }
            dot += __shfl_xor(dot, 1); dot += __shfl_xor(dot, 2); dot += __shfl_xor(dot, 4);
            float o[8];
#pragma unroll
            for (int q = 0; q < 8; ++q) o[q] = (y[q] * rstd * lnw[q] + lnb[q] + dot * v[q]) * g[q];
            *(u32x4*)(ycat + tok * 1024 + c0) = (u32x4){pk2(o[0], o[1]), pk2(o[2], o[3]), pk2(o[4], o[5]), pk2(o[6], o[7])};
        }
    }
}

constexpr int BG_NTILES = 16 * 3 * 704;
#define BG_DECODE(x) const int region_ = (x) / 704, tt_ = (x) % 704, e_ = region_ / 3, kind_ = region_ % 3; \
    const float* bsrc_; bf16_t* bdst_; int blds_, bldd_; \
    if (kind_ < 2) { const int kt_ = tt_ & 15, nt_ = tt_ >> 4; const int f_ = nt_ * 64, tile22_ = f_ >> 7, r_ = f_ & 127; \
        bsrc_ = F.in[kind_ == 0 ? I_WGATE : I_WUP] + ((size_t)(16 + e_) * 1024 + kt_ * 64) * 2816 + nt_ * 64; blds_ = 2816; \
        bdst_ = (bf16_t*)(F.ws + OFF_W1T + W1T_LAYER) + ((size_t)((e_ * 22 + tile22_) * 256 + kind_ * 128 + r_)) * 1024 + kt_ * 64; bldd_ = 1024; } \
    else { const int kt_ = tt_ % 44, nt_ = tt_ / 44; \
        bsrc_ = F.in[I_WDOWN] + ((size_t)(16 + e_) * 2816 + kt_ * 64) * 1024 + nt_ * 64; blds_ = 1024; \
        bdst_ = (bf16_t*)(F.ws + OFF_W2T + W2T_LAYER) + ((size_t)(e_ * 1024 + nt_ * 64)) * 2816 + kt_ * 64; bldd_ = 2816; }
__device__ __forceinline__ void bg_issue(const Frame& F, int x, LAS unsigned char* stg, int tz) {
    if (x < BG_NTILES) { BG_DECODE(x); (void)bdst_; (void)bldd_;
#pragma unroll
        for (int i = 0; i < 2; ++i) { const int ci = F.wid * 2 + i, row = ci * 4 + ((tz & 63) >> 4), col = (tz & 15) * 4;
            __builtin_amdgcn_global_load_lds((const unsigned*)(bsrc_ + (size_t)row * blds_ + col), (LAS unsigned*)(stg + ci * 1024), 16, 0, 0); } }
}
__device__ __forceinline__ void bg_flush(const Frame& F, LAS unsigned char* stg, int x, int tz) {
    if (x < BG_NTILES) { BG_DECODE(x); (void)bsrc_; (void)blds_; const int n = tz >> 3, ks = (tz & 7) * 8; const LAS float* t = (const LAS float*)stg + ks * 64 + n;
        u32x4 o; o.x = pk2(t[0], t[64]); o.y = pk2(t[128], t[192]); o.z = pk2(t[256], t[320]); o.w = pk2(t[384], t[448]);
        *(u32x4*)(bdst_ + (size_t)n * bldd_ + ks) = o; }
}
__device__ __forceinline__ void bg_issue2(const Frame& F, int x, LAS unsigned char* stg, int tz, bf16_t*& dsto, int& lddo) {
    dsto = nullptr; lddo = 0;
    if (x < BG_NTILES) { BG_DECODE(x); dsto = bdst_; lddo = bldd_; const int w_ = __builtin_amdgcn_readfirstlane(tz >> 6);
#pragma unroll
        for (int i = 0; i < 2; ++i) { const int ci = w_ * 2 + i, row = ci * 4 + ((tz & 63) >> 4), col = (tz & 15) * 4;
            __builtin_amdgcn_global_load_lds((const unsigned*)(bsrc_ + (size_t)row * blds_ + col), (LAS unsigned*)(stg + ci * 1024), 16, 0, 0); } }
}
__device__ __forceinline__ void bg_flush2(LAS unsigned char* stg, bf16_t* dst, int ldd, int tz) {
    if (dst != nullptr) { const int n = tz >> 3, ks = (tz & 7) * 8; const LAS float* t = (const LAS float*)stg + ks * 64 + n;
        u32x4 o; o.x = pk2(t[0], t[64]); o.y = pk2(t[128], t[192]); o.z = pk2(t[256], t[320]); o.w = pk2(t[384], t[448]);
        *(u32x4*)(dst + (size_t)n * ldd + ks) = o; }
}
constexpr int BG3_NTILES = 16 * 3 * 176;
__device__ __forceinline__ void bg3_issue(const Frame& F, int x, LAS unsigned char* stg, int tz, bf16_t*& dsto, int& lddo) {
    dsto = nullptr; lddo = 0;
    if (x < BG3_NTILES) {
        const int region_ = x / 176, tt_ = x % 176, e_ = region_ / 3, kind_ = region_ % 3; const float* bsrc_; int blds_;
        if (kind_ < 2) { const int kt_ = tt_ & 7, nt_ = tt_ >> 3;
            bsrc_ = F.in[kind_ == 0 ? I_WGATE : I_WUP] + ((size_t)(16 + e_) * 1024 + kt_ * 128) * 2816 + nt_ * 128; blds_ = 2816;
            dsto = (bf16_t*)(F.ws + OFF_W1T + W1T_LAYER) + (size_t)(e_ * 22 + nt_) * (256 * 1024) + (size_t)(2 * kt_) * 16384 + kind_ * 128 * 64; lddo = 1024; }
        else { const int kt_ = tt_ % 22, nt_ = tt_ / 22;
            bsrc_ = F.in[I_WDOWN] + ((size_t)(16 + e_) * 2816 + kt_ * 128) * 1024 + nt_ * 128; blds_ = 1024;
            dsto = (bf16_t*)(F.ws + OFF_W2T + W2T_LAYER) + (size_t)(e_ * 4 + (nt_ >> 1)) * (256 * 2816) + (size_t)(2 * kt_) * 16384 + (nt_ & 1) * 128 * 64; lddo = 2816; }
        const int w_ = __builtin_amdgcn_readfirstlane(tz >> 6);
#pragma unroll
        for (int i = 0; i < 8; ++i) { const int row = w_ * 16 + 2 * i + ((tz & 63) >> 5), col = (tz & 31) * 4;
            __builtin_amdgcn_global_load_lds((const unsigned*)(bsrc_ + (size_t)row * blds_ + col), (LAS unsigned*)(stg + (w_ * 16 + 2 * i) * 512), 16, 0, 0); } }
}
__device__ __forceinline__ void bg3_flush(LAS unsigned char* stg, bf16_t* dst, int ldd, int tz) {
    if (dst != nullptr) { const int n0 = tz & 63, w_ = __builtin_amdgcn_readfirstlane(tz >> 6);
#pragma unroll
        for (int ps = 0; ps < 4; ++ps) { const int c = w_ * 4 + ps, n = (c & 1) * 64 + n0, k0 = (c >> 1) * 8; const LAS float* t = (const LAS float*)stg + k0 * 128 + n;
            u32x4 o; o.x = pk2(t[0], t[128]); o.y = pk2(t[256], t[384]); o.z = pk2(t[512], t[640]); o.w = pk2(t[768], t[896]);
            *(u32x4*)(dst + (k0 >> 6) * 16384 + n * 64 + (k0 & 63)) = o; } }
}
template <bool BGON = true> __device__ __forceinline__ void phase_attn(const Frame& F) {
    LAS unsigned char* lds = F.lds;
    const bf16_t* P1 = WSP(bf16_t, OFF_P1); const bf16_t* Vimg = WSP(bf16_t, OFF_VIMG); bf16_t* ycat = WSP(bf16_t, OFF_YCAT);
    constexpr int KS = 0, VS = 16384, CVB = 49152;
    const float lam_init = 0.8f - 0.6f * 0.7408182206817179f;
    float lam;
    { const float* lp = F.in[I_DF_LAM]; float s1 = 0.f, s2 = 0.f;
      for (int i = 0; i < 64; ++i) { s1 += lp[i] * lp[64 + i]; s2 += lp[128 + i] * lp[192 + i]; }
      lam = __expf(s1) - __expf(s2) + lam_init; }
    const int hh = F.lane >> 5, ql = F.lane & 31;
    for (int u = F.bid; u < 256; u += F.nblk) {
        const int qb = u & 15, h = (u >> 4) & 3, b = u >> 6;
        const float slope2 = exp2f(-2.f * (float)(h + 1)) * 1.4426950408889634f;
        const size_t tok0 = (size_t)b * 4096 + qb * 256;
        const int qrow = F.wid * 32 + ql;
        const float qpos = (float)(qb * 256 + qrow);
        bf16_t* bgd = nullptr; int bgl = 0;
        for (int m = 0; m < 2; ++m) {
            const unsigned klo = (unsigned)(((F.wid * 8 + (F.lane >> 3)) * 3072 + (((F.lane & 7) ^ (((F.wid * 8 + (F.lane >> 3)) >> 1) & 7)) * 8)) * 2);
            const unsigned vlo = (unsigned)((F.wid * 1024 + F.lane * 8) * 2);
            const char* kub = (const char*)(P1 + ((size_t)b * 4096) * 3072 + 2432 + h * 128 + m * 64);
            const char* vub = (const char*)(Vimg + ((size_t)(b * 4 + h) * 64) * 8192);
#define AT_STAGE(kt, buf) do { unsigned klo_ = klo, vlo_ = vlo; asm volatile("" : "+v"(klo_), "+v"(vlo_));     \
            __builtin_amdgcn_global_load_lds((const unsigned*)(kub + (size_t)(kt) * (64 * 3072 * 2) + klo_), (LAS unsigned*)(lds + KS + (buf) * 8192 + F.wid * 1024), 16, 0, 0); \
            __builtin_amdgcn_global_load_lds((const unsigned*)(vub + (size_t)(kt) * 16384 + vlo_), (LAS unsigned*)(lds + VS + (buf) * 16384 + F.wid * 2048), 16, 0, 0); \
            __builtin_amdgcn_global_load_lds((const unsigned*)(vub + (size_t)(kt) * 16384 + vlo_ + 1024), (LAS unsigned*)(lds + VS + (buf) * 16384 + F.wid * 2048 + 1024), 16, 0, 0); } while (0)
            AT_STAGE(0, 0);
            f32x16 O[4];
#pragma unroll
            for (int dt = 0; dt < 4; ++dt)
#pragma unroll
                for (int r = 0; r < 16; ++r) O[dt][r] = 0.f;
            float mrun = -1e30f, lrun = 0.f;
            asm volatile("s_waitcnt vmcnt(0)" ::: "memory");
            __syncthreads();
            bf16x8 qf[4];
#pragma unroll
            for (int s = 0; s < 4; ++s) { const u32x4 qv = *(const u32x4*)(P1 + (tok0 + qrow) * 3072 + 1920 + h * 128 + m * 64 + (s * 2 + hh) * 8);
                const float sc = 0.18033688011112042f;
                u32x4 o; o.x = pk2(bflo(qv.x) * sc, bfhi(qv.x) * sc); o.y = pk2(bflo(qv.y) * sc, bfhi(qv.y) * sc); o.z = pk2(bflo(qv.z) * sc, bfhi(qv.z) * sc); o.w = pk2(bflo(qv.w) * sc, bfhi(qv.w) * sc);
                qf[s] = as_frag(o); }
            for (int kt = 0; kt < 64; ++kt) {
                const int buf = kt & 1;
                if (kt + 1 < 64) AT_STAGE(kt + 1, buf ^ 1);
                bf16x8 kf[2][4];
#pragma unroll
                for (int k2 = 0; k2 < 2; ++k2)
#pragma unroll
                    for (int s = 0; s < 4; ++s) { const int col16 = s * 2 + hh; const int key = k2 * 32 + ql;
                        kf[k2][s] = *(const LAS bf16x8*)(lds + KS + buf * 8192 + key * 128 + ((col16 ^ ((key >> 1) & 7)) * 16)); }
                asm volatile("" ::: "memory");
                const int bgi = m * 64 + kt;
                { int tzb = F.tid; asm volatile("" : "+v"(tzb));
                  if (BGON) { if (bgi & 1) bg3_issue(F, F.bid + (bgi >> 1) * (int)F.nblk, lds + CVB, tzb, bgd, bgl);
                              else bg3_flush(lds + CVB, bgd, bgl, tzb); } }
                const float dbase = (float)(kt * 64 + 4 * hh) - qpos;
                f32x16 Sx[2];
#pragma unroll
                for (int k2 = 0; k2 < 2; ++k2)
#pragma unroll
                    for (int r = 0; r < 16; ++r) Sx[k2][r] = 0.f;
                asm volatile("s_waitcnt lgkmcnt(0)" ::: "memory");
#pragma unroll
                for (int s = 0; s < 4; ++s) {
                    Sx[0] = __builtin_amdgcn_mfma_f32_32x32x16_bf16(kf[0][s], qf[s], Sx[0], 0, 0, 0);
                    Sx[1] = __builtin_amdgcn_mfma_f32_32x32x16_bf16(kf[1][s], qf[s], Sx[1], 0, 0, 0); }
                asm volatile("" ::: "memory");
                bf16x8 va[4], vb[4];
#define AT_VLOAD(dst, dt) _Pragma("unroll") for (int ks = 0; ks < 4; ++ks) { const int dv = (dt) * 32 + ql; \
                    dst[ks] = *(const LAS bf16x8*)(lds + VS + buf * 16384 + ((ks * 2 + hh) * 128 + dv) * 16); }
                AT_VLOAD(va, 0) AT_VLOAD(vb, 1)
                asm volatile("" ::: "memory");
                float mt = -1e30f;
#pragma unroll
                for (int k2 = 0; k2 < 2; ++k2)
#pragma unroll
                    for (int r = 0; r < 16; ++r) { const float dd = dbase + (float)(k2 * 32 + (r & 3) + 8 * (r >> 2));
                        const float tv = Sx[k2][r] - slope2 * fabsf(dd); Sx[k2][r] = tv; mt = fmaxf(mt, tv); }
                mt = fmaxf(mt, __shfl_xor(mt, 32));
                const float mnew = fmaxf(mrun, mt), alpha = __builtin_amdgcn_exp2f(mrun - mnew);
                float ls = 0.f;
#pragma unroll
                for (int k2 = 0; k2 < 2; ++k2)
#pragma unroll
                    for (int r = 0; r < 16; ++r) { const float pv = __builtin_amdgcn_exp2f(Sx[k2][r] - mnew); Sx[k2][r] = pv; ls += pv; }
                lrun = lrun * alpha + ls; mrun = mnew;
                bf16x8 Pp[4];
#pragma unroll
                for (int ks = 0; ks < 4; ++ks) { const int k2 = ks >> 1, r0 = (ks & 1) * 8; bf16x8 pf;
#pragma unroll
                    for (int j = 0; j < 4; ++j) { const unsigned w2 = pg8::cvt_pk_bf16(Sx[k2][r0 + 2 * j], Sx[k2][r0 + 2 * j + 1]); pf[2 * j] = (short)(w2 & 0xFFFFu); pf[2 * j + 1] = (short)(w2 >> 16); }
                    Pp[ks] = pf; }
                if (__builtin_amdgcn_ballot_w64(alpha != 1.f)) {
#pragma unroll
                    for (int dt = 0; dt < 4; ++dt)
#pragma unroll
                        for (int r = 0; r < 16; ++r) O[dt][r] *= alpha; }
                asm volatile("" ::: "memory");
                bf16x8 vc[4], vd[4];
                AT_VLOAD(vc, 2) AT_VLOAD(vd, 3)
                asm volatile("" ::: "memory");
#define AT_VF(v, ks) (v[ks])
#pragma unroll
                for (int ks = 0; ks < 4; ++ks) {
                    O[0] = __builtin_amdgcn_mfma_f32_32x32x16_bf16(AT_VF(va, ks), Pp[ks], O[0], 0, 0, 0);
                    O[1] = __builtin_amdgcn_mfma_f32_32x32x16_bf16(AT_VF(vb, ks), Pp[ks], O[1], 0, 0, 0); }
#pragma unroll
                for (int ks = 0; ks < 4; ++ks) {
                    O[2] = __builtin_amdgcn_mfma_f32_32x32x16_bf16(AT_VF(vc, ks), Pp[ks], O[2], 0, 0, 0);
                    O[3] = __builtin_amdgcn_mfma_f32_32x32x16_bf16(AT_VF(vd, ks), Pp[ks], O[3], 0, 0, 0); }
                asm volatile("" ::: "memory");
#undef AT_VLOAD
#undef AT_VF
                asm volatile("s_waitcnt vmcnt(0)" ::: "memory");
                __syncthreads();
            }
#undef AT_STAGE
            const float lt = lrun + __shfl_xor(lrun, 32);
            int tze = F.tid; asm volatile("" : "+v"(tze));
            bf16_t* orow = ycat + (tok0 + (tze >> 6) * 32 + (tze & 31)) * 1024 + 512 + h * 128;
            if (m == 0) { const float i0 = 1.f / lt;
#pragma unroll
                for (int dt = 0; dt < 4; ++dt)
#pragma unroll
                    for (int gq = 0; gq < 4; ++gq) { const int dv = dt * 32 + 8 * gq + 4 * hh;
                        u32x2 pk; pk.x = pk2(O[dt][4 * gq] * i0, O[dt][4 * gq + 1] * i0); pk.y = pk2(O[dt][4 * gq + 2] * i0, O[dt][4 * gq + 3] * i0);
                        *(u32x2*)(orow + dv) = pk; }
                asm volatile("s_waitcnt vmcnt(0)" ::: "memory");
            } else {
                const float i1 = lam / lt;
                float ss = 0.f;
#pragma unroll
                for (int dt = 0; dt < 4; ++dt)
#pragma unroll
                    for (int gq = 0; gq < 4; ++gq) { const int dv = dt * 32 + 8 * gq + 4 * hh; const u32x2 pv = *(const u32x2*)(orow + dv);
                        const float o0 = bflo(pv.x) - O[dt][4 * gq] * i1, o1 = bfhi(pv.x) - O[dt][4 * gq + 1] * i1, o2 = bflo(pv.y) - O[dt][4 * gq + 2] * i1, o3 = bfhi(pv.y) - O[dt][4 * gq + 3] * i1;
                        O[dt][4 * gq] = o0; O[dt][4 * gq + 1] = o1; O[dt][4 * gq + 2] = o2; O[dt][4 * gq + 3] = o3; ss += o0 * o0 + o1 * o1 + o2 * o2 + o3 * o3; }
                ss += __shfl_xor(ss, 32);
                const float rstd = rsqrtf(ss * (1.f / 128.f) + 1e-5f) * (1.f - lam_init);
#pragma unroll
                for (int dt = 0; dt < 4; ++dt)
#pragma unroll
                    for (int gq = 0; gq < 4; ++gq) { const int dv = dt * 32 + 8 * gq + 4 * hh; const float4 sw = *(const float4*)(F.in[I_DF_SUBLN] + dv);
                        u32x2 pk; pk.x = pk2(O[dt][4 * gq] * rstd * sw.x, O[dt][4 * gq + 1] * rstd * sw.y); pk.y = pk2(O[dt][4 * gq + 2] * rstd * sw.z, O[dt][4 * gq + 3] * rstd * sw.w);
                        *(u32x2*)(orow + dv) = pk; }
            }
        }
        __syncthreads();
        int tzt = F.tid; asm volatile("" : "+v"(tzt));
        asm volatile("s_waitcnt vmcnt(0)" ::: "memory"); __syncthreads();
        bg3_flush(lds + CVB, bgd, bgl, tzt);
        for (int x = F.bid + 64 * (int)F.nblk; BGON && x < BG3_NTILES; x += F.nblk) {
            __syncthreads(); bg3_issue(F, x, lds + CVB, tzt, bgd, bgl);
            asm volatile("s_waitcnt vmcnt(0)" ::: "memory"); __syncthreads();
            bg3_flush(lds + CVB, bgd, bgl, tzt); }
        __syncthreads();
    }
}
enum { PH_PRO = 0, PH_NORM0, PH_IN0, PH_DNPREP, PH_DNAB, PH_DNC, PH_SCAN0, PH_POST0, PH_GLU, PH_OUT0, PH_MID0, PH_TOPK0, PH_MOE1_0, PH_MOE2_0, PH_COMB0,
       PH_IN1, PH_RWPREP, PH_LORA, PH_RWA, PH_RWB, PH_RWC, PH_SCAN1, PH_RWPOST, PH_OUT1, PH_MID1, PH_TOPK1, PH_MOE1_1, PH_MOE2_1, PH_COMB1, N_PHASES };
#ifndef DBL
#define DBL -1
#endif
constexpr int CVT_NJOB = 520 + 16 * 3 * 176, CVT_SPLIT = CVT_NJOB - 3072;
#ifdef PROBE_MIN
#define STAMP(k) do { if (F.bid == 0 && F.tid == 0) ((unsigned long long*)(F.ws + OFF_BAR))[1800 + (k)] = __builtin_amdgcn_s_memrealtime(); } while (0)
#else
#define STAMP(k) do { } while (0)
#endif
#define REP(k) for (int rep_ = 0; rep_ < ((DBL) == (k) ? 2 : 1); ++rep_)
__global__ void __launch_bounds__(NTHR, 2) fwd(Args args) {
    extern __shared__ __attribute__((aligned(16))) unsigned char smem[];
    Frame F;
    const int wid_s = __builtin_amdgcn_readfirstlane((int)threadIdx.x >> 6);
    F.smem = smem; F.lds = (LAS unsigned char*)smem; F.wid = wid_s; F.lane = my_lane(); F.tid = wid_s * 64 + F.lane;
    F.bid = blockIdx.x; F.nblk = gridDim.x; F.in = args.in; F.out = args.out; F.ws = args.ws; F.z = 0;
#define FRESH() do { int l_ = my_lane(); asm volatile("" : "+v"(l_)); F.lane = l_; F.wid = wid_s; F.tid = wid_s * 64 + l_; \
        size_t z_ = 0; asm volatile("" : "+s"(z_)); F.z = z_; } while (0)
    volatile LAS unsigned* xbw = (volatile LAS unsigned*)(F.lds + LDS_MAIN);
    if (F.tid < 4) xbw[F.tid] = 0u;
    __syncthreads();
    const int lo = args.ph_lo, hi = args.ph_hi;
    XcdBarrier bar; bar.bar = (unsigned*)(args.ws + OFF_BAR); bar.x = 0; bar.st = xbw;
    if (hi - lo > 1) bar = xcd_barrier_post((unsigned*)(args.ws + OFF_BAR), xbw, F.tid);
#define IN(k) (lo <= (k) && (k) < hi)
#define SEAM(k) do { if (IN(k) && IN((k) + 1)) { FRESH(); xcd_barrier(bar, F.tid); } } while (0)
    const int G = F.nblk, c = F.bid;

    if (IN(PH_PRO)) { FRESH(); REP(0) { phase_mod(F); __syncthreads(); phase_convert<true>(F, 0, CVT_SPLIT, (int)F.bid, (int)F.nblk); __syncthreads(); } } SEAM(PH_PRO);
    if (IN(PH_NORM0)) { FRESH(); phase_norm0(F); } SEAM(PH_NORM0);
    if (IN(PH_IN0)) { FRESH();
        pg8::Gemm g{WSP(bf16_t, OFF_HB), WSP(bf16_t, OFF_WIN0T), 1024, 1024, 1024, nullptr}; pg8::StaticOrder S; S.init(T_, 2560, G, c);
        EpiBf16Plain E{WSP(bf16_t, OFF_P0), 2560, 2560};
        pg8::gemm_phase<EpiBf16Plain, pg8::StaticOrder, false>(F.lds, g, S, E, F.tid);
#if DBL == 2
        __syncthreads(); FRESH(); pg8::gemm_phase<EpiBf16Plain, pg8::StaticOrder, false>(F.lds, g, S, E, F.tid);
#endif
    } SEAM(PH_IN0);
    if (IN(PH_DNPREP)) { FRESH(); phase_dnprep(F); } SEAM(PH_DNPREP);
    STAMP(0);
    if (IN(PH_DNAB)) { FRESH(); REP(40) { phase_dn_ab(F); __syncthreads(); } asm volatile("s_waitcnt vmcnt(0)" ::: "memory"); __syncthreads(); } STAMP(1);
    if (IN(PH_DNC)) { FRESH(); phase_dn_c(F); __syncthreads();
#if DBL == 41
        FRESH(); phase_dn_c(F); __syncthreads();
#endif
    } SEAM(PH_DNC); STAMP(2);
    if (IN(PH_SCAN0)) { FRESH();
#ifdef DN_NAIVE_CHECK
        phase_dn_naive_check(F); __syncthreads();
#endif
#if defined(DN_NANSCAN) && !defined(S5_NANSCAN)
        phase_dn_nanscan(F); __syncthreads(); FRESH(); xcd_barrier(bar, F.tid);
#endif
#ifdef BISECT_OLD_FIRST
        phase_dnscan(F); __syncthreads(); FRESH(); xcd_barrier(bar, F.tid);
#endif
        if (F.nblk == 256 ? F.bid >= 128 : true) {
            if (F.nblk == 256) phase_convert<false>(F, CVT_SPLIT, CVT_NJOB, (int)F.bid - 128, 128); else phase_convert<false>(F, CVT_SPLIT, CVT_NJOB, (int)F.bid, (int)F.nblk);
            __syncthreads(); }
        REP(42) { CarryBufs<4> cb{WSP(u32x4, OFF_DN_PHI), WSP(u32x4, OFF_DN_C), WSP(bf16_t, OFF_DN_QE), WSP(u32x4, OFF_DN_YI), WSP(bf16_t, OFF_DNO), 4, 512, 8192, 1024};
          phase_carry<4, 3>(F, cb, 128, F.bid, F.nblk); __syncthreads();
#ifdef DN_CHECK2
          FRESH(); xcd_barrier(bar, F.tid); if (F.bid == 0 && F.tid == 0) ((unsigned*)(F.ws + OFF_BAR))[4002] = 1u; FRESH(); xcd_barrier(bar, F.tid);
          phase_dn_ab(F); FRESH(); xcd_barrier(bar, F.tid); phase_dn_c(F); FRESH(); xcd_barrier(bar, F.tid); phase_carry<4>(F, cb, 128, F.bid, F.nblk); __syncthreads();
#endif
          }
#ifdef BISECT_OLD_DN
        phase_dnscan(F); __syncthreads();
#endif
#ifdef S5_CMP
#ifdef S5_BITCMP
        phase_s5scan_store(F); __syncthreads(); FRESH(); xcd_barrier(bar, F.tid);
#else
        phase_s5scan_old(F); __syncthreads(); FRESH(); xcd_barrier(bar, F.tid);
#endif
#endif
        REP(43) { phase_s5scan(F); __syncthreads(); }
#ifdef S5_CMP
        FRESH(); xcd_barrier(bar, F.tid);
#endif
#ifdef S5_NANSCAN
        FRESH(); xcd_barrier(bar, F.tid); phase_dn_nanscan(F); __syncthreads(); FRESH(); xcd_barrier(bar, F.tid);
#endif
    } SEAM(PH_SCAN0);
#ifdef PROBE_MIN
    {
        FRESH(); const float* fw = (const float*)(F.ws + OFF_BAR); const float r1 = sqrtf(fw[4004] / fmaxf(fw[4005], 1e-30f)), r2 = sqrtf(fw[4006] / fmaxf(fw[4007], 1e-30f));
        const float d1 = (r1 == r1) ? fminf(8.f, floorf(r1 * 50.f)) : 9.f, d2 = (r2 == r2) ? fminf(8.f, floorf(r2 * 50.f)) : 9.f;
        float addv = 100.f * (1.f + 10.f * d1 + d2);
#ifdef DN_NANSCAN
        addv = 100.f * (float)(((const unsigned*)(F.ws + OFF_BAR))[4001] + 1u);
#endif
#ifdef PROBE_SEL
        { FRESH(); xcd_barrier(bar, F.tid); const unsigned long long* st = (const unsigned long long*)(F.ws + OFF_BAR) + 1800; addv = 10.f * 0.01f * (float)(st[PROBE_SEL + 1] - st[PROBE_SEL]); }
#endif
        for (size_t i = (size_t)F.bid * NTHR + F.tid; i < (size_t)T_ * 1024; i += (size_t)F.nblk * NTHR) F.out[i] = addv;
        return; }
#else
    if (IN(PH_POST0)) { FRESH(); phase_post0(F); } SEAM(PH_POST0);
    if (IN(PH_GLU)) { FRESH();
        pg8::Gemm g{WSP(bf16_t, OFF_YS5), WSP(bf16_t, OFF_WGLUT), 512, 512, 512, nullptr}; pg8::StaticOrder S; S.init(T_, 512, G, c);
        EpiGlu E{WSP(bf16_t, OFF_YS5), F.in[I_S5_GLUB], WSP(bf16_t, OFF_YCAT)};
        pg8::gemm_phase<EpiGlu, pg8::StaticOrder, false>(F.lds, g, S, E, F.tid);
    } SEAM(PH_GLU);
    if (IN(PH_OUT0)) { FRESH();
        pg8::Gemm g{WSP(bf16_t, OFF_YCAT), WSP(bf16_t, OFF_WOUT0T), 1024, 1024, 1024, nullptr}; pg8::StaticOrder S; S.init(T_, 1024, G, c);
        EpiBf16Plain E{WSP(bf16_t, OFF_YMIX), 1024, 1024};
        pg8::gemm_phase<EpiBf16Plain, pg8::StaticOrder, false>(F.lds, g, S, E, F.tid);
#if DBL == 7
        __syncthreads(); FRESH(); pg8::gemm_phase<EpiBf16Plain, pg8::StaticOrder, false>(F.lds, g, S, E, F.tid);
#endif
    } SEAM(PH_OUT0);
    if (IN(PH_MID0)) { FRESH(); phase_mid<false>(F, 0, F.in[I_X], WSP(bf16_t, OFF_XA)); } SEAM(PH_MID0);
    if (IN(PH_TOPK0)) { FRESH(); phase_topk(F); } SEAM(PH_TOPK0);
    if (IN(PH_MOE1_0)) { FRESH();
        pg8::Gemm g{WSP(bf16_t, OFF_HB), (const bf16_t*)(F.ws + OFF_W1T), 1024, 64, 1024, WSP(int, OFF_ROWTOK), (size_t)32768, (size_t)256 * 1024 * 2}; pg8::MoeOrder S{176, 22, G, c};
        EpiSwiglu E{WSP(bf16_t, OFF_HBUF)};
        pg8::gemm_phase<EpiSwiglu, pg8::MoeOrder, true>(F.lds, g, S, E, F.tid);
#if DBL == 10
        __syncthreads(); FRESH(); pg8::gemm_phase<EpiSwiglu, pg8::MoeOrder, true>(F.lds, g, S, E, F.tid);
#endif
    } SEAM(PH_MOE1_0);
    if (IN(PH_MOE2_0)) { FRESH();
        pg8::Gemm g{WSP(bf16_t, OFF_HBUF), (const bf16_t*)(F.ws + OFF_W2T), F_, 64, F_, nullptr, (size_t)32768, (size_t)256 * F_ * 2}; pg8::MoeOrder S{32, 4, G, c};
        EpiDown E{WSP(bf16_t, OFF_YBUF), WSP(float, OFF_GATEV)};
        pg8::gemm_phase<EpiDown, pg8::MoeOrder, false>(F.lds, g, S, E, F.tid);
#if DBL == 11
        __syncthreads(); FRESH(); pg8::gemm_phase<EpiDown, pg8::MoeOrder, false>(F.lds, g, S, E, F.tid);
#endif
    } SEAM(PH_MOE2_0);
    if (IN(PH_COMB0)) { FRESH(); phase_combine<true>(F, 0, WSP(bf16_t, OFF_XA), WSP(bf16_t, OFF_XB), true); } SEAM(PH_COMB0);
    if (IN(PH_IN1)) { FRESH();
        { pg8::Gemm g{WSP(bf16_t, OFF_HB), WSP(bf16_t, OFF_WIN1T), 1024, 1024, 1024, nullptr}; pg8::StaticOrder S; S.init(T_, 3072, G, c);
          EpiBf16Plain E{WSP(bf16_t, OFF_P1), 3072, 2944};
          pg8::gemm_phase<EpiBf16Plain, pg8::StaticOrder, false>(F.lds, g, S, E, F.tid); }
        { pg8::Gemm g{WSP(bf16_t, OFF_WVT), WSP(bf16_t, OFF_HB), 1024, 1024, 1024, nullptr}; pg8::StaticOrder S; S.init(512, T_, G, c);
          EpiVimg E{WSP(bf16_t, OFF_VIMG)};
          pg8::gemm_phase<EpiVimg, pg8::StaticOrder, false>(F.lds, g, S, E, F.tid); }
    } SEAM(PH_IN1);
    if (IN(PH_RWPREP)) { FRESH(); phase_rwprep(F); } SEAM(PH_RWPREP);
    if (IN(PH_LORA)) { FRESH();
        pg8::Gemm g{WSP(bf16_t, OFF_LORAIN), WSP(bf16_t, OFF_WLORAT), 384, 384, 384, nullptr}; pg8::StaticOrder S; S.init(T_, 2560, G, c);
        EpiLora E{WSP(float, OFF_RWDEC), WSP(bf16_t, OFF_RWA), WSP(bf16_t, OFF_RWG), F.in[I_RW_W0], F.in[I_RW_A0]};
        pg8::gemm_phase<EpiLora, pg8::StaticOrder, false>(F.lds, g, S, E, F.tid);
    } SEAM(PH_LORA);
    if (IN(PH_RWA)) { FRESH(); phase_rw_a(F); asm volatile("s_waitcnt vmcnt(0)" ::: "memory"); __syncthreads(); }
    if (IN(PH_RWB)) { FRESH(); phase_rw_b(F); asm volatile("s_waitcnt vmcnt(0)" ::: "memory"); __syncthreads(); }
    if (IN(PH_RWC)) { FRESH(); phase_rw_c(F); __syncthreads(); } SEAM(PH_RWC);
    if (IN(PH_SCAN1)) { FRESH();
        { CarryBufs<2> cb{WSP(u32x4, OFF_RW_PHI), WSP(u32x4, OFF_RW_C), WSP(bf16_t, OFF_RW_QE), WSP(u32x4, OFF_RW_YI), WSP(bf16_t, OFF_RWY), 2, 512, 8192, 1024};
          phase_carry<2, 4>(F, cb, 128, F.bid, F.nblk); __syncthreads(); }
        const bool fusepost = (F.nblk == 256);
        if (fusepost && F.bid < 128) { asm volatile("s_waitcnt vmcnt(0)" ::: "memory"); __syncthreads();
            if (F.tid == 0) { __builtin_amdgcn_fence(__ATOMIC_RELEASE, "agent"); asm volatile("s_waitcnt vmcnt(0)" ::: "memory"); (void)xb_add(&bar.bar[XB_RWFLAG], 1u); } }
        phase_attn(F); __syncthreads();
        if (fusepost && F.bid >= 128) {
            if (F.tid == 0) { unsigned* bb = bar.bar; XB_SPIN(xb_ld(&bb[XB_RWFLAG]) < 128u, bb); __builtin_amdgcn_fence(__ATOMIC_ACQUIRE, "agent"); asm volatile("s_waitcnt vmcnt(0)" ::: "memory"); }
            __syncthreads(); FRESH(); phase_rwpost(F, (int)F.bid - 128, 128); __syncthreads(); }
#if DBL == 161
        FRESH(); phase_attn(F); __syncthreads();
#endif
#if DBL == 162
        FRESH(); phase_attn<false>(F); __syncthreads();
#endif
    } SEAM(PH_SCAN1);
    if (F.nblk != 256) { if (IN(PH_RWPOST)) { FRESH(); phase_rwpost(F, (int)F.bid, (int)F.nblk); } SEAM(PH_RWPOST); }
    if (IN(PH_OUT1)) { FRESH();
        pg8::Gemm g{WSP(bf16_t, OFF_YCAT), WSP(bf16_t, OFF_WOUT1T), 1024, 1024, 1024, nullptr}; pg8::StaticOrder S; S.init(T_, 1024, G, c);
        EpiBf16Plain E{WSP(bf16_t, OFF_YMIX), 1024, 1024};
        pg8::gemm_phase<EpiBf16Plain, pg8::StaticOrder, false>(F.lds, g, S, E, F.tid);
    } SEAM(PH_OUT1);
    if (IN(PH_MID1)) { FRESH(); phase_mid<true>(F, 1, WSP(bf16_t, OFF_XB), WSP(bf16_t, OFF_XA)); } SEAM(PH_MID1);
    if (IN(PH_TOPK1)) { FRESH(); phase_topk(F); } SEAM(PH_TOPK1);
    if (IN(PH_MOE1_1)) { FRESH();
        pg8::Gemm g{WSP(bf16_t, OFF_HB), (const bf16_t*)(F.ws + OFF_W1T + W1T_LAYER), 1024, 64, 1024, WSP(int, OFF_ROWTOK), (size_t)32768, (size_t)256 * 1024 * 2}; pg8::MoeOrder S{176, 22, G, c};
        EpiSwiglu E{WSP(bf16_t, OFF_HBUF)};
        pg8::gemm_phase<EpiSwiglu, pg8::MoeOrder, true>(F.lds, g, S, E, F.tid);
    } SEAM(PH_MOE1_1);
    if (IN(PH_MOE2_1)) { FRESH();
        pg8::Gemm g{WSP(bf16_t, OFF_HBUF), (const bf16_t*)(F.ws + OFF_W2T + W2T_LAYER), F_, 64, F_, nullptr, (size_t)32768, (size_t)256 * F_ * 2}; pg8::MoeOrder S{32, 4, G, c};
        EpiDown E{WSP(bf16_t, OFF_YBUF), WSP(float, OFF_GATEV)};
        pg8::gemm_phase<EpiDown, pg8::MoeOrder, false>(F.lds, g, S, E, F.tid);
    } SEAM(PH_MOE2_1);
    if (IN(PH_COMB1)) { FRESH(); phase_combine<false>(F, 1, WSP(bf16_t, OFF_XA), F.out, false); }
#endif
#undef IN
#undef SEAM
#undef FRESH
}

#ifndef ONE_LAUNCH
#define ONE_LAUNCH 1
#endif
extern "C" void kernel_launch(void* const* d_in, const int* in_sizes, int n_in, void* d_out, int out_size, void* d_ws, size_t ws_size, hipStream_t stream) {
    static int grid = 0;
    if (grid == 0) {
        int dev = 0, cus = 0, per_cu = 0;
        if (n_in != 43 || ws_size < WS_NEED) { fprintf(stderr, "kernel_launch: unexpected inputs (%d) or workspace (%zu < %zu)\n", n_in, ws_size, (size_t)WS_NEED); grid = -1; return; }
        if (hipGetDevice(&dev) != hipSuccess || hipDeviceGetAttribute(&cus, hipDeviceAttributeMultiprocessorCount, dev) != hipSuccess) { grid = -1; return; }
        if (hipFuncSetAttribute((const void*)fwd, hipFuncAttributeMaxDynamicSharedMemorySize, LDS_BYTES) != hipSuccess) { fprintf(stderr, "kernel_launch: hipFuncSetAttribute failed\n"); grid = -1; return; }
        if (hipOccupancyMaxActiveBlocksPerMultiprocessor(&per_cu, (const void*)fwd, NTHR, LDS_BYTES) != hipSuccess || per_cu < 1) { fprintf(stderr, "kernel_launch: occupancy query says %d\n", per_cu); (void)hipGetLastError(); }
        grid = cus;
    }
    if (grid < 0) return;
    (void)hipMemsetAsync((char*)d_ws + OFF_BAR, 0, 16384, stream);
    Args a{};
    for (int i = 0; i < 43; ++i) a.in[i] = (const float*)d_in[i];
    a.out = (float*)d_out; a.ws = (unsigned char*)d_ws;
#if ONE_LAUNCH
    a.ph_lo = 0; a.ph_hi = N_PHASES;
    hipLaunchKernelGGL(fwd, dim3(grid), dim3(NTHR), LDS_BYTES, stream, a);
#else
    for (int ph = 0; ph < N_PHASES; ++ph) { a.ph_lo = ph; a.ph_hi = ph + 1; hipLaunchKernelGGL(fwd, dim3(grid), dim3(NTHR), LDS_BYTES, stream, a); }
#endif
}
```
